# Optimizing an MI355X kernel written in HIP

```python
import jax, jax.numpy as jnp
from jax import lax
import numpy as np

D_MODEL = 1024
BATCH = 4
SEQ = 4096
DEPTH = 4

N_EVEN = (DEPTH + 1) // 2
N_ODD = DEPTH // 2
EPS = 1e-6
LRU_WIDTH = D_MODEL // 2
LRU_BLOCKS = 8
LRU_BLOCK = LRU_WIDTH // LRU_BLOCKS
CONV_W = 4
LRU_C = 8.0
FOX_HEADS = 8
FOX_HEAD_DIM = (D_MODEL // 2) // FOX_HEADS
FOX_WIDTH = FOX_HEADS * FOX_HEAD_DIM
Q_BLOCK = 128
EVEN_SPLITS = [LRU_WIDTH, 2 * LRU_WIDTH, 2 * LRU_WIDTH + FOX_WIDTH, 2 * LRU_WIDTH + 2 * FOX_WIDTH, 2 * LRU_WIDTH + 3 * FOX_WIDTH]
EVEN_IN = 2 * LRU_WIDTH + 3 * FOX_WIDTH + FOX_HEADS
GLA_HEADS = 4
GLA_DK = (D_MODEL // 2) // GLA_HEADS
GLA_DV = D_MODEL // GLA_HEADS
GLA_RANK = 16
GLA_TAU = 16.0
GLA_CHUNK = 64
GLA_KW = GLA_HEADS * GLA_DK
GLA_VW = GLA_HEADS * GLA_DV
ODD_SPLITS = [GLA_KW, 2 * GLA_KW, 2 * GLA_KW + GLA_VW, 2 * GLA_KW + 2 * GLA_VW]
ODD_IN = 2 * GLA_KW + 2 * GLA_VW + GLA_RANK
D_FF = 2816
N_EXPERTS = 8
TOP_K = 2
D_FF_EXPERT = 3584

kernel_name = "hybrid_rglru_fox_gla_moe"


def rms_norm(x, g):
    xf = x.astype(jnp.float32)
    y = xf * lax.rsqrt(jnp.mean(xf * xf, axis=-1, keepdims=True) + EPS)
    return (y * g.astype(jnp.float32)).astype(x.dtype)


def causal_depthwise_conv(x, w, b):
    s = x.shape[1]
    xp = jnp.pad(x, ((0, 0), (CONV_W - 1, 0), (0, 0)))
    out = b
    for j in range(CONV_W):
        out = out + xp[:, j:j + s] * w[j]
    return out


def block_diag_linear(x, w, b):
    xb = x.reshape(x.shape[0], x.shape[1], LRU_BLOCKS, LRU_BLOCK)
    return jnp.einsum('bsni,nij->bsnj', xb, w).reshape(x.shape) + b


def rglru(x, ga_w, ga_b, gx_w, gx_b, lam):
    xf = x.astype(jnp.float32)
    r = jax.nn.sigmoid(block_diag_linear(xf, ga_w.astype(jnp.float32), ga_b.astype(jnp.float32)))
    i = jax.nn.sigmoid(block_diag_linear(xf, gx_w.astype(jnp.float32), gx_b.astype(jnp.float32)))
    log_a = -LRU_C * r * jax.nn.softplus(-lam.astype(jnp.float32))
    a = jnp.exp(log_a)
    u = jnp.sqrt(-jnp.expm1(2.0 * log_a)) * (i * xf)

    def combine(c1, c2):
        a1, b1 = c1
        a2, b2 = c2
        return a1 * a2, a2 * b1 + b2

    _, h = lax.associative_scan(combine, (a, u), axis=1)
    return h


def fox_attention(q, k, v, log_f):
    bsz, s, h, dh = q.shape
    nb = s // Q_BLOCK
    c = jnp.cumsum(log_f, axis=1).transpose(0, 2, 1)
    qh = q.transpose(0, 2, 1, 3) * (dh ** -0.5)
    kh = k.transpose(0, 2, 1, 3)
    vh = v.transpose(0, 2, 1, 3)
    qb = qh.reshape(bsz, h, nb, Q_BLOCK, dh).transpose(2, 0, 1, 3, 4)
    cb = c.reshape(bsz, h, nb, Q_BLOCK).transpose(2, 0, 1, 3)
    pos_b = jnp.arange(s).reshape(nb, Q_BLOCK)
    k_pos = jnp.arange(s)

    def one_block(args):
        q_blk, c_blk, p_blk = args
        logits = jnp.einsum('bhqd,bhkd->bhqk', q_blk, kh).astype(jnp.float32)
        logits = logits + c_blk[..., None] - c[:, :, None, :]
        mask = p_blk[:, None] >= k_pos[None, :]
        logits = jnp.where(mask, logits, -jnp.inf)
        p = jax.nn.softmax(logits, axis=-1)
        return jnp.einsum('bhqk,bhkd->bhqd', p.astype(vh.dtype), vh)

    ob = lax.map(one_block, (qb, cb, pos_b))
    return ob.transpose(1, 0, 3, 2, 4).reshape(bsz, s, h * dh)


def gla_chunked(q, k, v, log_a):
    bsz, s, h, dk = q.shape
    dv = v.shape[-1]
    n = s // GLA_CHUNK

    def chunks(t):
        return t.reshape(bsz, n, GLA_CHUNK, h, t.shape[-1]).transpose(1, 0, 3, 2, 4)

    qc, kc, vc, gc = chunks(q), chunks(k), chunks(v), chunks(log_a)
    b = jnp.cumsum(gc, axis=3)
    b_last = b[:, :, :, -1:, :]
    q_dec = qc * jnp.exp(b)
    k_intra = kc * jnp.exp(-b)
    k_state = kc * jnp.exp(b_last - b)
    chunk_decay = jnp.exp(b_last[:, :, :, 0, :])
    causal = jnp.tril(jnp.ones((GLA_CHUNK, GLA_CHUNK), dtype=bool))
    scores = jnp.where(causal, jnp.einsum('nbhid,nbhjd->nbhij', q_dec, k_intra), 0.0)
    o_intra = jnp.einsum('nbhij,nbhje->nbhie', scores, vc)

    def step(state, xs):
        q_n, k_n, v_n, d_n = xs
        o_n = jnp.einsum('bhid,bhde->bhie', q_n, state)
        state = d_n[..., None] * state + jnp.einsum('bhjd,bhje->bhde', k_n, v_n)
        return state, o_n

    state0 = jnp.zeros((bsz, h, dk, dv), jnp.float32)
    _, o_inter = lax.scan(step, state0, (q_dec, k_state, vc, chunk_decay))
    o = o_intra + o_inter
    return o.transpose(1, 0, 3, 2, 4).reshape(bsz, s, h, dv)


def even_mixer(hn, w_in, conv_w, conv_b, ga_w, ga_b, gx_w, gx_b, lam, f_b, w_out):
    bsz, s, _ = hn.shape
    proj = hn @ w_in
    xr, yr, q, k, v, f_logit = jnp.split(proj, EVEN_SPLITS, axis=-1)
    xc = causal_depthwise_conv(xr, conv_w, conv_b)
    h_lru = rglru(xc, ga_w, ga_b, gx_w, gx_b, lam)
    y_a = (h_lru * jax.nn.gelu(yr.astype(jnp.float32))).astype(hn.dtype)
    log_f = jax.nn.log_sigmoid((f_logit + f_b).astype(jnp.float32))
    shp = (bsz, s, FOX_HEADS, FOX_HEAD_DIM)
    y_b = fox_attention(q.reshape(shp), k.reshape(shp), v.reshape(shp), log_f).astype(hn.dtype)
    return jnp.concatenate([y_a, y_b], axis=-1) @ w_out


def odd_mixer(hn, w_in, gate_w2, gate_b, head_norm, w_out):
    bsz, s, _ = hn.shape
    proj = hn @ w_in
    q, k, v, g, lr = jnp.split(proj, ODD_SPLITS, axis=-1)
    log_a = jax.nn.log_sigmoid((lr @ gate_w2 + gate_b).astype(jnp.float32)) / GLA_TAU
    kshp = (bsz, s, GLA_HEADS, GLA_DK)
    o = gla_chunked((q.astype(jnp.float32) * (GLA_DK ** -0.5)).reshape(kshp),
                    k.astype(jnp.float32).reshape(kshp),
                    v.astype(jnp.float32).reshape(bsz, s, GLA_HEADS, GLA_DV),
                    log_a.reshape(kshp))
    o = o * lax.rsqrt(jnp.mean(o * o, axis=-1, keepdims=True) + EPS)
    o = o * head_norm.astype(jnp.float32).reshape(GLA_HEADS, GLA_DV)
    o = o.reshape(bsz, s, GLA_VW) * jax.nn.silu(g.astype(jnp.float32))
    return o.astype(hn.dtype) @ w_out


def swiglu(hn, w1, w3, w2):
    return (jax.nn.silu(hn @ w1) * (hn @ w3)) @ w2


def moe_swiglu(hn, router, w1, w3, w2):
    bsz, s, d = hn.shape
    t = hn.reshape(-1, d)
    logits = (t @ router).astype(jnp.float32)
    top_vals, top_idx = lax.top_k(logits, TOP_K)
    top_w = jax.nn.softmax(top_vals, axis=-1)
    gates = jnp.sum(top_w[..., None] * jax.nn.one_hot(top_idx, N_EXPERTS, dtype=jnp.float32), axis=1)
    out = jnp.zeros_like(t)
    for e in range(N_EXPERTS):
        h_e = jax.nn.silu(t @ w1[e]) * (t @ w3[e])
        out = out + gates[:, e:e + 1].astype(t.dtype) * (h_e @ w2[e])
    return out.reshape(bsz, s, d)


def setup_inputs(seed: int = 0) -> dict:
    key = jax.random.key(seed)
    ks = iter(jax.random.split(key, 32))
    f32 = jnp.float32
    out_scale = (2.0 * DEPTH) ** -0.5

    def dense(shape, fan_in, scale=1.0):
        return jax.random.normal(next(ks), shape, f32) * (scale * fan_in ** -0.5)

    def gain(shape):
        return 1.0 + 0.02 * jax.random.normal(next(ks), shape, f32)

    def small(shape):
        return 0.02 * jax.random.normal(next(ks), shape, f32)

    x = jax.random.normal(next(ks), (BATCH, SEQ, D_MODEL), f32)
    norm_mix = gain((DEPTH, D_MODEL))
    norm_ffn = gain((DEPTH, D_MODEL))
    norm_final = gain((D_MODEL,))
    ev_w_in = dense((N_EVEN, D_MODEL, EVEN_IN), D_MODEL)
    ev_conv_w = dense((N_EVEN, CONV_W, LRU_WIDTH), CONV_W)
    ev_conv_b = small((N_EVEN, LRU_WIDTH))
    ev_ga_w = dense((N_EVEN, LRU_BLOCKS, LRU_BLOCK, LRU_BLOCK), LRU_BLOCK)
    ev_ga_b = small((N_EVEN, LRU_WIDTH))
    ev_gx_w = dense((N_EVEN, LRU_BLOCKS, LRU_BLOCK, LRU_BLOCK), LRU_BLOCK)
    ev_gx_b = small((N_EVEN, LRU_WIDTH))
    u = jax.random.uniform(next(ks), (N_EVEN, LRU_WIDTH), f32, minval=0.9, maxval=0.999)
    p = u ** (1.0 / LRU_C)
    ev_lambda = jnp.log(p) - jnp.log1p(-p)
    ev_f_b = 2.0 + 0.1 * jax.random.normal(next(ks), (N_EVEN, FOX_HEADS), f32)
    ev_w_out = dense((N_EVEN, D_MODEL, D_MODEL), D_MODEL, out_scale)
    ev_ffn_w1 = dense((N_EVEN, D_MODEL, D_FF), D_MODEL)
    ev_ffn_w3 = dense((N_EVEN, D_MODEL, D_FF), D_MODEL)
    ev_ffn_w2 = dense((N_EVEN, D_FF, D_MODEL), D_FF, out_scale)
    od_w_in = dense((N_ODD, D_MODEL, ODD_IN), D_MODEL)
    od_gate_w2 = dense((N_ODD, GLA_RANK, GLA_KW), GLA_RANK)
    od_gate_b = small((N_ODD, GLA_KW))
    od_head_norm = gain((N_ODD, GLA_VW))
    od_w_out = dense((N_ODD, GLA_VW, D_MODEL), GLA_VW, out_scale)
    od_router = dense((N_ODD, D_MODEL, N_EXPERTS), D_MODEL)
    od_exp_w1 = dense((N_ODD, N_EXPERTS, D_MODEL, D_FF_EXPERT), D_MODEL)
    od_exp_w3 = dense((N_ODD, N_EXPERTS, D_MODEL, D_FF_EXPERT), D_MODEL)
    od_exp_w2 = dense((N_ODD, N_EXPERTS, D_FF_EXPERT, D_MODEL), D_FF_EXPERT, out_scale)
    return {"x": x, "norm_mix": norm_mix, "norm_ffn": norm_ffn, "norm_final": norm_final,
            "ev_w_in": ev_w_in, "ev_conv_w": ev_conv_w, "ev_conv_b": ev_conv_b,
            "ev_ga_w": ev_ga_w, "ev_ga_b": ev_ga_b, "ev_gx_w": ev_gx_w, "ev_gx_b": ev_gx_b,
            "ev_lambda": ev_lambda, "ev_f_b": ev_f_b, "ev_w_out": ev_w_out,
            "ev_ffn_w1": ev_ffn_w1, "ev_ffn_w3": ev_ffn_w3, "ev_ffn_w2": ev_ffn_w2,
            "od_w_in": od_w_in, "od_gate_w2": od_gate_w2, "od_gate_b": od_gate_b,
            "od_head_norm": od_head_norm, "od_w_out": od_w_out, "od_router": od_router,
            "od_exp_w1": od_exp_w1, "od_exp_w3": od_exp_w3, "od_exp_w2": od_exp_w2}


def reference(x, norm_mix, norm_ffn, norm_final,
              ev_w_in, ev_conv_w, ev_conv_b, ev_ga_w, ev_ga_b, ev_gx_w, ev_gx_b,
              ev_lambda, ev_f_b, ev_w_out, ev_ffn_w1, ev_ffn_w3, ev_ffn_w2,
              od_w_in, od_gate_w2, od_gate_b, od_head_norm, od_w_out, od_router,
              od_exp_w1, od_exp_w3, od_exp_w2):
    h = x
    for layer in range(DEPTH):
        j = layer // 2
        hn = rms_norm(h, norm_mix[layer])
        if layer % 2 == 0:
            h = h + even_mixer(hn, ev_w_in[j], ev_conv_w[j], ev_conv_b[j], ev_ga_w[j], ev_ga_b[j],
                               ev_gx_w[j], ev_gx_b[j], ev_lambda[j], ev_f_b[j], ev_w_out[j])
            h = h + swiglu(rms_norm(h, norm_ffn[layer]), ev_ffn_w1[j], ev_ffn_w3[j], ev_ffn_w2[j])
        else:
            h = h + odd_mixer(hn, od_w_in[j], od_gate_w2[j], od_gate_b[j], od_head_norm[j], od_w_out[j])
            h = h + moe_swiglu(rms_norm(h, norm_ffn[layer]), od_router[j], od_exp_w1[j],
                               od_exp_w3[j], od_exp_w2[j])
    return rms_norm(h, norm_final)
```

```cpp
#include <hip/hip_runtime.h>
#include <cstdio>
#include <cstdint>
#include <hip/hip_bf16.h>
#include <cmath>
#ifndef BUILD_MODE
#define BUILD_MODE 0
#endif
#define GAS __attribute__((address_space(1)))
#define LAS __attribute__((address_space(3)))
typedef unsigned short bf16_t;
typedef short bf16x8 __attribute__((ext_vector_type(8)));
typedef short s16x4 __attribute__((ext_vector_type(4)));
typedef float f32x4 __attribute__((ext_vector_type(4)));
typedef float f32x2 __attribute__((ext_vector_type(2)));
typedef float f32x16 __attribute__((ext_vector_type(16)));
typedef unsigned u32x4 __attribute__((ext_vector_type(4)));
typedef unsigned u32x2 __attribute__((ext_vector_type(2)));
typedef GAS unsigned gu32;
#define RLX_AGENT __ATOMIC_RELAXED, __HIP_MEMORY_SCOPE_AGENT
#define LDS_WAIT() asm volatile("s_waitcnt lgkmcnt(0)" ::: "memory")
#define VM_WAIT() asm volatile("s_waitcnt vmcnt(0)" ::: "memory")
__device__ __forceinline__ unsigned cvt_pk_bf16(float lo, float hi) { unsigned r; asm volatile("v_cvt_pk_bf16_f32 %0, %1, %2" : "=v"(r) : "v"(lo), "v"(hi)); return r; }
__device__ __forceinline__ float bf2f(bf16_t v) { return __uint_as_float(((unsigned)v) << 16); }
__device__ __forceinline__ float bflo(unsigned w) { return __uint_as_float(w << 16); }
__device__ __forceinline__ float bfhi(unsigned w) { return __uint_as_float(w & 0xffff0000u); }
__device__ __forceinline__ float wave_sum(float v) {
#pragma unroll
    for (int o = 1; o < 64; o <<= 1) v += __shfl_xor(v, o);
    return v;
}
__device__ __forceinline__ float fast_exp(float x) { return __builtin_amdgcn_exp2f(x * 1.4426950408889634f); }
__device__ __forceinline__ float fast_sigm(float x) { return __builtin_amdgcn_rcpf(1.f + __builtin_amdgcn_exp2f(-x * 1.4426950408889634f)); }
__device__ __forceinline__ float fast_silu(float x) { return x * fast_sigm(x); }

#define XB_TMO      128
#define XB_XCNT(j)  (256  + 64 * (j))
#define XB_XSUB(j)  (1280 + 64 * (j))
#define XB_XGEN(j)  (2304 + 64 * (j))
#define XB_TOP      3328
#define XB_TOPGEN   3392
#define XCD_BAR_WORDS 3456
#define XB_SPIN_CAP (1u << 18)

__device__ __forceinline__ unsigned xb_ld(unsigned* p)              { return __hip_atomic_load(p, __ATOMIC_RELAXED, __HIP_MEMORY_SCOPE_AGENT); }
__device__ __forceinline__ unsigned xb_add(unsigned* p, unsigned v) { return __hip_atomic_fetch_add(p, v, __ATOMIC_RELAXED, __HIP_MEMORY_SCOPE_AGENT); }
__device__ __forceinline__ unsigned xb_xcc_id() { return (unsigned)__builtin_amdgcn_s_getreg((3 << 11) | 20) & 0xFu; }
#define XB_SPIN(cond, bar) do { unsigned _sp = 0; while (cond) { __builtin_amdgcn_s_sleep(1); \
    if ((++_sp & 255u) == 0u) { if (xb_ld(&(bar)[XB_TMO])) break; if (_sp > XB_SPIN_CAP) { atomicAdd(&(bar)[XB_TMO], 1u); break; } } } } while (0)

struct XcdBarrier {
    unsigned* bar; unsigned x;
    volatile LAS unsigned* st;
};
__device__ __forceinline__ XcdBarrier xcd_barrier_post(unsigned* bar, volatile LAS unsigned* st) {
    XcdBarrier b; b.bar = bar; b.x = xb_xcc_id(); b.st = st;
    if (threadIdx.x == 0) (void)xb_add(&bar[XB_XCNT(b.x)], 1u);
    return b;
}
__device__ __forceinline__ void xcd_barrier_complete(unsigned* bar, unsigned x, unsigned& nloc, unsigned& nx) {
    const unsigned G = gridDim.x * gridDim.y * gridDim.z;
    unsigned sum, cnt, mine, sp = 0u;
    for (;;) {
        sum = 0u; cnt = 0u; mine = 0u;
#pragma unroll
        for (unsigned j = 0; j < 16; ++j) { const unsigned c = xb_ld(&bar[XB_XCNT(j)]); sum += c; cnt += (c > 0u) ? 1u : 0u; mine = (j == x) ? c : mine; }
        if (sum == G) break;
        __builtin_amdgcn_s_sleep(1);
        if ((++sp & 255u) == 0u) { if (xb_ld(&bar[XB_TMO])) break; if (sp > XB_SPIN_CAP) { atomicAdd(&bar[XB_TMO], 1u); break; } }
    }
    nloc = mine > 0u ? mine : 1u; nx = cnt > 0u ? cnt : 1u;
}
__device__ __forceinline__ void xcd_barrier(const XcdBarrier& b) {
    asm volatile("s_waitcnt vmcnt(0)" ::: "memory");
    __syncthreads();
    if (threadIdx.x == 0) {
        unsigned* bar = b.bar;
        __builtin_amdgcn_s_waitcnt(0);
        unsigned nloc = b.st[0], nx = b.st[1];
        if (nloc == 0u) { xcd_barrier_complete(bar, b.x, nloc, nx); b.st[0] = nloc; b.st[1] = nx; }
        const unsigned old = xb_add(&bar[XB_XSUB(b.x)], 1u);
        const unsigned gen = old / nloc;
        if (old + 1u == (gen + 1u) * nloc) {
            __builtin_amdgcn_fence(__ATOMIC_RELEASE, "agent");
            asm volatile("s_waitcnt vmcnt(0)" ::: "memory");
            const unsigned og = xb_add(&bar[XB_TOP], 1u);
            const unsigned tg = og / nx;
            if (og + 1u == (tg + 1u) * nx) xb_add(&bar[XB_TOPGEN], 1u);
            else XB_SPIN(xb_ld(&bar[XB_TOPGEN]) == tg, bar);
            __builtin_amdgcn_fence(__ATOMIC_ACQUIRE, "agent");
            xb_add(&bar[XB_XGEN(b.x)], 1u);
            asm volatile("s_waitcnt vmcnt(0)" ::: "memory");
        } else {
            XB_SPIN(xb_ld(&bar[XB_XGEN(b.x)]) == gen, bar);
            __builtin_amdgcn_fence(__ATOMIC_ACQUIRE, "agent");
            asm volatile("s_waitcnt vmcnt(0)" ::: "memory");
        }
    }
    __syncthreads();
}

namespace pg8 {
constexpr int BM = 256, BK = 64, HALF = 128, HTB = HALF * BK * 2  , STAGE_BYTES = 8 * HTB, NXCD = 8, WGM = 8;
__host__ __device__ __forceinline__ int lds_byte(int r, int c) { const int st = (r >> 4) * 2 + (c >> 5), rr = r & 15, cc = c & 31, ob = rr * 64 + cc * 2; return st * 1024 + (ob ^ (((ob >> 9) & 1) << 5)); }
__host__ __device__ __forceinline__ void stage_rc(int b, int& R, int& C) { const int st = b / 1024, sb = b % 1024, swz = sb ^ (((sb >> 9) & 1) << 5); R = (st >> 1) * 16 + swz / 64; C = (st & 1) * 32 + (swz % 64) / 2; }
__host__ __device__ __forceinline__ int perm32(int rho) { const int n = rho >> 4, i = rho & 15; return 8 * (i >> 2) + 4 * n + (i & 3); }

struct Unit { int pm, pn; };
__device__ __forceinline__ bool static_unit(int i, int G, int c, int nM, int nN, Unit& u) {
    const int nwg = nM * nN; const long L = (long)i * G + c; if (L >= nwg) return false;
    int wgid = (int)L; { const int q = nwg / NXCD, r = nwg % NXCD, xcd = wgid % NXCD, off = wgid / NXCD; wgid = (xcd < r ? xcd * (q + 1) : r * (q + 1) + (xcd - r) * q) + off; }
    const int nig = WGM * nN, gid = wgid / nig, fm = gid * WGM, gsz = (nM - fm) < WGM ? (nM - fm) : WGM;
    u.pm = fm + ((wgid % nig) % gsz); u.pn = (wgid % nig) / gsz; return true;
}
struct DenseSched {
    static constexpr bool GATHER = false;
    const char* A; const char* Bt; int nM, nN, G, c; size_t tstep;
    __device__ __forceinline__ void init(const void* A_, const void* Bt_, int M, int N, int K, int G_, int c_, int es = 2) { A = (const char*)A_; Bt = (const char*)Bt_; nM = M / BM; nN = N / BM; G = G_; c = c_; tstep = (size_t)BM * K * es; }
    __device__ __forceinline__ bool next(int i, Unit& u) const { return static_unit(i, G, c, nM, nN, u); }
    __device__ __forceinline__ const char* a_base(const Unit& u) const { return A + (size_t)u.pm * tstep; }
    __device__ __forceinline__ const char* b_base(const Unit& u) const { return Bt + (size_t)u.pn * tstep; }
    __device__ __forceinline__ void rows(const Unit&, const int (&)[2], int, unsigned (&)[2][2]) const {}
};
template <bool GATH> struct MoeSched {
    static constexpr bool GATHER = GATH;
    const char* A; const char* Bt; int nM, nN, G, c; size_t tstepA, tstepB, estride; int K2;
    int ncol; size_t ksoff;
    const LAS int* tab;
    const int* TL;
    const LAS unsigned* rowtab;
    __device__ __forceinline__ int expert(int pm) const { int e = 0;
#pragma unroll
        for (int k = 1; k < 8; ++k) e += (pm >= tab[k]) ? 1 : 0; return e; }
    __device__ __forceinline__ bool next(int i, Unit& u) const { return static_unit(i, G, c, nM, nN, u); }
    __device__ __forceinline__ const char* a_base(const Unit& u) const { return GATH ? A : A + (size_t)u.pm * tstepA + (size_t)(u.pn / ncol) * ksoff; }
    __device__ __forceinline__ const char* b_base(const Unit& u) const { return Bt + (size_t)__builtin_amdgcn_readfirstlane(expert(u.pm)) * estride + (size_t)(u.pn % ncol) * tstepB + (size_t)(u.pn / ncol) * ksoff; }
    __device__ __forceinline__ void rows(const Unit&, const int (&R)[2], int ord, unsigned (&v)[2][2]) const {
        if constexpr (GATH) {
#pragma unroll
            for (int h = 0; h < 2; ++h)
#pragma unroll
                for (int i = 0; i < 2; ++i) v[h][i] = rowtab[ord * 256 + h * 128 + R[i]];
        }
    }
    __device__ __forceinline__ void fill_rows(LAS unsigned* tabw) const {
        if constexpr (GATH) { Unit u;
            for (int i = 0; next(i, u); ++i) { if (threadIdx.x < 256) { const int e = expert(u.pm); const int pe = tab[e], ce = tab[16 + e]; int pos = (u.pm - pe) * 256 + (int)threadIdx.x; pos = pos < ce ? pos : ce - 1;
                    tabw[i * 256 + threadIdx.x] = (unsigned)TL[e * 16384 + pos] * (unsigned)K2; } }
            __syncthreads(); }
    }
};

constexpr float RMS_EPS = 1e-6f;
struct SumSq { const float* f; const unsigned long long* q; };
__device__ __forceinline__ float ss_value(const SumSq& s, int row) { return s.q ? (float)((double)s.q[row] * (1.0 / 4294967296.0)) : s.f[row]; }
__device__ __forceinline__ float inv_rms(const SumSq& s, int row) { return (s.f || s.q) ? 1.0f / sqrtf(ss_value(s, row) * (1.0f / 1024.0f) + RMS_EPS) : 1.0f; }

template <int MODE> struct EpiProj {
    static constexpr bool PERM = true, AFTER_DRAIN = false;
    SumSq ss; bf16_t* p0; int ld0; float qscale; bf16_t* p1;
    __device__ __forceinline__ void operator()(const f32x4 (&acc)[2][2][4][2], const Unit& u, int wr, int wc, int fr, int fq) const {
        bf16_t* base; int ldc, colt; float scl = 1.f;
        if constexpr (MODE == 0) { const int t = u.pn >> 1; base = p0 + (size_t)t * (8u << 20); ldc = 512; colt = (u.pn & 1) * BM; scl = (t == 2) ? qscale : 1.f; }
        else if constexpr (MODE == 1) { if (u.pn < 4) { base = p0 + (size_t)(u.pn >> 1) * (8u << 20); ldc = 512; colt = (u.pn & 1) * BM; }
                                        else { const int q = u.pn - 4; base = p0 + (size_t)(16u << 20) + (size_t)(q >> 2) * (16u << 20); ldc = 1024; colt = (q & 3) * BM; } }
        else if constexpr (MODE == 3) { base = (u.pn >> 2) ? p1 : p0; ldc = ld0; colt = (u.pn & 3) * BM; }
        else { base = p0; ldc = ld0; colt = u.pn * BM; }
        const int row0 = u.pm * BM + wr * 64 + fr, col0 = colt + wc * 32 + 8 * fq;
#pragma unroll
        for (int ai = 0; ai < 2; ++ai)
#pragma unroll
            for (int m = 0; m < 4; ++m) { const int row = row0 + ai * HALF + m * 16; const float s = inv_rms(ss, row) * scl; bf16_t* rowp = base + (size_t)row * ldc + col0;
#pragma unroll
                for (int bj = 0; bj < 2; ++bj) { const f32x4 v0 = acc[ai][bj][m][0] * s, v1 = acc[ai][bj][m][1] * s;
                    u32x4 w; w.x = cvt_pk_bf16(v0[0], v0[1]); w.y = cvt_pk_bf16(v0[2], v0[3]); w.z = cvt_pk_bf16(v1[0], v1[1]); w.w = cvt_pk_bf16(v1[2], v1[3]);
                    *(u32x4*)(rowp + bj * HALF) = w; } }
    }
};
__device__ __forceinline__ unsigned pk4_fp8(float a, float b, float c, float d) { int w = __builtin_amdgcn_cvt_pk_fp8_f32(a, b, 0, false); w = __builtin_amdgcn_cvt_pk_fp8_f32(c, d, w, true); return (unsigned)w; }
template <bool F8> struct EpiGluT {
    static constexpr bool PERM = true, AFTER_DRAIN = false;
    SumSq ss; void* O; int ldc;
    __device__ __forceinline__ void operator()(const f32x4 (&acc)[2][2][4][2], const Unit& u, int wr, int wc, int fr, int fq) const {
        const int row0 = u.pm * BM + wr * 64 + fr, col0 = u.pn * HALF + wc * 32 + 8 * fq;
#pragma unroll
        for (int ai = 0; ai < 2; ++ai)
#pragma unroll
            for (int m = 0; m < 4; ++m) { const int row = row0 + ai * HALF + m * 16; const float s = inv_rms(ss, row);
                float o[8];
#pragma unroll
                for (int n = 0; n < 2; ++n)
#pragma unroll
                    for (int q = 0; q < 4; ++q) { const float a = acc[ai][0][m][n][q] * s, b = acc[ai][1][m][n][q] * s; o[n * 4 + q] = fast_silu(a) * b; }
                if constexpr (F8) { u32x2 w; w.x = pk4_fp8(o[0], o[1], o[2], o[3]); w.y = pk4_fp8(o[4], o[5], o[6], o[7]); *(u32x2*)((unsigned char*)O + (size_t)row * ldc + col0) = w; }
                else { u32x4 w; w.x = cvt_pk_bf16(o[0], o[1]); w.y = cvt_pk_bf16(o[2], o[3]); w.z = cvt_pk_bf16(o[4], o[5]); w.w = cvt_pk_bf16(o[6], o[7]); *(u32x4*)((bf16_t*)O + (size_t)row * ldc + col0) = w; } }
    }
};
typedef EpiGluT<false> EpiGlu;
struct EpiRes {
    static constexpr bool PERM = false, AFTER_DRAIN = false;
    const float* base; float* out; bf16_t* outb; unsigned long long* ss; unsigned char* outq;
    __device__ __forceinline__ void operator()(const f32x4 (&acc)[2][2][4][2], const Unit& u, int wr, int wc, int fr, int fq) const {
        const int row0 = u.pm * BM + wr * 64 + fr, col0 = u.pn * BM + wc * 32 + 4 * fq;
#pragma unroll
        for (int ai = 0; ai < 2; ++ai)
#pragma unroll
            for (int m = 0; m < 4; ++m) { const int row = row0 + ai * HALF + m * 16; const size_t off = (size_t)row * 1024 + col0; float rs = 0.f;
#pragma unroll
                for (int bj = 0; bj < 2; ++bj)
#pragma unroll
                    for (int n = 0; n < 2; ++n) { const size_t o2 = off + bj * HALF + n * 16; const f32x4 r = *(const f32x4*)(base + o2) + acc[ai][bj][m][n];
                        *(f32x4*)(out + o2) = r; rs += (r[0] * r[0] + r[1] * r[1]) + (r[2] * r[2] + r[3] * r[3]);
                        if (outb) { u32x2 w; w.x = cvt_pk_bf16(r[0], r[1]); w.y = cvt_pk_bf16(r[2], r[3]); *(u32x2*)(outb + o2) = w; }
                        if (outq) *(unsigned*)(outq + o2) = pk4_fp8(r[0], r[1], r[2], r[3]); }
                if (ss) { rs += __shfl_xor(rs, 16); rs += __shfl_xor(rs, 32); if (fq == 0) __hip_atomic_fetch_add(ss + row, (unsigned long long)(rs * 4294967296.0f), __ATOMIC_RELAXED, __HIP_MEMORY_SCOPE_AGENT); }
                if (m & 1) asm volatile("" ::: "memory"); }
    }
};

typedef int i32x8 __attribute__((ext_vector_type(8)));
typedef int i32x4 __attribute__((ext_vector_type(4)));
template <class Epi, class Sched, bool ALIGN_EPI, bool SP2, int ES = 2>
__device__ __forceinline__ void gemm_phase(LAS unsigned char* lds, const int K, const int LD, const Sched& S, const Epi& E, const int wscale = 0x7f7f7f7f) {
    int tid_ = threadIdx.x; asm volatile("" : "+v"(tid_));
    const int tid = tid_, wid = __builtin_amdgcn_readfirstlane(tid >> 6), lane = tid & 63, wr = wid >> 2, wc = wid & 3, fr = lane & 15, fq = lane >> 4;
    const int nt = K * ES / (BK * 2);
    constexpr bool GATH = Sched::GATHER;
    const size_t kstep = (size_t)(BK * 2);
    const size_t hstep = (size_t)HALF * LD * ES;
    unsigned voffB[2]; unsigned vA[2][2], vAn[2][2]; int RA[2]; unsigned CA2[2];
#pragma unroll
    for (int i = 0; i < 2; ++i) { int R, C; stage_rc(tid * 16 + i * 8192, R, C); const int Rb = Epi::PERM ? ((R & ~31) + perm32(R & 31)) : R;
        RA[i] = R; CA2[i] = (unsigned)C * 2u; voffB[i] = (unsigned)(Rb * LD * ES + C * 2);
        vA[0][i] = (unsigned)(R * LD * ES + C * 2); vA[1][i] = vA[0][i] + (unsigned)hstep; vAn[0][i] = vA[0][i]; vAn[1][i] = vA[1][i]; }
    const unsigned ldsw = (unsigned)wid * 1024u;
    int aoffk[2], boffk[2];
#pragma unroll
    for (int k = 0; k < 2; ++k) { aoffk[k] = lds_byte(wr * 64 + fr, 32 * k + 8 * fq); boffk[k] = lds_byte(wc * 32 + fr, 32 * k + 8 * fq); }
#define PG8_SA(b, h) (((b) * 2 + (h)) * HTB)
#define PG8_SB(b, h) ((4 + (b) * 2 + (h)) * HTB)
#define PG8_STAGE2(bufoff, gbase, o0, o1) do { \
        __builtin_amdgcn_global_load_lds((const unsigned*)((const char*)(gbase) + (o0)), (LAS unsigned*)(lds + (bufoff) + ldsw), 16, 0, 0); \
        __builtin_amdgcn_global_load_lds((const unsigned*)((const char*)(gbase) + (o1)), (LAS unsigned*)(lds + (bufoff) + ldsw + 8192), 16, 0, 0); } while (0)
#define PG8_STAGEB(bufoff, gbase) PG8_STAGE2(bufoff, gbase, voffB[0], voffB[1])
#define PG8_STAGEA(bufoff, gbase, h) PG8_STAGE2(bufoff, gbase, vA[h][0], vA[h][1])
#define PG8_STAGEAX(bufoff, gbase, h, nx) PG8_STAGE2(bufoff, gbase, ((nx) ? vAn[h][0] : vA[h][0]), ((nx) ? vAn[h][1] : vA[h][1]))
#define PG8_LDA(dst, b, h) do { _Pragma("unroll") for (int m = 0; m < 4; ++m) { const i32x4 l_ = *(const LAS i32x4*)(lds + PG8_SA(b, h) + aoffk[0] + m * 2048), h_ = *(const LAS i32x4*)(lds + PG8_SA(b, h) + aoffk[1] + m * 2048); dst##8[m] = __builtin_shufflevector(l_, h_, 0, 1, 2, 3, 4, 5, 6, 7); } } while (0)
#define PG8_LDB(dst, b, h) do { _Pragma("unroll") for (int n = 0; n < 2; ++n) { const i32x4 l_ = *(const LAS i32x4*)(lds + PG8_SB(b, h) + boffk[0] + n * 2048), h_ = *(const LAS i32x4*)(lds + PG8_SB(b, h) + boffk[1] + n * 2048); dst##8[n] = __builtin_shufflevector(l_, h_, 0, 1, 2, 3, 4, 5, 6, 7); } } while (0)
#define PG8_MMA(ai, bj, At, Bt) do { __builtin_amdgcn_s_setprio(1); _Pragma("unroll") for (int m = 0; m < 4; ++m) _Pragma("unroll") for (int n = 0; n < 2; ++n) { \
        if constexpr (ES == 2) { \
            acc[ai][bj][m][n] = __builtin_amdgcn_mfma_f32_16x16x32_bf16(__builtin_bit_cast(bf16x8, __builtin_shufflevector(Bt##8[n], Bt##8[n], 0, 1, 2, 3)), __builtin_bit_cast(bf16x8, __builtin_shufflevector(At##8[m], At##8[m], 0, 1, 2, 3)), acc[ai][bj][m][n], 0, 0, 0); \
            acc[ai][bj][m][n] = __builtin_amdgcn_mfma_f32_16x16x32_bf16(__builtin_bit_cast(bf16x8, __builtin_shufflevector(Bt##8[n], Bt##8[n], 4, 5, 6, 7)), __builtin_bit_cast(bf16x8, __builtin_shufflevector(At##8[m], At##8[m], 4, 5, 6, 7)), acc[ai][bj][m][n], 0, 0, 0); } \
        else { asm volatile("v_mfma_scale_f32_16x16x128_f8f6f4 %0, %1, %2, %0, %3, %4 op_sel_hi:[0,0,0]" : "+v"(acc[ai][bj][m][n]) : "v"(Bt##8[n]), "v"(At##8[m]), "v"(wsc_), "v"(one_)); } } \
        __builtin_amdgcn_s_setprio(0); } while (0)
#define PG8_WAIT_V(n) asm volatile("s_waitcnt vmcnt(" #n ")" ::: "memory")
#define PG8_WAIT_L(n) asm volatile("s_waitcnt lgkmcnt(" #n ")" ::: "memory")
#define PG8_BAR __builtin_amdgcn_s_barrier()
#define PG8_SCHED __builtin_amdgcn_sched_barrier(0)
    Unit cur, nxt; int ui = 0;
    if (!S.next(0, cur)) return;
    f32x4 acc[2][2][4][2];
#pragma unroll
    for (int a = 0; a < 2; ++a)
#pragma unroll
        for (int b = 0; b < 2; ++b)
#pragma unroll
            for (int m = 0; m < 4; ++m)
#pragma unroll
                for (int n = 0; n < 2; ++n) { acc[a][b][m][n] = (f32x4){0.f, 0.f, 0.f, 0.f}; if constexpr (ES == 1) asm volatile("" : "+v"(acc[a][b][m][n])); }
    int wsc_ = wscale, one_ = 0x7f7f7f7f; asm volatile("" : "+v"(wsc_), "+v"(one_));
    i32x8 At8[4], B08[2], B18[2];
    const char* cA = S.a_base(cur); const char* cB = S.b_base(cur);
    if constexpr (GATH) { S.rows(cur, RA, 0, vA);
#pragma unroll
        for (int h = 0; h < 2; ++h)
#pragma unroll
            for (int i = 0; i < 2; ++i) vA[h][i] += CA2[i]; }
    if constexpr (SP2) {
        PG8_STAGEB(PG8_SB(0, 0), cB); PG8_STAGEB(PG8_SB(0, 1), cB + hstep); PG8_STAGEA(PG8_SA(0, 0), cA, 0); PG8_STAGEA(PG8_SA(0, 1), cA, 1);
        if (wr == 1) PG8_BAR;
        PG8_WAIT_V(2); PG8_BAR;
        PG8_STAGEB(PG8_SB(1, 0), cB + kstep); PG8_STAGEA(PG8_SA(1, 0), cA + kstep, 0); PG8_STAGEB(PG8_SB(1, 1), cB + hstep + kstep);
        PG8_WAIT_V(6); PG8_BAR;
    } else {
        PG8_STAGEB(PG8_SB(0, 0), cB); PG8_STAGEA(PG8_SA(0, 0), cA, 0); PG8_STAGEB(PG8_SB(0, 1), cB + hstep); PG8_STAGEA(PG8_SA(0, 1), cA, 1);
        if (wr == 1) PG8_BAR;
        PG8_WAIT_V(4); PG8_BAR;
        PG8_STAGEB(PG8_SB(1, 0), cB + kstep); PG8_STAGEA(PG8_SA(1, 0), cA + kstep, 0); PG8_STAGEB(PG8_SB(1, 1), cB + hstep + kstep);
        PG8_WAIT_V(6); PG8_BAR;
    }
    for (;;) {
        const bool has_next = S.next(ui + 1, nxt);
        const char* nA = has_next ? S.a_base(nxt) : cA; const char* nB = has_next ? S.b_base(nxt) : cB;
        if constexpr (GATH) { if (has_next) { S.rows(nxt, RA, ui + 1, vAn);
#pragma unroll
                for (int h = 0; h < 2; ++h)
#pragma unroll
                    for (int i = 0; i < 2; ++i) vAn[h][i] += CA2[i]; } else {
#pragma unroll
                for (int h = 0; h < 2; ++h)
#pragma unroll
                    for (int i = 0; i < 2; ++i) vAn[h][i] = vA[h][i]; } }
        for (int t = 0; t < nt; t += 2) {
            const bool last = (t == nt - 2);
            const char* a1 = cA + (size_t)(t + 1) * kstep;
            const char* a2 = last ? nA : cA + (size_t)(t + 2) * kstep; const char* b2 = last ? nB : cB + (size_t)(t + 2) * kstep;
            const char* a3 = a2 + kstep; const char* b3 = b2 + kstep;
            const bool nx = GATH && last;
            if constexpr (SP2) {
            PG8_LDB(B0, 0, 0); PG8_LDB(B1, 0, 1); PG8_SCHED; PG8_LDA(At, 0, 0); PG8_STAGEA(PG8_SA(1, 1), a1, 1);
            PG8_WAIT_V(8); PG8_WAIT_L(0); PG8_BAR; PG8_MMA(0, 0, At, B0); PG8_MMA(0, 1, At, B1); PG8_BAR; PG8_SCHED;
            PG8_LDA(At, 0, 1); PG8_STAGEB(PG8_SB(0, 0), b2); PG8_STAGEB(PG8_SB(0, 1), b2 + hstep); PG8_STAGEAX(PG8_SA(0, 0), a2, 0, nx);
            PG8_WAIT_V(8); PG8_WAIT_L(0); PG8_BAR; PG8_MMA(1, 0, At, B0); PG8_MMA(1, 1, At, B1); PG8_BAR; PG8_SCHED;
            PG8_LDB(B0, 1, 0); PG8_LDB(B1, 1, 1); PG8_SCHED; PG8_LDA(At, 1, 0); PG8_STAGEAX(PG8_SA(0, 1), a2, 1, nx);
            PG8_WAIT_V(8); PG8_WAIT_L(0); PG8_BAR; PG8_MMA(0, 0, At, B0); PG8_MMA(0, 1, At, B1); PG8_BAR; PG8_SCHED;
            PG8_LDA(At, 1, 1); PG8_STAGEB(PG8_SB(1, 0), b3); PG8_STAGEB(PG8_SB(1, 1), b3 + hstep); PG8_STAGEAX(PG8_SA(1, 0), a3, 0, nx);
            PG8_WAIT_V(8); PG8_WAIT_L(0); PG8_BAR; PG8_MMA(1, 0, At, B0); PG8_MMA(1, 1, At, B1); PG8_BAR; PG8_SCHED;
            } else {
            PG8_LDB(B0, 0, 0); PG8_SCHED; PG8_LDA(At, 0, 0); PG8_STAGEA(PG8_SA(1, 1), a1, 1);
            PG8_WAIT_L(8); PG8_BAR; PG8_WAIT_L(0); PG8_MMA(0, 0, At, B0); PG8_BAR; PG8_SCHED;
            PG8_LDB(B1, 0, 1); PG8_STAGEB(PG8_SB(0, 0), b2);
            PG8_BAR; PG8_WAIT_L(0); PG8_MMA(0, 1, At, B1); PG8_BAR;
            PG8_LDA(At, 0, 1); PG8_STAGEAX(PG8_SA(0, 0), a2, 0, nx);
            PG8_BAR; PG8_WAIT_L(0); PG8_MMA(1, 0, At, B0); PG8_BAR; PG8_SCHED;
            PG8_STAGEB(PG8_SB(0, 1), b2 + hstep);
            PG8_WAIT_V(6); PG8_BAR; PG8_MMA(1, 1, At, B1); PG8_BAR;
            PG8_LDB(B0, 1, 0); PG8_SCHED; PG8_LDA(At, 1, 0); PG8_STAGEAX(PG8_SA(0, 1), a2, 1, nx);
            PG8_WAIT_L(8); PG8_BAR; PG8_WAIT_L(0); PG8_MMA(0, 0, At, B0); PG8_BAR; PG8_SCHED;
            PG8_LDB(B1, 1, 1); PG8_STAGEB(PG8_SB(1, 0), b3);
            PG8_BAR; PG8_WAIT_L(0); PG8_MMA(0, 1, At, B1); PG8_BAR;
            PG8_LDA(At, 1, 1); PG8_STAGEAX(PG8_SA(1, 0), a3, 0, nx);
            PG8_BAR; PG8_WAIT_L(0); PG8_MMA(1, 0, At, B0); PG8_BAR; PG8_SCHED;
            PG8_STAGEB(PG8_SB(1, 1), b3 + hstep);
            PG8_WAIT_V(6); PG8_BAR; PG8_MMA(1, 1, At, B1); PG8_BAR;
            }
        }
        if constexpr (ALIGN_EPI) { if (wr == 0) PG8_BAR; }
        if constexpr (ES == 1) asm volatile("s_nop 15\n\ts_nop 15" ::: "memory");
        E(acc, cur, wr, wc, fr, fq);
        if (!has_next) break;
#pragma unroll
        for (int a = 0; a < 2; ++a)
#pragma unroll
            for (int b = 0; b < 2; ++b)
#pragma unroll
                for (int m = 0; m < 4; ++m)
#pragma unroll
                    for (int n = 0; n < 2; ++n) { acc[a][b][m][n] = (f32x4){0.f, 0.f, 0.f, 0.f}; if constexpr (ES == 1) asm volatile("" : "+v"(acc[a][b][m][n])); }
        cur = nxt; cA = nA; cB = nB; ++ui;
        if constexpr (GATH) {
#pragma unroll
            for (int h = 0; h < 2; ++h)
#pragma unroll
                for (int i = 0; i < 2; ++i) vA[h][i] = vAn[h][i]; }
        if constexpr (ALIGN_EPI) { if (wr == 1) PG8_BAR; }
    }
    PG8_WAIT_V(0);
    if constexpr (!ALIGN_EPI) { if (wr == 0) PG8_BAR; }
    PG8_BAR;
#undef PG8_SA
#undef PG8_SB
#undef PG8_STAGE2
#undef PG8_STAGEA
#undef PG8_STAGEAX
#undef PG8_STAGEB
#undef PG8_LDA
#undef PG8_LDB
#undef PG8_MMA
#undef PG8_WAIT_V
#undef PG8_WAIT_L
#undef PG8_BAR
#undef PG8_SCHED
}
}
#ifndef FFN_UP_FP8
#define FFN_UP_FP8 0
#endif
namespace fk {
constexpr int NWAVES = 8, NTHR = 512;
constexpr int T = 16384, D = 1024, SEQ = 4096, NBATCH = 4;
constexpr int EIN = 2568, OIN = 3088, DFF = 2816, DFE = 3584, NE = 8;
constexpr float EPS = 1e-6f;
constexpr float LOG2E = 1.4426950408889634f;
constexpr float C2 = 0.125f * LOG2E;
constexpr float GLA_QS = 0.08838834764831845f;

constexpr size_t MiB = 1u << 20;
constexpr size_t WS_CTL = 0, CTL_ZERO_BYTES = 2 * MiB;
constexpr int CW_TMO = 0, CW_CODE = 1;
constexpr int CW_BAR = 4096;
constexpr int CW_CNT = 8192;
constexpr size_t CTL_SS = 1 * MiB;
constexpr size_t WS_H = 66 * MiB, WS_HB = 130 * MiB, WS_HB8 = 130 * MiB;
constexpr size_t WS_WINE = 162 * MiB, WS_WOUTE = 172 * MiB, WS_W13F = 176 * MiB, WS_W2F = 198 * MiB, WS_WINO = 209 * MiB, WS_WOUTO = 221 * MiB, WS_SMALL = 225 * MiB;
constexpr size_t SM_WLR = 0, SM_GAT = 128 * 1024, SM_GXT = 256 * 1024, SM_SSA = 384 * 1024;
constexpr size_t SM_KMAX = 600 * 1024;
constexpr size_t SM_SSF = 512 * 1024;
constexpr size_t WS_W13E = 226 * MiB, WS_W2E = 338 * MiB;
constexpr size_t WS_ACT = 394 * MiB;
constexpr size_t WS_XR = 394 * MiB, WS_YR = 410 * MiB, WS_Q = 426 * MiB, WS_K = 442 * MiB, WS_V = 458 * MiB, WS_YLG = 474 * MiB, WS_PG = 490 * MiB, WS_Y = 506 * MiB, WS_HF = 538 * MiB, WS_ESM = 626 * MiB;
constexpr size_t ES_FLOG = 0, ES_CP = 512 * 1024, ES_AGG = 1024 * 1024;
constexpr size_t WS_GQ = 394 * MiB, WS_GK = 410 * MiB, WS_GV = 426 * MiB, WS_GG = 458 * MiB, WS_LR = 490 * MiB, WS_DEC = 491 * MiB, WS_KVT = 492 * MiB, WS_SNT = 556 * MiB;
constexpr size_t WS_OG = 652 * MiB, WS_XN = 684 * MiB, WS_RT = 716 * MiB, WS_YM = 718 * MiB, WS_HM = 394 * MiB, WS_YM1 = 632 * MiB;
constexpr size_t RT_TS = 0, RT_TW = 128 * 1024, RT_TL = 256 * 1024;
constexpr size_t WS_END = 840 * MiB;
static_assert(WS_YM + (size_t)34816 * 1024 * 2 <= WS_END && WS_HM + (size_t)34816 * 3584 * 2 <= WS_OG, "ws map");

constexpr int LDS_BYTES = 151552;
constexpr int RING_BYTES = 131072, MISC_OFF = 147456;

struct Args { const float* in[26]; float* out; unsigned char* ws; int ph_lo, ph_hi; };

struct Frame {
    LAS unsigned char* lds; volatile LAS unsigned* MISC; gu32* ctl; unsigned char* ws;
    int tid, lane, wave, vcu, G;
};

constexpr float W13_MUL = 64.f, W2_MUL = 256.f; constexpr int W13_SCALE = 0x79797979, W2_SCALE = 0x77777777;
__device__ __forceinline__ unsigned f2bf(float f) { unsigned u = __builtin_bit_cast(unsigned, f); return (u + 0x7fffu + ((u >> 16) & 1u)) >> 16; }
__device__ __forceinline__ unsigned pk2(float lo, float hi) { return f2bf(lo) | (f2bf(hi) << 16); }

struct TrReg { float v[32]; };
template <bool HASG> __device__ __forceinline__ void transpose_load(TrReg& t, const float* W, int ldw, int c0, const float* g, int kb, int nb, int lane) {
    const int k0 = 64 * kb, n0 = 32 * nb;
#pragma unroll
    for (int i = 0; i < 32; ++i) { const int kk = 2 * i + (lane >> 5); float v = W[(size_t)(k0 + kk) * ldw + c0 + n0 + (lane & 31)]; if (HASG) v *= g[k0 + kk]; t.v[i] = v; }
}
template <int MODE, bool F8> __device__ __forceinline__ void transpose_store(const TrReg& t, int K, void* WTv, int half, LAS float* scr, int kb, int nb, int lane, float wmul) {
    const int k0 = 64 * kb, n0 = 32 * nb;
#pragma unroll
    for (int i = 0; i < 32; ++i) { const int kk = 2 * i + (lane >> 5); scr[kk * 33 + (lane & 31)] = t.v[i]; }
    LDS_WAIT(); asm volatile("" ::: "memory");
    const int c = lane & 7;
#pragma unroll
    for (int j = 0; j < 4; ++j) { const int n = (lane >> 3) + 8 * j; const LAS float* s = scr + (8 * c) * 33 + n;
        const int col = n0 + n; const int orow = MODE == 0 ? col : (256 * (col >> 7) + 128 * half + (col & 127));
        if constexpr (F8) { u32x2 o; o.x = pg8::pk4_fp8(s[0 * 33] * wmul, s[1 * 33] * wmul, s[2 * 33] * wmul, s[3 * 33] * wmul); o.y = pg8::pk4_fp8(s[4 * 33] * wmul, s[5 * 33] * wmul, s[6 * 33] * wmul, s[7 * 33] * wmul);
            *(GAS u32x2*)((unsigned char*)WTv + (size_t)orow * K + k0 + 8 * c) = o; }
        else { bf16_t* WT = (bf16_t*)WTv; u32x4 o; o.x = cvt_pk_bf16(s[0 * 33], s[1 * 33]); o.y = cvt_pk_bf16(s[2 * 33], s[3 * 33]); o.z = cvt_pk_bf16(s[4 * 33], s[5 * 33]); o.w = cvt_pk_bf16(s[6 * 33], s[7 * 33]);
            *(GAS u32x4*)(WT + (size_t)orow * K + k0 + 8 * c) = o; } }
    LDS_WAIT(); asm volatile("" ::: "memory");
}
template <int MODE, bool F8 = false> __device__ __forceinline__ void convert_matrix(Frame& F, const float* W, int K, int ldw, int c0, int ncols, const float* g, void* WT, int half, int& itbase, float wmul = 1.f) {
    LAS float* scr = (LAS float*)(F.lds + F.wave * 16384);
    const int gw = F.vcu * NWAVES + F.wave, NGW = F.G * NWAVES; const int nblk = ncols / 32, nit = (K / 64) * nblk;
    int it = (gw - (itbase % NGW) + NGW) % NGW;
    itbase += nit;
    if (it >= nit) return;
    TrReg cur, nxt;
    if (g) transpose_load<true>(cur, W, ldw, c0, g, it / nblk, it % nblk, F.lane); else transpose_load<false>(cur, W, ldw, c0, g, it / nblk, it % nblk, F.lane);
    for (;;) {
        const int itn = it + NGW; const bool more = itn < nit;
        if (more) { if (g) transpose_load<true>(nxt, W, ldw, c0, g, itn / nblk, itn % nblk, F.lane); else transpose_load<false>(nxt, W, ldw, c0, g, itn / nblk, itn % nblk, F.lane); }
        transpose_store<MODE, F8>(cur, K, WT, half, scr, it / nblk, it % nblk, F.lane, wmul);
        if (!more) break;
        cur = nxt; it = itn;
    }
}

__device__ __forceinline__ void convert_dense(Frame& F, const Args& a) {
    int itb = 0;
    for (int j = 0; j < 2; ++j) {
        convert_matrix<0>(F, a.in[4] + (size_t)j * D * EIN, D, EIN, 0, 2560, a.in[1] + (2 * j) * D, (bf16_t*)(F.ws + WS_WINE) + (size_t)j * 2560 * D, 0, itb);
        convert_matrix<0>(F, a.in[13] + (size_t)j * D * D, D, D, 0, D, nullptr, (bf16_t*)(F.ws + WS_WOUTE) + (size_t)j * D * D, 0, itb);
#if FFN_UP_FP8
        convert_matrix<1, true>(F, a.in[14] + (size_t)j * D * DFF, D, DFF, 0, DFF, a.in[2] + (2 * j) * D, (unsigned char*)(F.ws + WS_W13F) + (size_t)j * 2 * DFF * D, 0, itb, W13_MUL);
        convert_matrix<1, true>(F, a.in[15] + (size_t)j * D * DFF, D, DFF, 0, DFF, a.in[2] + (2 * j) * D, (unsigned char*)(F.ws + WS_W13F) + (size_t)j * 2 * DFF * D, 1, itb, W13_MUL);
#else
        convert_matrix<1>(F, a.in[14] + (size_t)j * D * DFF, D, DFF, 0, DFF, a.in[2] + (2 * j) * D, (bf16_t*)(F.ws + WS_W13F) + (size_t)j * 2 * DFF * D, 0, itb);
        convert_matrix<1>(F, a.in[15] + (size_t)j * D * DFF, D, DFF, 0, DFF, a.in[2] + (2 * j) * D, (bf16_t*)(F.ws + WS_W13F) + (size_t)j * 2 * DFF * D, 1, itb);
#endif
        convert_matrix<0>(F, a.in[16] + (size_t)j * DFF * D, DFF, D, 0, D, nullptr, (bf16_t*)(F.ws + WS_W2F) + (size_t)j * D * DFF, 0, itb);
        convert_matrix<0>(F, a.in[17] + (size_t)j * D * OIN, D, OIN, 0, 3072, a.in[1] + (2 * j + 1) * D, (bf16_t*)(F.ws + WS_WINO) + (size_t)j * 3072 * D, 0, itb);
        convert_matrix<0>(F, a.in[21] + (size_t)j * D * D, D, D, 0, D, nullptr, (bf16_t*)(F.ws + WS_WOUTO) + (size_t)j * D * D, 0, itb);
    }
    const int gt = (F.vcu * NTHR + F.tid), NT_ = F.G * NTHR;
    for (int idx = gt; idx < 2 * 16 * 1024; idx += NT_) { const int j = idx >> 14, c = (idx >> 10) & 15, k = idx & 1023;
        ((bf16_t*)(F.ws + WS_SMALL + SM_WLR))[idx] = (bf16_t)f2bf(a.in[17][(size_t)j * D * OIN + (size_t)k * OIN + 3072 + c] * a.in[1][(2 * j + 1) * D + k]); }
    for (int idx = gt; idx < 2 * 8 * 64 * 64; idx += NT_) { const int jn = idx >> 12, jj = (idx >> 6) & 63, i = idx & 63;
        ((bf16_t*)(F.ws + WS_SMALL + SM_GAT))[idx] = (bf16_t)f2bf(a.in[7][(size_t)jn * 4096 + i * 64 + jj]);
        ((bf16_t*)(F.ws + WS_SMALL + SM_GXT))[idx] = (bf16_t)f2bf(a.in[9][(size_t)jn * 4096 + i * 64 + jj]); }
}
__device__ __forceinline__ void convert_experts(Frame& F, const Args& a, int j) {
    int itb = 0;
    for (int e = 0; e < NE; ++e) {
        const size_t eo = (size_t)j * NE + e;
        convert_matrix<1, true>(F, a.in[23] + eo * D * DFE, D, DFE, 0, DFE, nullptr, (unsigned char*)(F.ws + WS_W13E) + (size_t)e * 2 * DFE * D, 0, itb, W13_MUL);
        convert_matrix<1, true>(F, a.in[24] + eo * D * DFE, D, DFE, 0, DFE, nullptr, (unsigned char*)(F.ws + WS_W13E) + (size_t)e * 2 * DFE * D, 1, itb, W13_MUL);
        convert_matrix<0, true>(F, a.in[25] + eo * DFE * D, DFE, D, 0, D, nullptr, (unsigned char*)(F.ws + WS_W2E) + (size_t)e * D * DFE, 0, itb, W2_MUL);
    }
}

struct RowV { f32x4 v[4]; };
__device__ __forceinline__ void row_load(RowV& r, const float* p, int lane) { const GAS f32x4* x = (const GAS f32x4*)p + lane;
#pragma unroll
    for (int j = 0; j < 4; ++j) r.v[j] = x[64 * j]; }
__device__ __forceinline__ float row_sumsq(const RowV& r) { float s = 0.f;
#pragma unroll
    for (int j = 0; j < 4; ++j) s += (r.v[j].x * r.v[j].x + r.v[j].y * r.v[j].y) + (r.v[j].z * r.v[j].z + r.v[j].w * r.v[j].w);
    return wave_sum(s); }
__device__ __forceinline__ void row_store_f32(const RowV& r, float* p, int lane) { GAS f32x4* x = (GAS f32x4*)p + lane;
#pragma unroll
    for (int j = 0; j < 4; ++j) x[64 * j] = r.v[j]; }
__device__ __forceinline__ void row_store_bf16(const RowV& r, bf16_t* p, int lane) { GAS u32x2* x = (GAS u32x2*)p + lane;
#pragma unroll
    for (int j = 0; j < 4; ++j) { u32x2 w; w.x = cvt_pk_bf16(r.v[j].x, r.v[j].y); w.y = cvt_pk_bf16(r.v[j].z, r.v[j].w); x[64 * j] = w; } }
__device__ __forceinline__ void row_store_fp8(const RowV& r, unsigned char* p, int lane) { GAS unsigned* x = (GAS unsigned*)p + lane;
#pragma unroll
    for (int j = 0; j < 4; ++j) x[64 * j] = pg8::pk4_fp8(r.v[j].x, r.v[j].y, r.v[j].z, r.v[j].w); }
template <int NC> __device__ __forceinline__ void row_dots(const RowV& r, const LAS float* Wl, int lane, float (&out)[NC]) {
#pragma unroll
    for (int c = 0; c < NC; ++c) { float s = 0.f;
#pragma unroll
        for (int j = 0; j < 4; ++j) { const f32x4 w = *(const LAS f32x4*)(Wl + c * 1024 + 4 * lane + 256 * j); s += (r.v[j].x * w.x + r.v[j].y * w.y) + (r.v[j].z * w.z + r.v[j].w * w.w); }
        out[c] = wave_sum(s); }
}
__device__ __forceinline__ void stage_table8(Frame& F, LAS float* Wl, const float* W, int ldw, int c0, const float* g) {
    for (int idx = F.tid; idx < 8192; idx += NTHR) { const int k = idx >> 3, c = idx & 7; Wl[c * 1024 + k] = W[(size_t)k * ldw + c0 + c] * (g ? g[k] : 1.f); }
    __syncthreads();
}
__device__ __forceinline__ void p0_rows(Frame& F, const Args& a) {
    LAS float* Wl = (LAS float*)(F.lds);
    stage_table8(F, Wl, a.in[4], EIN, 2560, a.in[1]);
    float* ssa = (float*)(F.ws + WS_SMALL + SM_SSA); bf16_t* hb = (bf16_t*)(F.ws + WS_HB); float* flog = (float*)(F.ws + WS_ESM + ES_FLOG);
    const int gw = F.vcu * NWAVES + F.wave, NGW = F.G * NWAVES;
    for (int m = gw; m < T; m += NGW) {
        RowV r; row_load(r, a.in[0] + (size_t)m * D, F.lane);
        const float ss = row_sumsq(r); const float inv = 1.0f / sqrtf(ss * (1.f / D) + EPS);
        row_store_bf16(r, hb + (size_t)m * D, F.lane);
        float dts[8]; row_dots<8>(r, Wl, F.lane, dts);
        if (F.lane == 0) ssa[m] = ss;
        if (F.lane < 8) { float v = dts[0];
#pragma unroll
            for (int c = 1; c < 8; ++c) v = (F.lane == c) ? dts[c] : v;
            flog[m * 8 + F.lane] = v * inv; }
    }
    __syncthreads();
}
}
#ifndef ATTN_EXIT
#define ATTN_EXIT 1
#endif
namespace attn_body {
using bf16=__hip_bfloat16;
constexpr int BATCH=4,NHEAD=8,SEQ=4096,D=64,DM=NHEAD*D,ODM=1024,OCOL=512;
constexpr int NW=8,QBLK=32,QB=QBLK*NW,KVBLK=64,NQB=SEQ/QB;
constexpr int ATTN_PITCH=DM, ATTN_UNIT_ROWS=QB;
__device__ __forceinline__ int crow(int r,int hi){return (r&3)+8*(r>>2)+4*hi;}
#define SBAR() __builtin_amdgcn_sched_barrier(0)
__device__ __forceinline__ void cmask(f32x16&p0,f32x16&p1,int jb,int qrel,int hi){
  const float NEG=-INFINITY; int kb=64*jb+4*hi;
  #pragma unroll
  for(int r=0;r<16;++r){int kv=kb+(r&3)+8*(r>>2); if(kv>qrel)p0[r]=NEG; if(kv+32>qrel)p1[r]=NEG;}
}

constexpr int NSLOT=3, SLOTB=8192;
constexpr int LDS_K=0, LDS_V=NSLOT*SLOTB, LDS_WS=2*NSLOT*SLOTB, LDS_OST=LDS_WS+NW*64*4, LDS_CB=LDS_OST+NW*4096, LDS_STOP=LDS_CB+SEQ*4, LDS_BYTES=LDS_STOP+64;
constexpr float C2=0.125f*1.4426950408889634f;
__device__ __forceinline__ void glds16(const void*gsrc,unsigned lds_dst){unsigned keep;
  asm volatile("s_mov_b32 %0, m0\n\ts_mov_b32 m0, %2\n\ts_nop 0\n\tglobal_load_lds_dwordx4 %1, off\n\ts_mov_b32 m0, %0":"=&s"(keep):"v"(gsrc),"s"(lds_dst):"memory");}
__device__ __forceinline__ float max3f(float a,float b,float c){float r;asm("v_max3_f32 %0, %1, %2, %3":"=v"(r):"v"(a),"v"(b),"v"(c));return r;}
__device__ __forceinline__ float max2f(float a,float b){float r;asm("v_max_f32_e32 %0, %1, %2":"=v"(r):"v"(a),"v"(b));return r;}
__device__ __forceinline__ float fadd_s(float a,float b){float r;asm("v_add_f32_e32 %0, %1, %2":"=v"(r):"v"(a),"v"(b));return r;}
__device__ __forceinline__ float fsub_s(float a,float b){float r;asm("v_sub_f32_e32 %0, %1, %2":"=v"(r):"v"(a),"v"(b));return r;}
typedef float f32x2_t __attribute__((ext_vector_type(2))); typedef __bf16 bf16x2_t __attribute__((ext_vector_type(2)));
__device__ __forceinline__ unsigned cvtpk_s(float lo,float hi){f32x2_t v={lo,hi};bf16x2_t b=__builtin_convertvector(v,bf16x2_t);return __builtin_bit_cast(unsigned,b);}
#define WAIT_BAR(N) asm volatile("s_waitcnt vmcnt(" #N ") lgkmcnt(0)\n\ts_barrier":::"memory")

__device__ __forceinline__ void qkt(f32x16&p0,f32x16&p1,const char*Kslot,const bf16x8*qr,const f32x16&negm,int r32,int hi){
  const char*kb=Kslot+hi*1024+r32*16;
  #pragma unroll
  for(int d0=0;d0<4;++d0){
    const bf16x8 b0=*reinterpret_cast<const bf16x8*>(kb+d0*2048);
    const bf16x8 b1=*reinterpret_cast<const bf16x8*>(kb+d0*2048+512);
    if(d0==0){p0=__builtin_amdgcn_mfma_f32_32x32x16_bf16(b0,qr[0],negm,0,0,0);p1=__builtin_amdgcn_mfma_f32_32x32x16_bf16(b1,qr[0],negm,0,0,0);}
    else{p0=__builtin_amdgcn_mfma_f32_32x32x16_bf16(b0,qr[d0],p0,0,0,0);p1=__builtin_amdgcn_mfma_f32_32x32x16_bf16(b1,qr[d0],p1,0,0,0);}}
}
typedef __attribute__((address_space(3))) const char* lds_cptr;
typedef short v4i16_t __attribute__((ext_vector_type(4)));
__device__ __forceinline__ void kload8(bf16x8*kf,lds_cptr kp){
  kf[0]=*(const __attribute__((address_space(3))) bf16x8*)(kp);      kf[1]=*(const __attribute__((address_space(3))) bf16x8*)(kp+512);
  kf[2]=*(const __attribute__((address_space(3))) bf16x8*)(kp+2048); kf[3]=*(const __attribute__((address_space(3))) bf16x8*)(kp+2560);
  kf[4]=*(const __attribute__((address_space(3))) bf16x8*)(kp+4096); kf[5]=*(const __attribute__((address_space(3))) bf16x8*)(kp+4608);
  kf[6]=*(const __attribute__((address_space(3))) bf16x8*)(kp+6144); kf[7]=*(const __attribute__((address_space(3))) bf16x8*)(kp+6656);
}
__device__ __forceinline__ void kload2(bf16x8*kf,lds_cptr kp,int j){ kf[2*j]=*(const __attribute__((address_space(3))) bf16x8*)(kp+j*2048); kf[2*j+1]=*(const __attribute__((address_space(3))) bf16x8*)(kp+j*2048+512); }
__device__ __forceinline__ s16x4 vtr(lds_cptr p){ return __builtin_bit_cast(s16x4,__builtin_amdgcn_ds_read_tr16_b64_v4i16((__attribute__((address_space(3))) v4i16_t*)p)); }
__device__ __forceinline__ float rowmax(const f32x16&p0,const f32x16&p1){
  float a=max3f(p0[0],p0[1],p1[0]),b=max3f(p0[2],p0[3],p1[1]);a=max3f(a,p1[2],p1[3]);
  #pragma unroll
  for(int r=4;r<16;r+=4){a=max3f(a,p0[r],p0[r+1]);b=max3f(b,p0[r+2],p0[r+3]);a=max3f(a,p1[r],p1[r+1]);b=max3f(b,p1[r+2],p1[r+3]);}
  const float m=max2f(a,b);
  auto rr=__builtin_amdgcn_permlane32_swap(__float_as_uint(m),__float_as_uint(m),false,false);
  return max2f(__uint_as_float(rr[0]),__uint_as_float(rr[1]));
}
__device__ __forceinline__ void pv(f32x16*o,int vb,bf16x8 pa0,bf16x8 pa1,bf16x8 pa2,bf16x8 pa3){
  #pragma unroll
  for(int d0=0;d0<2;++d0){s16x4 lo[4],hi[4];
    #pragma unroll
    for(int ks=0;ks<4;++ks){
      asm volatile("ds_read_b64_tr_b16 %0,%1 offset:%c2":"=&v"(lo[ks]):"v"(vb),"i"(d0*4096+ks*1024):"memory");
      asm volatile("ds_read_b64_tr_b16 %0,%1 offset:%c2":"=&v"(hi[ks]):"v"(vb),"i"(d0*4096+ks*1024+512):"memory");}
    asm volatile("s_waitcnt lgkmcnt(0)":::"memory");SBAR();
    #define PK(k) (bf16x8){lo[k][0],lo[k][1],lo[k][2],lo[k][3],hi[k][0],hi[k][1],hi[k][2],hi[k][3]}
    o[d0]=__builtin_amdgcn_mfma_f32_32x32x16_bf16(pa0,PK(0),o[d0],0,0,0);
    o[d0]=__builtin_amdgcn_mfma_f32_32x32x16_bf16(pa1,PK(1),o[d0],0,0,0);
    o[d0]=__builtin_amdgcn_mfma_f32_32x32x16_bf16(pa2,PK(2),o[d0],0,0,0);
    o[d0]=__builtin_amdgcn_mfma_f32_32x32x16_bf16(pa3,PK(3),o[d0],0,0,0);
    #undef PK
  }
}

#ifndef ATTN_STORE16
#define ATTN_STORE16(p,v) (*(u32x4*)(p)=(v))
#endif
template<int THRL> __device__ __forceinline__ void attn_unit(int b,int h,int qb,const bf16*Q,const bf16*__restrict__ K,const bf16*__restrict__ V,bf16*O,const float*CPbh,const float kmax,char*shm){
  int tid_=threadIdx.x; asm volatile("":"+v"(tid_));
  const int tid=tid_,lane=tid&63,r32=lane&31,hi=lane>>5; const int wid=__builtin_amdgcn_readfirstlane(tid>>6);
  const long rowbase=(long)b*SEQ; const int q0=qb*QB;
  const bf16*Qw=Q+(rowbase+q0+wid*QBLK)*DM+h*D;
  const bf16*Kh=K+rowbase*DM+h*D,*Vh=V+rowbase*DM+h*D;
  const unsigned lds0=(unsigned)(uintptr_t)shm;
  float*wsf=(float*)(shm+LDS_WS)+wid*64;
  const bf16*ksrc=Kh+(long)lane*DM+wid*8;
  const bf16*vsrc=Vh+(long)(16*(wid&3)+(lane>>2))*DM+(wid>>2)*32+(lane&3)*8;
  const unsigned kdst=lds0+LDS_K+wid*1024, vdst=lds0+LDS_V+wid*1024;
  #define PT(x) (NT-1-(x))
  #define DMA_K(t,slot) glds16(ksrc+(long)PT(t)*KVBLK*DM,(unsigned)__builtin_amdgcn_readfirstlane(kdst+(slot)))
  #define DMA_V(t,slot) glds16(vsrc+(long)PT(t)*KVBLK*DM,(unsigned)__builtin_amdgcn_readfirstlane(vdst+(slot)))
  const int vb0=(int)(lds0+LDS_V)+((lane>>4)&1)*32+(lane&3)*8+(4*hi+((lane&15)>>2))*64;
  const char*Kbase=shm+LDS_K; bf16x8 kf[8];
  const lds_cptr shm3=(lds_cptr)shm; const lds_cptr kp0=shm3+LDS_K+hi*1024+r32*16; const lds_cptr vp0=shm3+LDS_V+((lane>>4)&1)*32+(lane&3)*8+(4*hi+((lane&15)>>2))*64;
  const int NT=(q0+QB)/KVBLK;
  DMA_K(0,0);DMA_V(0,0);DMA_K(1,SLOTB);
  bf16x8 qr[4];
  #pragma unroll
  for(int d0=0;d0<4;++d0)qr[d0]=*reinterpret_cast<const bf16x8*>(&Qw[(long)r32*DM+d0*16+hi*8]);
  { __attribute__((address_space(3))) f32x4* dst=(__attribute__((address_space(3))) f32x4*)((__attribute__((address_space(3))) char*)shm+LDS_CB); const f32x4* src=(const f32x4*)CPbh; const int n4=(q0+QB)/4;
    for(int i=tid;i<n4;i+=NW*64){ const f32x4 v=src[i]; dst[i]=v; } }
  const __attribute__((address_space(3))) float* cbl=(const __attribute__((address_space(3))) float*)((lds_cptr)shm+LDS_CB)+4*hi;
  #define BIAS(P0,P1,t) do{ const __attribute__((address_space(3))) float* cbp_=cbl+64*PT(t); _Pragma("unroll") for(int g_=0;g_<4;++g_){ const f32x4 b0_=*(const __attribute__((address_space(3))) f32x4*)(cbp_+8*g_), b1_=*(const __attribute__((address_space(3))) f32x4*)(cbp_+8*g_+32); \
      _Pragma("unroll") for(int q_=0;q_<4;++q_){ P0[4*g_+q_]-=b0_[q_]; P1[4*g_+q_]-=b1_[q_]; } } }while(0)
  float mhat=0.f,l_reg=0.f;f32x16 o[2];o[0]=f32x16{};o[1]=f32x16{};
  const int qrel=wid*QBLK+r32;
  #define CMASK(P0,P1,t) do{int jb_=3-(t); if(jb_>=0)cmask(P0,P1,jb_,qrel,hi);}while(0)
  bool resc=false;
  #define START(P0,P1) do{ const float rm=rowmax(P0,P1); resc=false; \
    { const float dl=(rm==-INFINITY)?0.f:rm; mhat=fadd_s(mhat,dl);     \
      _Pragma("unroll") for(int r=0;r<16;++r){P0[r]=fsub_s(P0[r],dl);P1[r]=fsub_s(P1[r],dl);} \
      } \
    _Pragma("unroll") for(int r=0;r<16;++r)P0[r]=__builtin_amdgcn_exp2f(P0[r]); }while(0)
  #define RESC() do{ if(resc){ asm volatile("s_waitcnt lgkmcnt(0)":::"memory"); \
      _Pragma("unroll") for(int d_=0;d_<2;++d_) _Pragma("unroll") for(int r=0;r<16;++r)o[d_][r]*=wsf[crow(r,hi)]; } }while(0)
  f32x16 pA0,pA1,pB0,pB1;
  int sl_prev=0,sl_cur=0,sl_next=SLOTB;
  #define ROT() do{sl_prev=sl_cur;sl_cur=sl_next;sl_next=(sl_next==(NSLOT-1)*SLOTB)?0:sl_next+SLOTB;}while(0)
  DMA_K(2,2*SLOTB);
  WAIT_BAR(3);
  { f32x16 z0_=f32x16{}; asm volatile("":"+v"(z0_)); qkt(pA0,pA1,Kbase,qr,z0_,r32,hi); }asm volatile("s_nop 15\n\ts_nop 7":"+v"(pA0),"+v"(pA1));BIAS(pA0,pA1,0);CMASK(pA0,pA1,0);
  START(pA0,pA1);
  _Pragma("unroll") for(int r=0;r<16;++r)pA1[r]=__builtin_amdgcn_exp2f(pA1[r]);
  { const float nmh_=-mhat; _Pragma("unroll") for(int g_=0;g_<4;++g_){ const f32x4 b0_=*(const __attribute__((address_space(3))) f32x4*)(cbl+64*PT(1)+8*g_), b1_=*(const __attribute__((address_space(3))) f32x4*)(cbl+64*PT(1)+8*g_+32);
      _Pragma("unroll") for(int q_=0;q_<4;++q_){ pB0[4*g_+q_]=nmh_-b0_[q_]; pB1[4*g_+q_]=nmh_-b1_[q_]; } } }
  WAIT_BAR(0);
  DMA_K(3,0);DMA_V(1,SLOTB);
  ROT();
  kload8(kf,kp0+sl_cur);
  WAIT_BAR(2);
  s16x4 vlo[8],vhi[8]; u32x4 pw0,pw1,pw2,pw3;
  #define PKW(P,B) cvtpk_s(P[B],P[B+1])
  #define PAF(k) __builtin_bit_cast(bf16x8,pw##k)
  #define VFR(i) (bf16x8){vlo[i][0],vlo[i][1],vlo[i][2],vlo[i][3],vhi[i][0],vhi[i][1],vhi[i][2],vhi[i][3]}
  #define PIN(x) asm volatile("":"+v"(x))
  #define MX3(a,b,c) __builtin_fmaxf(__builtin_fmaxf((a),(b)),(c))
  #define GAPA(MF,A0,A1,A2,A3,W0,W1,PW) do{ MF; sacc+=A0; sacc+=A1; sacc+=A2; sacc+=A3; PIN(sacc); W0; W1; PIN(PW); SBAR(); }while(0)
  #define EX(v) __builtin_amdgcn_exp2f(v)
  #define INI(GI,P,g,p,t) do{ if(GI){ const f32x4 b_=*(const __attribute__((address_space(3))) f32x4*)(cbl+64*PT((t)+1)+8*(g)+32*(p)); P[4*(g)]=nmh_-b_[0]; P[4*(g)+1]=nmh_-b_[1]; P[4*(g)+2]=nmh_-b_[2]; P[4*(g)+3]=nmh_-b_[3]; PIN(P); } }while(0)
  #define GAPB(MF,X,B,INIT) do{ MF; X[B]=EX(X[B]); X[B+1]=EX(X[B+1]); X[B+2]=EX(X[B+2]); X[B+3]=EX(X[B+3]); PIN(X); INIT; SBAR(); }while(0)
  #define VRD(i) do{ vlo[i]=vtr(vp_+(((i)>>2)*4096+((i)&3)*1024)); vhi[i]=vtr(vp_+(((i)>>2)*4096+((i)&3)*1024+512)); }while(0)
  #define KRD(G,j) do{ if(G){ kload2(kf,kp0+sl_next,j); SBAR(); } }while(0)
  #define STEP(C0,C1,P0,P1,t,GK,GV,GL) do{ SBAR(); \
    const lds_cptr vp_=vp0+sl_prev; \
    VRD(0); SBAR(); float sacc=(P0[0]+P0[1]); \
    GAPA(C0=__builtin_amdgcn_mfma_f32_32x32x16_bf16(kf[0],qr[0],C0,0,0,0), P0[2],P0[3],P0[4],P0[5],     pw0[0]=PKW(P0,0), pw0[1]=PKW(P0,2), pw0); \
    VRD(4); SBAR(); GAPA(C1=__builtin_amdgcn_mfma_f32_32x32x16_bf16(kf[1],qr[0],C1,0,0,0), P0[6],P0[7],P0[8],P0[9],     pw0[2]=PKW(P0,4), pw0[3]=PKW(P0,6), pw0); \
    VRD(1); SBAR(); GAPA(C0=__builtin_amdgcn_mfma_f32_32x32x16_bf16(kf[2],qr[1],C0,0,0,0),   P0[10],P0[11],P0[12],P0[13], pw1[0]=PKW(P0,8), pw1[1]=PKW(P0,10), pw1); \
    VRD(5); SBAR(); GAPA(C1=__builtin_amdgcn_mfma_f32_32x32x16_bf16(kf[3],qr[1],C1,0,0,0),   P0[14],P0[15],P1[0],P1[1],   pw1[2]=PKW(P0,12),pw1[3]=PKW(P0,14), pw1); \
    VRD(2); SBAR(); GAPA(C0=__builtin_amdgcn_mfma_f32_32x32x16_bf16(kf[4],qr[2],C0,0,0,0),   P1[2],P1[3],P1[4],P1[5],     pw2[0]=PKW(P1,0), pw2[1]=PKW(P1,2), pw2); \
    VRD(6); SBAR(); GAPA(C1=__builtin_amdgcn_mfma_f32_32x32x16_bf16(kf[5],qr[2],C1,0,0,0),   P1[6],P1[7],P1[8],P1[9],     pw2[2]=PKW(P1,4), pw2[3]=PKW(P1,6), pw2); \
    VRD(3); SBAR(); GAPA(C0=__builtin_amdgcn_mfma_f32_32x32x16_bf16(kf[6],qr[3],C0,0,0,0),   P1[10],P1[11],P1[12],P1[13], pw3[0]=PKW(P1,8), pw3[1]=PKW(P1,10), pw3); \
    VRD(7); SBAR(); GAPA(C1=__builtin_amdgcn_mfma_f32_32x32x16_bf16(kf[7],qr[3],C1,0,0,0),   P1[14],P1[15],0.f,0.f,       pw3[2]=PKW(P1,12),pw3[3]=PKW(P1,14), pw3); \
    l_reg+=sacc; \
    if(GK){DMA_K((t)+3,sl_cur);} if(GV){DMA_V((t)+1,sl_next);} \
    CMASK(C0,C1,t); \
    { float a=MX3(C0[0],C0[1],C1[0]),b=MX3(C0[2],C0[3],C1[1]); a=MX3(a,C1[2],C1[3]); \
      _Pragma("unroll") for(int r=4;r<16;r+=4){a=MX3(a,C0[r],C0[r+1]);b=MX3(b,C0[r+2],C0[r+3]);a=MX3(a,C1[r],C1[r+1]);b=MX3(b,C1[r+2],C1[r+3]);} \
      float rm=__builtin_fmaxf(a,b); { auto rr=__builtin_amdgcn_permlane32_swap(__float_as_uint(rm),__float_as_uint(rm),false,false); rm=__builtin_fmaxf(__uint_as_float(rr[0]),__uint_as_float(rr[1])); } \
      resc=false; \
      if(__builtin_expect(__any(rm>(float)THRL),0)){ const float dl=__builtin_fmaxf(rm,0.f); mhat+=dl; \
        _Pragma("unroll") for(int r=0;r<16;++r){C0[r]-=dl;C1[r]-=dl;} \
        const float f=__builtin_amdgcn_exp2f(-dl); l_reg*=f; if(hi==0)wsf[r32]=f; resc=true; } } \
    const float nmh_=-mhat; SBAR(); \
    GAPB(o[0]=__builtin_amdgcn_mfma_f32_32x32x16_bf16(PAF(0),VFR(0),o[0],0,0,0), C0,0, INI(GL,P0,0,0,t)); \
    GAPB(o[1]=__builtin_amdgcn_mfma_f32_32x32x16_bf16(PAF(0),VFR(4),o[1],0,0,0), C0,4, INI(GL,P0,1,0,t)); \
    KRD(GL,0); GAPB(o[0]=__builtin_amdgcn_mfma_f32_32x32x16_bf16(PAF(1),VFR(1),o[0],0,0,0), C0,8, INI(GL,P0,2,0,t)); \
    KRD(GL,1); GAPB(o[1]=__builtin_amdgcn_mfma_f32_32x32x16_bf16(PAF(1),VFR(5),o[1],0,0,0), C0,12, INI(GL,P0,3,0,t)); \
    KRD(GL,2); GAPB(o[0]=__builtin_amdgcn_mfma_f32_32x32x16_bf16(PAF(2),VFR(2),o[0],0,0,0), C1,0, INI(GL,P1,0,1,t)); \
    KRD(GL,3); GAPB(o[1]=__builtin_amdgcn_mfma_f32_32x32x16_bf16(PAF(2),VFR(6),o[1],0,0,0), C1,4, INI(GL,P1,1,1,t)); \
    GAPB(o[0]=__builtin_amdgcn_mfma_f32_32x32x16_bf16(PAF(3),VFR(3),o[0],0,0,0), C1,8, INI(GL,P1,2,1,t)); \
    GAPB(o[1]=__builtin_amdgcn_mfma_f32_32x32x16_bf16(PAF(3),VFR(7),o[1],0,0,0), C1,12, INI(GL,P1,3,1,t)); \
    }while(0)
  float qnk;
  { float s2=0.f;
    _Pragma("unroll") for(int d0=0;d0<4;++d0){ _Pragma("unroll") for(int e=0;e<8;++e){ const float v=__uint_as_float(((unsigned)(unsigned short)qr[d0][e])<<16); s2+=v*v; } }
    auto rr=__builtin_amdgcn_permlane32_swap(__float_as_uint(s2),__float_as_uint(s2),false,false); s2=__uint_as_float(rr[0])+__uint_as_float(rr[1]);
    qnk=sqrtf(s2)*kmax; }
  const __attribute__((address_space(3))) float* cb0=(const __attribute__((address_space(3))) float*)((lds_cptr)shm+LDS_CB);
  __attribute__((address_space(3))) unsigned* stopf=(__attribute__((address_space(3))) unsigned*)((__attribute__((address_space(3))) char*)shm+LDS_STOP);
  #define ENDW(tt) do{ if((tt)+3<NT){WAIT_BAR(2);} else if((tt)+2<NT){WAIT_BAR(1);} else {WAIT_BAR(0);} }while(0)
  #define DRAIN(P0,P1,slot) do{ float sacc=P0[0]+P0[1]; _Pragma("unroll") for(int r=2;r<16;++r)sacc+=P0[r]; _Pragma("unroll") for(int r=0;r<16;++r)sacc+=P1[r]; l_reg+=sacc; \
    pw0=(u32x4){PKW(P0,0),PKW(P0,2),PKW(P0,4),PKW(P0,6)};pw1=(u32x4){PKW(P0,8),PKW(P0,10),PKW(P0,12),PKW(P0,14)};pw2=(u32x4){PKW(P1,0),PKW(P1,2),PKW(P1,4),PKW(P1,6)};pw3=(u32x4){PKW(P1,8),PKW(P1,10),PKW(P1,12),PKW(P1,14)}; \
    SBAR(); pv(o,vb0+(slot),PAF(0),PAF(1),PAF(2),PAF(3)); }while(0)
  int t=1; bool stopped=false;
  for(;t+1<NT;t+=2){
    STEP(pB0,pB1,pA0,pA1,t,(t+3<NT),(t+1<NT),(t+1<NT));       ENDW(t);   RESC(); ROT();
    STEP(pA0,pA1,pB0,pB1,t+1,(t+4<NT),(t+2<NT),(t+2<NT));
    { bool ok=(t+2<NT) && ATTN_EXIT; if(ok){ const float cl=cb0[64*PT(t+2)+63]; ok=__all((qnk-cl-mhat)<-160.f); } if(lane==0)stopf[wid]=ok?1u:0u; }
    ENDW(t+1); RESC(); ROT();
    { const u32x4 f0=*(const __attribute__((address_space(3))) u32x4*)stopf, f1=*(const __attribute__((address_space(3))) u32x4*)(stopf+4);
      if((f0.x&f0.y&f0.z&f0.w&f1.x&f1.y&f1.z&f1.w)!=0u){ stopped=true; break; } }
  }
  if(!stopped){ STEP(pB0,pB1,pA0,pA1,NT-1,false,false,false); RESC(); DRAIN(pB0,pB1,sl_cur); }
  else { asm volatile("s_waitcnt vmcnt(0)":::"memory"); DRAIN(pA0,pA1,sl_prev); }
  #undef DRAIN
  #undef PKW
  #undef PAF
  #undef VFR
  #undef PIN
  #undef MX3
  #undef GAPA
  #undef GAPB
  #undef INI
  #undef EX
  #undef VRD
  #undef KRD
  #undef STEP
  #undef ENDW
  {auto rr=__builtin_amdgcn_permlane32_swap(__float_as_uint(l_reg),__float_as_uint(l_reg),false,false);l_reg=__uint_as_float(rr[0])+__uint_as_float(rr[1]);}
  if(hi==0)wsf[32+r32]=l_reg;asm volatile("s_waitcnt lgkmcnt(0)":::"memory");
  float rli[16];
  #pragma unroll
  for(int r=0;r<16;++r)rli[r]=__builtin_amdgcn_rcpf(wsf[32+crow(r,hi)]);
  bf16*Ow=O+(rowbase+q0+wid*QBLK)*ODM+OCOL+h*D;
  { bf16*stg=(bf16*)(shm+LDS_OST)+wid*2048;
    #pragma unroll
    for(int r=0;r<16;++r){const int orow=crow(r,hi);
      #pragma unroll
      for(int d0=0;d0<2;++d0)stg[orow*64+d0*32+r32]=__float2bfloat16(o[d0][r]*rli[r]);}
    asm volatile("s_waitcnt lgkmcnt(0)":::"memory");
    #pragma unroll
    for(int i=0;i<4;++i){const int row=i*8+(lane>>3),ch=lane&7; const u32x4 v=*(const u32x4*)(stg+row*64+ch*8); ATTN_STORE16(Ow+(long)row*ODM+ch*8,v);} }
  asm volatile("s_waitcnt lgkmcnt(0)\n\ts_barrier":::"memory");
  #undef BIAS
  #undef PT
  #undef DMA_K
  #undef DMA_V
  #undef CMASK
  #undef START
  #undef RESC
  #undef ROT
}
constexpr int ATTN_LDS_BYTES=LDS_BYTES;
#undef SBAR
#undef WAIT_BAR
}
namespace fk {
__device__ __forceinline__ float gelu_tanh_fast(float x) {
    const float z = 0.7978845608028654f * (x + 0.044715f * x * x * x);
    const float e = __builtin_amdgcn_exp2f(2.f * LOG2E * z);
    const float th = 1.f - 2.f * __builtin_amdgcn_rcpf(1.f + e);
    return 0.5f * x * (1.f + th);
}
__device__ __forceinline__ bf16_t bf1(float v) { return (bf16_t)cvt_pk_bf16(v, 0.f); }
__device__ __forceinline__ f32x16 zero16v() { f32x16 z = f32x16{}; asm volatile("" : "+v"(z)); return z; }
__device__ __forceinline__ int crow32f(int r, int hi) { return (r & 3) + 8 * (r >> 2) + 4 * hi; }
__device__ __forceinline__ float logsigm_acc(float z) {
    const float e = __builtin_amdgcn_exp2f(-fabsf(z) * LOG2E); return fminf(z, 0.f) - 0.6931471805599453f * __builtin_amdgcn_logf(1.f + e); }

constexpr int LW_STRIDE = 13312, LW_XRT = 0, LW_XCI = 4480, LW_YRT = 9088, LW_OUT = 0;
static_assert(8 * LW_STRIDE <= RING_BYTES && LW_YRT + 4096 <= LW_STRIDE, "lru wave lds");
__device__ __forceinline__ void lru_wave_task(Frame& F, const Args& a, int j, int task) {
    int lane0_ = F.lane; asm volatile("" : "+v"(lane0_));
    const int lane = lane0_, r31 = lane & 31, hi = lane >> 5;
    LAS unsigned char* L = F.lds + F.wave * LW_STRIDE;
    const int c = task >> 5, bn = task & 31, b = bn >> 3, n = bn & 7;
    const bf16_t* XR = (const bf16_t*)(F.ws + WS_XR); const bf16_t* YR = (const bf16_t*)(F.ws + WS_YR);
    bf16_t* YLG = (bf16_t*)(F.ws + WS_YLG); bf16_t* PGo = (bf16_t*)(F.ws + WS_PG); float* AGG = (float*)(F.ws + WS_ESM + ES_AGG);
    const bf16_t* GAT = (const bf16_t*)(F.ws + WS_SMALL + SM_GAT) + (size_t)(j * 8 + n) * 4096; const bf16_t* GXT = (const bf16_t*)(F.ws + WS_SMALL + SM_GXT) + (size_t)(j * 8 + n) * 4096;
    float cb[2], w0[2], w1[2], w2[2], w3[2], gab[2], gxb[2], sp[2];
#pragma unroll
    for (int nbk = 0; nbk < 2; ++nbk) { const int gch = n * 64 + 32 * nbk + r31; const float* cw = a.in[5] + j * 2048;
        cb[nbk] = a.in[6][j * 512 + gch]; w0[nbk] = cw[gch]; w1[nbk] = cw[512 + gch]; w2[nbk] = cw[1024 + gch]; w3[nbk] = cw[1536 + gch];
        gab[nbk] = a.in[8][j * 512 + gch]; gxb[nbk] = a.in[10][j * 512 + gch];
        const float lam = a.in[11][j * 512 + gch]; sp[nbk] = 0.6931471805599453f * __builtin_amdgcn_logf(1.f + __builtin_amdgcn_exp2f(-lam * LOG2E));
    }
    float Pc[2] = {1.f, 1.f}, yc[2] = {0.f, 0.f};
    for (int hb = 0; hb < 2; ++hb) {
        int row0 = b * SEQ + c * 64 + hb * 32;
        asm volatile("" : "+s"(row0));
#pragma unroll
        for (int i = 0; i < 5; ++i) { const int q = lane + 64 * i; if (q < 280) { const int r = q >> 3, c8 = q & 7; u32x4 v = (u32x4){0u, 0u, 0u, 0u};
                if (c > 0 || hb > 0 || r >= 3) v = *(const GAS u32x4*)(XR + (size_t)(row0 - 3 + r) * 512 + n * 64 + c8 * 8);
                *(LAS u32x4*)(L + LW_XRT + q * 16) = v; } }
#pragma unroll
        for (int i = 0; i < 4; ++i) { const int q = lane + 64 * i, r = q >> 3, c8 = q & 7; *(LAS u32x4*)(L + LW_YRT + q * 16) = *(const GAS u32x4*)(YR + (size_t)(row0 + r) * 512 + n * 64 + c8 * 8); }
        float xc[2][16];
        const LAS bf16_t* xt = (const LAS bf16_t*)(L + LW_XRT); LAS bf16_t* xi = (LAS bf16_t*)(L + LW_XCI);
#pragma unroll
        for (int nbk = 0; nbk < 2; ++nbk) { const int ch = 32 * nbk + r31;
#pragma unroll
            for (int g4 = 0; g4 < 4; ++g4) { const int t0 = 8 * g4 + 4 * hi; float xv[7];
#pragma unroll
                for (int q = 0; q < 7; ++q) xv[q] = bf2f(xt[(t0 + q) * 64 + ch]);
#pragma unroll
                for (int q = 0; q < 4; ++q) { const float v = cb[nbk] + w0[nbk] * xv[q] + w1[nbk] * xv[q + 1] + w2[nbk] * xv[q + 2] + w3[nbk] * xv[q + 3]; xc[nbk][4 * g4 + q] = v; xi[(t0 + q) * 72 + ch] = bf1(v); } } }
        f32x16 ra[2], rx[2];
#pragma unroll
        for (int nbk = 0; nbk < 2; ++nbk) { ra[nbk] = zero16v(); rx[nbk] = zero16v(); }
#pragma unroll
        for (int s = 0; s < 4; ++s) { const bf16x8 af = *(const LAS bf16x8*)(L + LW_XCI + (r31 * 72 + 16 * s + 8 * hi) * 2);
#pragma unroll
            for (int nbk = 0; nbk < 2; ++nbk) { const size_t bo = (size_t)(32 * nbk + r31) * 64 + 16 * s + 8 * hi;
                const bf16x8 ba = *(const GAS bf16x8*)(GAT + bo), bx = *(const GAS bf16x8*)(GXT + bo);
                ra[nbk] = __builtin_amdgcn_mfma_f32_32x32x16_bf16(af, ba, ra[nbk], 0, 0, 0); rx[nbk] = __builtin_amdgcn_mfma_f32_32x32x16_bf16(af, bx, rx[nbk], 0, 0, 0); } }
#pragma unroll
        for (int nbk = 0; nbk < 2; ++nbk)
#pragma unroll
            for (int r = 0; r < 16; ++r) { const float rg = fast_sigm(ra[nbk][r] + gab[nbk]), ig = fast_sigm(rx[nbk][r] + gxb[nbk]);
                const float la = -8.0f * rg * sp[nbk]; const float av = fast_exp(la);
                const float x2 = 2.f * la; const float om = x2 > -0.02f ? -x2 * (1.f + x2 * (0.5f + x2 * (1.f / 6.f))) : 1.f - av * av;
                ra[nbk][r] = av; rx[nbk][r] = __builtin_amdgcn_sqrtf(om) * (ig * xc[nbk][r]); }
#pragma unroll
        for (int nbk = 0; nbk < 2; ++nbk) {
#pragma unroll
            for (int g4 = 0; g4 < 4; ++g4) {
#pragma unroll
                for (int q = 1; q < 4; ++q) { const int r = 4 * g4 + q; rx[nbk][r] = ra[nbk][r] * rx[nbk][r - 1] + rx[nbk][r]; ra[nbk][r] = ra[nbk][r] * ra[nbk][r - 1]; }
                const float P4 = ra[nbk][4 * g4 + 3], y4 = rx[nbk][4 * g4 + 3];
                float Pin = Pc[nbk], yin = yc[nbk];
                { const float yo = P4 * yin + y4, Po = P4 * Pin;
                  const auto sy = __builtin_amdgcn_permlane32_swap(__float_as_uint(yo), __float_as_uint(yo), false, false); const auto sP = __builtin_amdgcn_permlane32_swap(__float_as_uint(Po), __float_as_uint(Po), false, false);
                  const float y_lo = __uint_as_float(sy[0]), P_lo = __uint_as_float(sP[0]);
                  if (hi) { Pin = P_lo; yin = y_lo; }
                  const float y1 = P4 * yin + y4, P1 = P4 * Pin;
                  const auto ty = __builtin_amdgcn_permlane32_swap(__float_as_uint(y1), __float_as_uint(y1), false, false); const auto tP = __builtin_amdgcn_permlane32_swap(__float_as_uint(P1), __float_as_uint(P1), false, false);
                  yc[nbk] = __uint_as_float(ty[1]); Pc[nbk] = __uint_as_float(tP[1]); }
#pragma unroll
                for (int q = 0; q < 4; ++q) { const int r = 4 * g4 + q; rx[nbk][r] = ra[nbk][r] * yin + rx[nbk][r]; ra[nbk][r] = ra[nbk][r] * Pin; }
            }
        }
        { const LAS bf16_t* yt = (const LAS bf16_t*)(L + LW_YRT); LAS bf16_t* o0 = (LAS bf16_t*)(L + LW_OUT); LAS bf16_t* o1 = (LAS bf16_t*)(L + LW_OUT + 4096);
#pragma unroll
          for (int nbk = 0; nbk < 2; ++nbk) { const int ch = 32 * nbk + r31;
#pragma unroll
              for (int r = 0; r < 16; ++r) { const int t = crow32f(r, hi); const float g = gelu_tanh_fast(bf2f(yt[t * 64 + ch]));
                  o0[t * 64 + ch] = bf1(rx[nbk][r] * g); o1[t * 64 + ch] = bf1(ra[nbk][r] * g); } }
#pragma unroll
          for (int i = 0; i < 4; ++i) { const int q = lane + 64 * i, r = q >> 3, c8 = q & 7; const size_t go = (size_t)(row0 + r) * 512 + n * 64 + c8 * 8;
              *(GAS u32x4*)(YLG + go) = *(const LAS u32x4*)(L + LW_OUT + q * 16); *(GAS u32x4*)(PGo + go) = *(const LAS u32x4*)(L + LW_OUT + 4096 + q * 16); }
          asm volatile("s_waitcnt lgkmcnt(0)" ::: "memory"); }
    }
    if (hi == 0) {
#pragma unroll
        for (int nbk = 0; nbk < 2; ++nbk) { float* ag = AGG + ((size_t)(b * 64 + c) * 512 + n * 64 + 32 * nbk + r31) * 2; *(GAS f32x2*)ag = (f32x2){Pc[nbk], yc[nbk]}; } }
}

__device__ __forceinline__ void fox_cumsum(Frame& F, const Args& a, int j, int bh) {
    const int b = bh >> 3, h = bh & 7; const float fb = a.in[12][j * 8 + h];
    const float* flog = (const float*)(F.ws + WS_ESM + ES_FLOG); float* CP = (float*)(F.ws + WS_ESM + ES_CP) + (size_t)bh * SEQ;
    const bf16_t* Kb = (const bf16_t*)(F.ws + WS_K);
    LAS float* wt = (LAS float*)(F.lds);
    float v[8]; float run = 0.f, kmx = 0.f;
#pragma unroll
    for (int i = 0; i < 8; ++i) { const int t = F.tid * 8 + i; run += logsigm_acc(flog[(size_t)(b * SEQ + t) * 8 + h] + fb); v[i] = run;
        const GAS u32x4* kr = (const GAS u32x4*)(Kb + (size_t)(b * SEQ + t) * 512 + h * 64); float s2 = 0.f;
#pragma unroll
        for (int q = 0; q < 8; ++q) { const u32x4 w = kr[q]; s2 += bflo(w.x) * bflo(w.x) + bfhi(w.x) * bfhi(w.x) + bflo(w.y) * bflo(w.y) + bfhi(w.y) * bfhi(w.y) + bflo(w.z) * bflo(w.z) + bfhi(w.z) * bfhi(w.z) + bflo(w.w) * bflo(w.w) + bfhi(w.w) * bfhi(w.w); }
        kmx = fmaxf(kmx, s2); }
    float inc = run;
#pragma unroll
    for (int o = 1; o < 64; o <<= 1) { const float u = __shfl_up(inc, o); if (F.lane >= o) inc += u; }
#pragma unroll
    for (int o = 32; o; o >>= 1) kmx = fmaxf(kmx, __shfl_xor(kmx, o));
    if (F.lane == 63) { wt[F.wave] = inc; wt[8 + F.wave] = kmx; }
    __syncthreads();
    float base = inc - run;
    for (int w = 0; w < F.wave; ++w) base += wt[w];
#pragma unroll
    for (int i = 0; i < 8; ++i) CP[F.tid * 8 + i] = (base + v[i]) * LOG2E;
    if (F.tid == 0) { float m = 0.f; for (int w = 0; w < 8; ++w) m = fmaxf(m, wt[8 + w]); ((float*)(F.ws + WS_SMALL + SM_KMAX))[bh] = sqrtf(m) * 1.002f; }
    __syncthreads();
}

__device__ __forceinline__ void lru_fixup(Frame& F, int b, int c) {
    const float* AGG = (const float*)(F.ws + WS_ESM + ES_AGG);
    const bf16_t* YLG = (const bf16_t*)(F.ws + WS_YLG); const bf16_t* PGi = (const bf16_t*)(F.ws + WS_PG); bf16_t* Y = (bf16_t*)(F.ws + WS_Y);
    LAS float* HIN = (LAS float*)(F.lds);
    { const int ch = F.tid; float hh = 0.f;
      for (int cc = 0; cc < c; ++cc) { const f32x2 g = *(const GAS f32x2*)(AGG + ((size_t)(b * 64 + cc) * 512 + ch) * 2); hh = g.x * hh + g.y; }
      HIN[ch] = hh; }
    __syncthreads();
    const int rbase = b * SEQ + c * 64;
#pragma unroll 2
    for (int i = 0; i < 8; ++i) { const int q = F.tid + NTHR * i, r = q >> 6, c8 = q & 63; const size_t off = (size_t)(rbase + r) * 512 + c8 * 8;
        const u32x4 yl = *(const GAS u32x4*)(YLG + off), pg = *(const GAS u32x4*)(PGi + off);
        const f32x4 h0 = *(const LAS f32x4*)(HIN + c8 * 8), h1 = *(const LAS f32x4*)(HIN + c8 * 8 + 4);
        u32x4 o;
        o.x = cvt_pk_bf16(bflo(yl.x) + bflo(pg.x) * h0.x, bfhi(yl.x) + bfhi(pg.x) * h0.y);
        o.y = cvt_pk_bf16(bflo(yl.y) + bflo(pg.y) * h0.z, bfhi(yl.y) + bfhi(pg.y) * h0.w);
        o.z = cvt_pk_bf16(bflo(yl.z) + bflo(pg.z) * h1.x, bfhi(yl.z) + bfhi(pg.z) * h1.y);
        o.w = cvt_pk_bf16(bflo(yl.w) + bflo(pg.w) * h1.z, bfhi(yl.w) + bfhi(pg.w) * h1.w);
        *(GAS u32x4*)(Y + (size_t)(rbase + r) * 1024 + c8 * 8) = o; }
    __syncthreads();
}
}
namespace fk {
__device__ __forceinline__ float fast_logsigm(float z) {
    const float az = fabsf(z); const float e = __builtin_amdgcn_exp2f(-az * LOG2E);
    return fminf(z, 0.f) - 0.6931471805599453f * __builtin_amdgcn_logf(1.f + e);
}
__device__ __forceinline__ s16x4 tr16(const LAS void* p) { typedef short v4i16_t __attribute__((ext_vector_type(4))); return __builtin_bit_cast(s16x4, __builtin_amdgcn_ds_read_tr16_b64_v4i16((LAS v4i16_t*)p)); }
#define MFMA32(a, b, c) __builtin_amdgcn_mfma_f32_32x32x16_bf16(a, b, c, 0, 0, 0)
__device__ __forceinline__ f32x16 zero16() { f32x16 z = f32x16{}; asm volatile("" : "+v"(z)); return z; }
__device__ __forceinline__ int crow32(int r, int hi) { return (r & 3) + 8 * (r >> 2) + 4 * hi; }

__device__ __forceinline__ void skinny_lr(Frame& F, int j, int rb, const pg8::SumSq ss) {
    const bf16_t* hb = (const bf16_t*)(F.ws + WS_HB); const bf16_t* Wt = (const bf16_t*)(F.ws + WS_SMALL + SM_WLR) + (size_t)j * 16 * 1024; float* LR = (float*)(F.ws + WS_LR);
    const int lane = F.lane, w = F.wave, fr = lane & 15, fq = lane >> 4, mb = w & 3, kh = w >> 2;
    const bf16_t* ap = hb + (size_t)(rb * 64 + mb * 16 + fr) * D + kh * 512 + 8 * fq; const bf16_t* bp = Wt + (size_t)fr * D + kh * 512 + 8 * fq;
    f32x4 acc = (f32x4){0.f, 0.f, 0.f, 0.f};
#pragma unroll 8
    for (int s = 0; s < 16; ++s) { const bf16x8 av = *(const GAS bf16x8*)(ap + 32 * s), bv = *(const GAS bf16x8*)(bp + 32 * s); acc = __builtin_amdgcn_mfma_f32_16x16x32_bf16(av, bv, acc, 0, 0, 0); }
    LAS float* red = (LAS float*)(F.lds);
#pragma unroll
    for (int r = 0; r < 4; ++r) red[w * 256 + (4 * fq + r) * 16 + fr] = acc[r];
    __syncthreads();
#pragma unroll
    for (int i = 0; i < 2; ++i) { const int o = F.tid + NTHR * i, row = o >> 4, col = o & 15, m = row >> 4, rr = row & 15;
        const float v = red[m * 256 + rr * 16 + col] + red[(4 + m) * 256 + rr * 16 + col]; const int grow = rb * 64 + row;
        LR[(size_t)grow * 16 + col] = v * pg8::inv_rms(ss, grow); }
    __syncthreads();
}

constexpr int GA_KST = 0;
constexpr int GA_VT = 18432;
constexpr int GA_LR = GA_VT + 36864;
constexpr int GA_QT = GA_LR + 4096;
constexpr int GA_QS = GA_QT + 2048;
constexpr int GA_KS = GA_QS + 17408;
constexpr int GA_OUT = GA_VT;
static_assert(GA_KS + 17408 <= RING_BYTES && GA_OUT + 69632 <= GA_KS + 17408, "gla prep lds");
struct GlaPrepRegs { u32x4 v[4], q[2], k[2]; f32x4 lr; };
__device__ __forceinline__ void gla_prep_load(Frame& F, int item, GlaPrepRegs& R) {
    const int tid = F.tid; const int bh = item >> 6, n = item & 63, b = bh >> 2, h = bh & 3; const int r0 = b * SEQ + n * 64;
    const bf16_t* GQ = (const bf16_t*)(F.ws + WS_GQ); const bf16_t* GK = (const bf16_t*)(F.ws + WS_GK); const bf16_t* GV = (const bf16_t*)(F.ws + WS_GV); const float* LR = (const float*)(F.ws + WS_LR);
#pragma unroll
    for (int i = 0; i < 4; ++i) { const int q = tid + NTHR * i, t = q >> 5, c8 = q & 31; R.v[i] = *(const GAS u32x4*)(GV + (size_t)(r0 + t) * 1024 + h * 256 + c8 * 8); }
#pragma unroll
    for (int i = 0; i < 2; ++i) { const int q = tid + NTHR * i, t = q >> 4, c8 = q & 15; const size_t go = (size_t)(r0 + t) * 512 + h * 128 + c8 * 8; R.q[i] = *(const GAS u32x4*)(GQ + go); R.k[i] = *(const GAS u32x4*)(GK + go); }
    R.lr = *(const GAS f32x4*)(LR + (size_t)r0 * 16 + (tid & 255) * 4);
}
__device__ __forceinline__ void gla_prep(Frame& F, const Args& a, int j, int item, int next_item, GlaPrepRegs& R) {
    const int tid = F.tid, lane = F.lane, w = F.wave; LAS unsigned char* L = F.lds;
    const int bh = item >> 6, n = item & 63, b = bh >> 2, h = bh & 3; const int r0 = b * SEQ + n * 64;
    bf16_t* GQ = (bf16_t*)(F.ws + WS_GQ); bf16_t* GK = (bf16_t*)(F.ws + WS_GK);
    float* DEC = (float*)(F.ws + WS_DEC); bf16_t* KVT = (bf16_t*)(F.ws + WS_KVT) + (size_t)item * 32768;
#pragma unroll
    for (int i = 0; i < 4; ++i) { const int q = tid + NTHR * i, t = q >> 5, c8 = q & 31; *(LAS u32x4*)(L + GA_VT + t * 576 + c8 * 16) = R.v[i]; }
#pragma unroll
    for (int i = 0; i < 2; ++i) { const int q = tid + NTHR * i, t = q >> 4, c8 = q & 15; *(LAS u32x4*)(L + GA_QS + t * 272 + c8 * 16) = R.q[i]; *(LAS u32x4*)(L + GA_KS + t * 272 + c8 * 16) = R.k[i]; }
    if (tid < 256) *(LAS f32x4*)(L + GA_LR + tid * 16) = R.lr;
    __syncthreads();
    if (next_item >= 0) gla_prep_load(F, next_item, R);
    const int d = tid & 127, tq = tid >> 7, gd = h * 128 + d;
    float gw[16];
#pragma unroll
    for (int r = 0; r < 16; ++r) gw[r] = a.in[18][(size_t)j * 8192 + r * 512 + gd];
    const float gb = a.in[19][j * 512 + gd];
    float bl[16]; float run = 0.f;
#pragma unroll
    for (int i = 0; i < 16; ++i) { const int t = 16 * tq + i; const LAS f32x4* lp = (const LAS f32x4*)(L + GA_LR + t * 64); float z = gb;
#pragma unroll
        for (int r4 = 0; r4 < 4; ++r4) { const f32x4 x = lp[r4]; z = fmaf(x.x, gw[4 * r4], z); z = fmaf(x.y, gw[4 * r4 + 1], z); z = fmaf(x.z, gw[4 * r4 + 2], z); z = fmaf(x.w, gw[4 * r4 + 3], z); }
        run += fast_logsigm(z) * (1.f / 16.f); bl[i] = run; }
    LAS float* QT = (LAS float*)(L + GA_QT);
    QT[tq * 128 + d] = run;
    __syncthreads();
    float offs = 0.f, blast = 0.f;
#pragma unroll
    for (int q = 0; q < 4; ++q) { const float v = QT[q * 128 + d]; blast += v; if (q < tq) offs += v; }
    if (tq == 0) DEC[(size_t)item * 128 + d] = fast_exp(blast);
    { LAS bf16_t* qs = (LAS bf16_t*)(L + GA_QS); LAS bf16_t* ks_ = (LAS bf16_t*)(L + GA_KS);
      unsigned ks[8];
#pragma unroll
      for (int i = 0; i < 16; i += 2) {
          float kst[2];
#pragma unroll
          for (int u = 0; u < 2; ++u) { const int t = 16 * tq + i + u; const float bb = bl[i + u] + offs;
              const float qv = bf2f(qs[t * 136 + d]), kv = bf2f(ks_[t * 136 + d]); const float eb = fast_exp(bb);
              qs[t * 136 + d] = (bf16_t)f2bf(qv * GLA_QS * eb); ks_[t * 136 + d] = (bf16_t)f2bf(kv * __builtin_amdgcn_rcpf(eb)); kst[u] = kv * fast_exp(blast - bb); }
          ks[i >> 1] = cvt_pk_bf16(kst[0], kst[1]); }
      *(LAS u32x4*)(L + GA_KST + d * 144 + tq * 32) = (u32x4){ks[0], ks[1], ks[2], ks[3]};
      *(LAS u32x4*)(L + GA_KST + d * 144 + tq * 32 + 16) = (u32x4){ks[4], ks[5], ks[6], ks[7]}; }
    __syncthreads();
#pragma unroll
    for (int i = 0; i < 2; ++i) { const int q = tid + NTHR * i, t = q >> 4, c8 = q & 15; const size_t go = (size_t)(r0 + t) * 512 + h * 128 + c8 * 8;
        *(GAS u32x4*)(GQ + go) = *(const LAS u32x4*)(L + GA_QS + t * 272 + c8 * 16); *(GAS u32x4*)(GK + go) = *(const LAS u32x4*)(L + GA_KS + t * 272 + c8 * 16); }
    const int r = lane & 31, hh = lane >> 5, g = lane >> 4, i16 = lane & 15;
    f32x16 acc[4];
#pragma unroll
    for (int nb = 0; nb < 4; ++nb) acc[nb] = zero16();
#pragma unroll
    for (int s = 0; s < 4; ++s) {
        const LAS unsigned char* vp = L + GA_VT + (16 * s + 8 * (g >> 1) + (i16 >> 2)) * 576 + (32 * w + 16 * (g & 1) + 4 * (i16 & 3)) * 2;
        const s16x4 lo = tr16(vp), hi4 = tr16(vp + 4 * 576);
        const bf16x8 af = (bf16x8){lo[0], lo[1], lo[2], lo[3], hi4[0], hi4[1], hi4[2], hi4[3]};
#pragma unroll
        for (int nb = 0; nb < 4; ++nb) { const bf16x8 bf = *(const LAS bf16x8*)(L + GA_KST + (32 * nb + r) * 144 + (16 * s + 8 * hh) * 2); acc[nb] = MFMA32(af, bf, acc[nb]); }
    }
    __syncthreads();
#pragma unroll
    for (int nb = 0; nb < 4; ++nb)
#pragma unroll
        for (int rr = 0; rr < 16; ++rr) *(LAS bf16_t*)(L + GA_OUT + (32 * w + crow32(rr, hh)) * 272 + (32 * nb + r) * 2) = (bf16_t)f2bf(acc[nb][rr]);
    __syncthreads();
#pragma unroll
    for (int i = 0; i < 8; ++i) { const int q = tid + NTHR * i, dv = q >> 4, c8 = q & 15; *(GAS u32x4*)(KVT + (size_t)dv * 128 + c8 * 8) = *(const LAS u32x4*)(L + GA_OUT + dv * 272 + c8 * 16); }
    __syncthreads();
}

__device__ __forceinline__ void gla_state(Frame& F, int gtid) {
    const int bh = gtid >> 13, rem = gtid & 8191; const size_t eo = (size_t)(rem >> 5) * 128 + (rem & 31) * 4; const int dk0 = (rem & 31) * 4;
    const bf16_t* KVT = (const bf16_t*)(F.ws + WS_KVT) + (size_t)bh * 64 * 32768 + eo; bf16_t* SNT = (bf16_t*)(F.ws + WS_SNT) + (size_t)bh * 64 * 32768 + eo;
    const float* DEC = (const float*)(F.ws + WS_DEC) + (size_t)bh * 64 * 128 + dk0;
    f32x4 s = (f32x4){0.f, 0.f, 0.f, 0.f};
    for (int n0 = 0; n0 < 64; n0 += 8) {
        u32x2 kv[8]; f32x4 dc[8];
#pragma unroll
        for (int u = 0; u < 8; ++u) { kv[u] = *(const GAS u32x2*)(KVT + (size_t)(n0 + u) * 32768); dc[u] = *(const GAS f32x4*)(DEC + (size_t)(n0 + u) * 128); }
#pragma unroll
        for (int u = 0; u < 8; ++u) { u32x2 o; o.x = cvt_pk_bf16(s.x, s.y); o.y = cvt_pk_bf16(s.z, s.w); *(GAS u32x2*)(SNT + (size_t)(n0 + u) * 32768) = o;
            s.x = dc[u].x * s.x + bflo(kv[u].x); s.y = dc[u].y * s.y + bfhi(kv[u].x); s.z = dc[u].z * s.z + bflo(kv[u].y); s.w = dc[u].w * s.w + bfhi(kv[u].y); }
    }
}

constexpr int GC_QD = 0;
constexpr int GC_KI = 17408;
constexpr int GC_VT = 34816;
constexpr int GC_XT = GC_VT + 36864;
constexpr int GC_GT = GC_XT + 9216;
constexpr int GC_SQ = GC_GT + 33792;
constexpr int GC_HN = GC_SQ + 2048;
static_assert(GC_HN + 1024 <= RING_BYTES, "gla lds");
struct GlaOutRegs { u32x4 qd[2], ki[2], vt[4], gt[4]; bf16x8 sn[8]; };
__device__ __forceinline__ void gla_out_load(Frame& F, int item, GlaOutRegs& R) {
    const int tid = F.tid, lane = F.lane, w = F.wave; const int bh = item >> 6, n = item & 63, b = bh >> 2, h = bh & 3; const int r0 = b * SEQ + n * 64;
    const bf16_t* GQ = (const bf16_t*)(F.ws + WS_GQ); const bf16_t* GK = (const bf16_t*)(F.ws + WS_GK); const bf16_t* GV = (const bf16_t*)(F.ws + WS_GV); const bf16_t* GG = (const bf16_t*)(F.ws + WS_GG);
    const bf16_t* SNT = (const bf16_t*)(F.ws + WS_SNT) + (size_t)item * 32768;
#pragma unroll
    for (int i = 0; i < 2; ++i) { const int q = tid + NTHR * i, t = q >> 4, c8 = q & 15; const size_t go = (size_t)(r0 + t) * 512 + h * 128 + c8 * 8; R.qd[i] = *(const GAS u32x4*)(GQ + go); R.ki[i] = *(const GAS u32x4*)(GK + go); }
#pragma unroll
    for (int i = 0; i < 4; ++i) { const int q = tid + NTHR * i, t = q >> 5, c8 = q & 31; const size_t go = (size_t)(r0 + t) * 1024 + h * 256 + c8 * 8; R.vt[i] = *(const GAS u32x4*)(GV + go); R.gt[i] = *(const GAS u32x4*)(GG + go); }
    const int r = lane & 31, hh = lane >> 5;
#pragma unroll
    for (int s = 0; s < 8; ++s) R.sn[s] = *(const GAS bf16x8*)(SNT + (size_t)(32 * w + r) * 128 + 16 * s + 8 * hh);
}
__device__ __forceinline__ void gla_out(Frame& F, const Args& a, int j, int item, int next_item, GlaOutRegs& R) {
    const int tid = F.tid, lane = F.lane, w = F.wave; LAS unsigned char* L = F.lds;
    const int bh = item >> 6, n = item & 63, b = bh >> 2, h = bh & 3; const int r0 = b * SEQ + n * 64;
    bf16_t* OG = (bf16_t*)(F.ws + WS_OG);
#pragma unroll
    for (int i = 0; i < 2; ++i) { const int q = tid + NTHR * i, t = q >> 4, c8 = q & 15; *(LAS u32x4*)(L + GC_QD + t * 272 + c8 * 16) = R.qd[i]; *(LAS u32x4*)(L + GC_KI + t * 272 + c8 * 16) = R.ki[i]; }
#pragma unroll
    for (int i = 0; i < 4; ++i) { const int q = tid + NTHR * i, t = q >> 5, c8 = q & 31; *(LAS u32x4*)(L + GC_VT + t * 576 + c8 * 16) = R.vt[i]; *(LAS u32x4*)(L + GC_GT + t * 528 + c8 * 16) = R.gt[i]; }
    __syncthreads();
    const int r = lane & 31, hh = lane >> 5, g = lane >> 4, i16 = lane & 15;
    if (w < 4) {
        const int jb = w >> 1, ib = w & 1;
        f32x16 x = zero16();
        if (!(jb == 1 && ib == 0)) {
#pragma unroll
            for (int s = 0; s < 8; ++s) { const bf16x8 af = *(const LAS bf16x8*)(L + GC_KI + (32 * jb + r) * 272 + (16 * s + 8 * hh) * 2), bf = *(const LAS bf16x8*)(L + GC_QD + (32 * ib + r) * 272 + (16 * s + 8 * hh) * 2);
                x = MFMA32(af, bf, x); }
        }
        const int i = 32 * ib + r;
#pragma unroll
        for (int q4 = 0; q4 < 4; ++q4) { float v[4];
#pragma unroll
            for (int q = 0; q < 4; ++q) { const int jj = 32 * jb + 8 * q4 + 4 * hh + q; v[q] = (jj <= i) ? x[4 * q4 + q] : 0.f; }
            u32x2 o; o.x = cvt_pk_bf16(v[0], v[1]); o.y = cvt_pk_bf16(v[2], v[3]);
            *(LAS u32x2*)(L + GC_XT + i * 144 + (32 * jb + 8 * q4 + 4 * hh) * 2) = o; }
    }
    f32x16 acc[2]; acc[0] = zero16(); acc[1] = zero16();
#pragma unroll
    for (int s = 0; s < 8; ++s) {
#pragma unroll
        for (int ib = 0; ib < 2; ++ib) { const bf16x8 bf = *(const LAS bf16x8*)(L + GC_QD + (32 * ib + r) * 272 + (16 * s + 8 * hh) * 2); acc[ib] = MFMA32(R.sn[s], bf, acc[ib]); } }
    if (next_item >= 0) gla_out_load(F, next_item, R);
    __syncthreads();
#pragma unroll
    for (int s = 0; s < 4; ++s) {
        const LAS unsigned char* vp = L + GC_VT + (16 * s + 8 * (g >> 1) + (i16 >> 2)) * 576 + (32 * w + 16 * (g & 1) + 4 * (i16 & 3)) * 2;
        const s16x4 lo = tr16(vp), hi4 = tr16(vp + 4 * 576);
        const bf16x8 af = (bf16x8){lo[0], lo[1], lo[2], lo[3], hi4[0], hi4[1], hi4[2], hi4[3]};
#pragma unroll
        for (int ib = 0; ib < 2; ++ib) { const bf16x8 bf = *(const LAS bf16x8*)(L + GC_XT + (32 * ib + r) * 144 + (16 * s + 8 * hh) * 2); acc[ib] = MFMA32(af, bf, acc[ib]); } }
    LAS float* SQ = (LAS float*)(L + GC_SQ);
#pragma unroll
    for (int ib = 0; ib < 2; ++ib) { float s2 = 0.f;
#pragma unroll
        for (int rr = 0; rr < 16; ++rr) s2 += acc[ib][rr] * acc[ib][rr];
        s2 += __shfl_xor(s2, 32);
        if (hh == 0) SQ[w * 64 + 32 * ib + r] = s2; }
    __syncthreads();
    const LAS float* hn = (const LAS float*)(L + GC_HN);
#pragma unroll
    for (int ib = 0; ib < 2; ++ib) { const int i = 32 * ib + r; float tot = 0.f;
#pragma unroll
        for (int ww = 0; ww < 8; ++ww) tot += SQ[ww * 64 + i];
        const float inv = 1.0f / sqrtf(tot * (1.f / 256.f) + EPS);
#pragma unroll
        for (int q4 = 0; q4 < 4; ++q4) { const int dv = 32 * w + 8 * q4 + 4 * hh; LAS u32x2* gp = (LAS u32x2*)(L + GC_GT + i * 528 + dv * 2);
            const u32x2 gv = *gp; const f32x4 hw = *(const LAS f32x4*)(hn + dv);
            const float o0 = acc[ib][4 * q4 + 0] * inv * hw.x * fast_silu(bflo(gv.x)), o1 = acc[ib][4 * q4 + 1] * inv * hw.y * fast_silu(bfhi(gv.x));
            const float o2 = acc[ib][4 * q4 + 2] * inv * hw.z * fast_silu(bflo(gv.y)), o3 = acc[ib][4 * q4 + 3] * inv * hw.w * fast_silu(bfhi(gv.y));
            u32x2 o; o.x = cvt_pk_bf16(o0, o1); o.y = cvt_pk_bf16(o2, o3); *gp = o; } }
    __syncthreads();
    for (int q = tid; q < 2048; q += NTHR) { const int t = q >> 5, c8 = q & 31; *(GAS u32x4*)(OG + (size_t)(r0 + t) * 1024 + h * 256 + c8 * 8) = *(const LAS u32x4*)(L + GC_GT + t * 528 + c8 * 16); }
    __syncthreads();
}
}
namespace fk {
constexpr int RP_TAB = 0;
constexpr int RP_SEL = 32768;
__device__ __forceinline__ void router_rows(Frame& F, const Args& a, int j, int rb, const f32x4 (&gk)[4]) {
    const int lane = F.lane, w = F.wave; LAS unsigned char* L = F.lds;
    const float* H = (const float*)(F.ws + WS_H); unsigned char* XN = (unsigned char*)(F.ws + WS_XN);
    LAS int* SEL = (LAS int*)(L + RP_SEL); LAS float* SELW = (LAS float*)(L + RP_SEL + 512);
    for (int rr = 0; rr < 8; ++rr) { const int lrow = w * 8 + rr, m = rb * 64 + lrow;
        RowV r; row_load(r, H + (size_t)m * D, lane);
        const float ss = row_sumsq(r); const float inv = 1.0f / sqrtf(ss * (1.f / D) + EPS);
        float lg[8]; row_dots<8>(r, (const LAS float*)(L + RP_TAB), lane, lg);
#pragma unroll
        for (int e = 0; e < 8; ++e) lg[e] *= inv;
        int i1 = 0; float v1 = lg[0];
#pragma unroll
        for (int e = 1; e < 8; ++e) if (lg[e] > v1) { v1 = lg[e]; i1 = e; }
        int i2 = -1; float v2 = -INFINITY;
#pragma unroll
        for (int e = 0; e < 8; ++e) if (e != i1 && (i2 < 0 || lg[e] > v2)) { v2 = lg[e]; i2 = e; }
        const float w1 = 1.f / (1.f + expf(v2 - v1)), w2 = 1.f - w1;
        if (lane == 0) { SEL[lrow * 2] = i1; SEL[lrow * 2 + 1] = i2; SELW[lrow * 2] = w1; SELW[lrow * 2 + 1] = w2; }
#pragma unroll
        for (int jj = 0; jj < 4; ++jj) r.v[jj] = r.v[jj] * gk[jj] * inv;
        row_store_fp8(r, XN + (size_t)m * D, lane);
    }
    __syncthreads();
    if (w == 0) {
        unsigned* cnt = (unsigned*)(F.ctl + CW_CNT + 64 * j);
        int* TS = (int*)(F.ws + WS_RT + RT_TS); float* TW = (float*)(F.ws + WS_RT + RT_TW); int* TL = (int*)(F.ws + WS_RT + RT_TL);
        const int e0 = SEL[lane * 2], e1 = SEL[lane * 2 + 1]; const int m = rb * 64 + lane;
        int p0 = 0, p1 = 0;
#pragma unroll
        for (int e = 0; e < 8; ++e) {
            const unsigned long long m0 = __ballot(e0 == e), m1 = __ballot(e1 == e);
            const int c0 = __popcll(m0), c1 = __popcll(m1);
            unsigned base = 0;
            if (lane == 0 && (c0 + c1) > 0) base = __hip_atomic_fetch_add(cnt + e, (unsigned)(c0 + c1), RLX_AGENT);
            base = __shfl(base, 0);
            const unsigned long long lt = (1ull << lane) - 1ull;
            if (e0 == e) p0 = (int)base + __popcll(m0 & lt);
            if (e1 == e) p1 = (int)base + c0 + __popcll(m1 & lt);
        }
        TL[e0 * T + p0] = m; TL[e1 * T + p1] = m;
        TS[m * 2] = e0 * T + p0; TS[m * 2 + 1] = e1 * T + p1;
        TW[m * 2] = SELW[lane * 2]; TW[m * 2 + 1] = SELW[lane * 2 + 1];
    }
    __syncthreads();
}
constexpr int ROWTAB_OFF = RING_BYTES + 1024;
static_assert(ROWTAB_OFF + 15 * 1024 <= LDS_BYTES, "row table");
constexpr int MT_OFF = MISC_OFF + 256;
__device__ __forceinline__ void moe_tables(Frame& F, int j) {
    LAS int* tab = (LAS int*)(F.lds + MT_OFF);
    if (F.tid == 0) { const unsigned* cnt = (const unsigned*)(F.ctl + CW_CNT + 64 * j); int run = 0;
        for (int e = 0; e < 8; ++e) { const int c = (int)__hip_atomic_load(cnt + e, RLX_AGENT); tab[16 + e] = c; tab[e] = run; run += (c + 255) >> 8; }
        tab[8] = run; }
    __syncthreads();
}
__device__ __forceinline__ void combine_rows(Frame& F, const Args& a, int j, bool last) {
    const LAS int* tab = (const LAS int*)(F.lds + MT_OFF);
    float* H = (float*)(F.ws + WS_H); bf16_t* HB = (bf16_t*)(F.ws + WS_HB); float* ssa = (float*)(F.ws + WS_SMALL + SM_SSA); float* flog = (float*)(F.ws + WS_ESM + ES_FLOG);
    const int* TS = (const int*)(F.ws + WS_RT + RT_TS); const float* TW = (const float*)(F.ws + WS_RT + RT_TW); const bf16_t* YM = (const bf16_t*)(F.ws + WS_YM); const bf16_t* YM1 = (const bf16_t*)(F.ws + WS_YM1);
    const LAS float* Wl = (const LAS float*)(F.lds);
    const int gw = F.vcu * NWAVES + F.wave, NGW = F.G * NWAVES, lane = F.lane;
    f32x4 gf[4];
#pragma unroll
    for (int jj = 0; jj < 4; ++jj) gf[jj] = last ? *(const GAS f32x4*)(a.in[3] + 4 * lane + 256 * jj) : (f32x4){0.f, 0.f, 0.f, 0.f};
    for (int m = gw; m < T; m += NGW) {
        RowV r; row_load(r, H + (size_t)m * D, lane);
        const int s0 = TS[m * 2], s1 = TS[m * 2 + 1]; const float w0 = TW[m * 2], w1 = TW[m * 2 + 1];
        const int sl0 = 256 * tab[s0 >> 14] + (s0 & 16383), sl1 = 256 * tab[s1 >> 14] + (s1 & 16383);
        const GAS u32x2* y0 = (const GAS u32x2*)(YM + (size_t)sl0 * D) + lane; const GAS u32x2* y1 = (const GAS u32x2*)(YM + (size_t)sl1 * D) + lane;
        const GAS u32x2* z0 = (const GAS u32x2*)(YM1 + (size_t)sl0 * D) + lane; const GAS u32x2* z1 = (const GAS u32x2*)(YM1 + (size_t)sl1 * D) + lane;
#pragma unroll
        for (int jj = 0; jj < 4; ++jj) { const u32x2 a0 = y0[64 * jj], a1 = y1[64 * jj], b0 = z0[64 * jj], b1 = z1[64 * jj];
            r.v[jj].x += w0 * (bflo(a0.x) + bflo(b0.x)) + w1 * (bflo(a1.x) + bflo(b1.x)); r.v[jj].y += w0 * (bfhi(a0.x) + bfhi(b0.x)) + w1 * (bfhi(a1.x) + bfhi(b1.x));
            r.v[jj].z += w0 * (bflo(a0.y) + bflo(b0.y)) + w1 * (bflo(a1.y) + bflo(b1.y)); r.v[jj].w += w0 * (bfhi(a0.y) + bfhi(b0.y)) + w1 * (bfhi(a1.y) + bfhi(b1.y)); }
        const float ss = row_sumsq(r); const float inv = 1.0f / sqrtf(ss * (1.f / D) + EPS);
        if (!last) {
            row_store_f32(r, H + (size_t)m * D, lane); row_store_bf16(r, HB + (size_t)m * D, lane);
            if (lane == 0) ssa[m] = ss;
            float dts[8]; row_dots<8>(r, Wl, lane, dts);
            if (lane < 8) { float v = dts[0];
#pragma unroll
                for (int c = 1; c < 8; ++c) v = (lane == c) ? dts[c] : v;
                flog[m * 8 + lane] = v * inv; }
        } else {
#pragma unroll
            for (int jj = 0; jj < 4; ++jj) r.v[jj] = r.v[jj] * gf[jj] * inv;
            row_store_f32(r, a.out + (size_t)m * D, lane);
        }
    }
}

#ifndef PHMASK
#define PHMASK 0xffff
#endif
#define PHC(k) (((PHMASK) >> (k)) & 1)
#ifndef PHREP
#define PHREP 0
#endif
#define REPK(k) (((PHREP) >> (k)) & 1)
constexpr int PH_PER_PAIR = 15, N_PHASES = 1 + 2 * PH_PER_PAIR;
#define IN(k) (lo <= (k) && (k) < hi)
#ifndef SEAM_REP
#define SEAM_REP 1
#endif
#define SEAM(k) do { if (IN(k) && IN((k) + 1)) { for (int sr_ = 0; sr_ < SEAM_REP; ++sr_) xcd_barrier(bar); } } while (0)

template <int J> __device__ __forceinline__ void pair_body(Frame& F, const Args& args, const int lo, const int hi, const XcdBarrier& bar, unsigned char* lds_raw) {
    constexpr int j = J, pb = 1 + J * PH_PER_PAIR;
    const int cblk = (int)blockIdx.x;
    float* H = (float*)(F.ws + WS_H); bf16_t* HB = (bf16_t*)(F.ws + WS_HB);
    float* SSA = (float*)(F.ws + WS_SMALL + SM_SSA);
    unsigned long long* SSB = (unsigned long long*)(F.ws + CTL_SS) + (size_t)j * T; unsigned long long* SSC = (unsigned long long*)(F.ws + CTL_SS) + (size_t)(2 + j) * T;
    if (PHC(0) && IN(pb + 0)) { auto body_ = [&]() { Frame Fq_ = F; { int t_ = threadIdx.x; asm volatile("" : "+v"(t_)); Fq_.tid = t_; Fq_.lane = t_ & 63; } Frame& F = Fq_;
        pg8::DenseSched S; S.init(HB, (const bf16_t*)(F.ws + WS_WINE) + (size_t)j * 2560 * D, T, 2560, D, F.G, cblk);
        pg8::EpiProj<0> E{pg8::SumSq{SSA, nullptr}, (bf16_t*)(F.ws + WS_XR), 512, C2, nullptr};
        pg8::gemm_phase<pg8::EpiProj<0>, pg8::DenseSched, true, true>(F.lds, D, D, S, E);
    }; body_(); if (REPK(0)) body_(); }
    SEAM(pb + 0);
    if (PHC(1) && IN(pb + 1)) { auto body_ = [&]() { Frame Fq_ = F; { int t_ = threadIdx.x; asm volatile("" : "+v"(t_)); Fq_.tid = t_; Fq_.lane = t_ & 63; } Frame& F = Fq_;
        for (int tk = F.vcu * NWAVES + F.wave; tk < 2048; tk += F.G * NWAVES) lru_wave_task(F, args, j, tk);
        __syncthreads();
        for (int it = F.vcu; it < 32; it += F.G) fox_cumsum(F, args, j, it);
    }; body_(); if (REPK(1)) body_(); }
    SEAM(pb + 1);
    if (PHC(2) && IN(pb + 2)) { auto body_ = [&]() { Frame Fq_ = F; { int t_ = threadIdx.x; asm volatile("" : "+v"(t_)); Fq_.tid = t_; Fq_.lane = t_ & 63; } Frame& F = Fq_;
        for (int p = F.vcu; p < 256; p += F.G) { const int bh = p >> 3, s = p & 7; const float* cp = (const float*)(F.ws + WS_ESM + ES_CP) + (size_t)bh * SEQ; const float kmax = ((const float*)(F.ws + WS_SMALL + SM_KMAX))[bh];
            attn_body::attn_unit<8>(bh >> 3, bh & 7, s, (const attn_body::bf16*)(F.ws + WS_Q), (const attn_body::bf16*)(F.ws + WS_K), (const attn_body::bf16*)(F.ws + WS_V), (attn_body::bf16*)(F.ws + WS_Y), cp, kmax, (char*)lds_raw);
            attn_body::attn_unit<8>(bh >> 3, bh & 7, 15 - s, (const attn_body::bf16*)(F.ws + WS_Q), (const attn_body::bf16*)(F.ws + WS_K), (const attn_body::bf16*)(F.ws + WS_V), (attn_body::bf16*)(F.ws + WS_Y), cp, kmax, (char*)lds_raw); }
        __syncthreads();
        for (int it = F.vcu; it < 256; it += F.G) lru_fixup(F, it >> 6, it & 63);
    }; body_(); if (REPK(2)) body_(); }
    SEAM(pb + 2);
    if (PHC(3) && IN(pb + 3)) { auto body_ = [&]() { Frame Fq_ = F; { int t_ = threadIdx.x; asm volatile("" : "+v"(t_)); Fq_.tid = t_; Fq_.lane = t_ & 63; } Frame& F = Fq_;
        pg8::DenseSched S; S.init((const bf16_t*)(F.ws + WS_Y), (const bf16_t*)(F.ws + WS_WOUTE) + (size_t)j * D * D, T, D, D, F.G, cblk);
        pg8::EpiRes E{j == 0 ? args.in[0] : H, H, FFN_UP_FP8 ? nullptr : HB, SSB, FFN_UP_FP8 ? (unsigned char*)(F.ws + WS_HB8) : nullptr};
        pg8::gemm_phase<pg8::EpiRes, pg8::DenseSched, false, true>(F.lds, D, D, S, E);
    }; body_(); if (REPK(3)) body_(); }
    SEAM(pb + 3);
    if (PHC(4) && IN(pb + 4)) { auto body_ = [&]() { Frame Fq_ = F; { int t_ = threadIdx.x; asm volatile("" : "+v"(t_)); Fq_.tid = t_; Fq_.lane = t_ & 63; } Frame& F = Fq_;
#if FFN_UP_FP8
        pg8::DenseSched S; S.init(F.ws + WS_HB8, (const unsigned char*)(F.ws + WS_W13F) + (size_t)j * 2 * DFF * D, T, 2 * DFF, D, F.G, cblk, 1);
        pg8::EpiGlu E{pg8::SumSq{nullptr, SSB}, (void*)(F.ws + WS_HF), DFF};
        pg8::gemm_phase<pg8::EpiGlu, pg8::DenseSched, true, true, 1>(F.lds, D, D, S, E, W13_SCALE);
#else
        pg8::DenseSched S; S.init(HB, (const bf16_t*)(F.ws + WS_W13F) + (size_t)j * 2 * DFF * D, T, 2 * DFF, D, F.G, cblk);
        pg8::EpiGlu E{pg8::SumSq{nullptr, SSB}, (void*)(F.ws + WS_HF), DFF};
        pg8::gemm_phase<pg8::EpiGlu, pg8::DenseSched, true, true>(F.lds, D, D, S, E);
#endif
    }; body_(); if (REPK(4)) body_(); }
    SEAM(pb + 4);
    if (PHC(5) && IN(pb + 5)) { auto body_ = [&]() { Frame Fq_ = F; { int t_ = threadIdx.x; asm volatile("" : "+v"(t_)); Fq_.tid = t_; Fq_.lane = t_ & 63; } Frame& F = Fq_;
        pg8::DenseSched S; S.init((const bf16_t*)(F.ws + WS_HF), (const bf16_t*)(F.ws + WS_W2F) + (size_t)j * D * DFF, T, D, DFF, F.G, cblk);
        pg8::EpiRes E{H, H, HB, SSC, nullptr};
        pg8::gemm_phase<pg8::EpiRes, pg8::DenseSched, false, true>(F.lds, DFF, DFF, S, E);
    }; body_(); if (REPK(5)) body_(); }
    SEAM(pb + 5);
    if (PHC(6) && IN(pb + 6)) { auto body_ = [&]() { Frame Fq_ = F; { int t_ = threadIdx.x; asm volatile("" : "+v"(t_)); Fq_.tid = t_; Fq_.lane = t_ & 63; } Frame& F = Fq_;
        convert_experts(F, args, j); __syncthreads();
        for (int rb = F.vcu; rb < 256; rb += F.G) skinny_lr(F, j, rb, pg8::SumSq{nullptr, SSC});
        pg8::DenseSched S; S.init(HB, (const bf16_t*)(F.ws + WS_WINO) + (size_t)j * 3072 * D, T, 3072, D, F.G, cblk);
        pg8::EpiProj<1> E{pg8::SumSq{nullptr, SSC}, (bf16_t*)(F.ws + WS_GQ), 512, 1.f, nullptr};
        pg8::gemm_phase<pg8::EpiProj<1>, pg8::DenseSched, true, true>(F.lds, D, D, S, E);
    }; body_(); if (REPK(6)) body_(); }
    SEAM(pb + 6);
    if (PHC(7) && IN(pb + 7)) { auto body_ = [&]() { Frame Fq_ = F; { int t_ = threadIdx.x; asm volatile("" : "+v"(t_)); Fq_.tid = t_; Fq_.lane = t_ & 63; } Frame& F = Fq_;     GlaPrepRegs R; if (F.vcu < 1024) gla_prep_load(F, F.vcu, R); for (int it = F.vcu; it < 1024; it += F.G) gla_prep(F, args, j, it, it + F.G < 1024 ? it + F.G : -1, R); }; body_(); if (REPK(7)) body_(); }
    SEAM(pb + 7);
    if (PHC(8) && IN(pb + 8)) { auto body_ = [&]() { Frame Fq_ = F; { int t_ = threadIdx.x; asm volatile("" : "+v"(t_)); Fq_.tid = t_; Fq_.lane = t_ & 63; } Frame& F = Fq_;     for (int g = F.vcu * NTHR + F.tid; g < 131072; g += F.G * NTHR) gla_state(F, g); }; body_(); if (REPK(8)) body_(); }
    SEAM(pb + 8);
    if (PHC(9) && IN(pb + 9)) { auto body_ = [&]() { Frame Fq_ = F; { int t_ = threadIdx.x; asm volatile("" : "+v"(t_)); Fq_.tid = t_; Fq_.lane = t_ & 63; } Frame& F = Fq_;     GlaOutRegs R; int cur_h = -1; if (F.vcu < 1024) gla_out_load(F, F.vcu, R); for (int it = F.vcu; it < 1024; it += F.G) { const int ih = (it >> 6) & 3; if (ih != cur_h) { __syncthreads(); if (F.tid < 256) ((LAS float*)(F.lds + GC_HN))[F.tid] = args.in[20][j * 1024 + ih * 256 + F.tid]; cur_h = ih; }     gla_out(F, args, j, it, it + F.G < 1024 ? it + F.G : -1, R); } }; body_(); if (REPK(9)) body_(); }
    SEAM(pb + 9);
    if (PHC(10) && IN(pb + 10)) { auto body_ = [&]() { Frame Fq_ = F; { int t_ = threadIdx.x; asm volatile("" : "+v"(t_)); Fq_.tid = t_; Fq_.lane = t_ & 63; } Frame& F = Fq_;
        pg8::DenseSched S; S.init((const bf16_t*)(F.ws + WS_OG), (const bf16_t*)(F.ws + WS_WOUTO) + (size_t)j * D * D, T, D, D, F.G, cblk);
        pg8::EpiRes E{H, H, nullptr, nullptr, nullptr};
        pg8::gemm_phase<pg8::EpiRes, pg8::DenseSched, false, true>(F.lds, D, D, S, E);
    }; body_(); if (REPK(10)) body_(); }
    SEAM(pb + 10);
    if (PHC(11) && IN(pb + 11)) { auto body_ = [&]() { Frame Fq_ = F; { int t_ = threadIdx.x; asm volatile("" : "+v"(t_)); Fq_.tid = t_; Fq_.lane = t_ & 63; } Frame& F = Fq_;
        stage_table8(F, (LAS float*)(F.lds + RP_TAB), args.in[22] + (size_t)j * D * 8, 8, 0, args.in[2] + (2 * j + 1) * D);
        f32x4 gk[4];
#pragma unroll
        for (int jj = 0; jj < 4; ++jj) gk[jj] = *(const GAS f32x4*)(args.in[2] + (2 * j + 1) * D + 4 * F.lane + 256 * jj);
        for (int rb = F.vcu; rb < 256; rb += F.G) router_rows(F, args, j, rb, gk);
    }; body_(); if (REPK(11)) body_(); }
    SEAM(pb + 11);
    if (IN(pb + 12) || IN(pb + 13) || IN(pb + 14)) moe_tables(F, j);
    const LAS int* tab = (const LAS int*)(F.lds + MT_OFF);
    if (PHC(12) && IN(pb + 12)) { auto body_ = [&]() { Frame Fq_ = F; { int t_ = threadIdx.x; asm volatile("" : "+v"(t_)); Fq_.tid = t_; Fq_.lane = t_ & 63; } Frame& F = Fq_;
        pg8::MoeSched<true> S; S.A = (const char*)(F.ws + WS_XN); S.Bt = (const char*)(F.ws + WS_W13E); S.nM = __builtin_amdgcn_readfirstlane(tab[8]); S.nN = 2 * DFE / 256; S.G = F.G; S.c = cblk;
        S.tstepA = 0; S.tstepB = (size_t)256 * D; S.estride = (size_t)2 * DFE * D; S.K2 = D; S.ncol = 2 * DFE / 256; S.ksoff = 0; S.tab = tab; S.TL = (const int*)(F.ws + WS_RT + RT_TL); S.rowtab = (const LAS unsigned*)(F.lds + ROWTAB_OFF); S.fill_rows((LAS unsigned*)(F.lds + ROWTAB_OFF));
        pg8::EpiGluT<true> E{pg8::SumSq{nullptr, nullptr}, (void*)(F.ws + WS_HM), DFE};
        pg8::gemm_phase<pg8::EpiGluT<true>, pg8::MoeSched<true>, true, true, 1>(F.lds, D, D, S, E, W13_SCALE);
    }; body_(); if (REPK(12)) body_(); }
    SEAM(pb + 12);
    if (PHC(13) && IN(pb + 13)) { auto body_ = [&]() { Frame Fq_ = F; { int t_ = threadIdx.x; asm volatile("" : "+v"(t_)); Fq_.tid = t_; Fq_.lane = t_ & 63; } Frame& F = Fq_;
        pg8::MoeSched<false> S; S.A = (const char*)(F.ws + WS_HM); S.Bt = (const char*)(F.ws + WS_W2E); S.nM = __builtin_amdgcn_readfirstlane(tab[8]); S.nN = 2 * (D / 256); S.G = F.G; S.c = cblk;
        S.tstepA = (size_t)256 * DFE; S.tstepB = (size_t)256 * DFE; S.estride = (size_t)D * DFE; S.K2 = DFE; S.ncol = D / 256; S.ksoff = (size_t)(DFE / 2); S.tab = tab; S.TL = nullptr; S.rowtab = nullptr;
        pg8::EpiProj<3> E{pg8::SumSq{nullptr, nullptr}, (bf16_t*)(F.ws + WS_YM), D, 1.f, (bf16_t*)(F.ws + WS_YM1)};
        pg8::gemm_phase<pg8::EpiProj<3>, pg8::MoeSched<false>, true, true, 1>(F.lds, DFE / 2, DFE, S, E, W2_SCALE);
    }; body_(); if (REPK(13)) body_(); }
    SEAM(pb + 13);
    if (PHC(14) && IN(pb + 14)) { auto body_ = [&]() { Frame Fq_ = F; { int t_ = threadIdx.x; asm volatile("" : "+v"(t_)); Fq_.tid = t_; Fq_.lane = t_ & 63; } Frame& F = Fq_;
        if (j == 0) stage_table8(F, (LAS float*)(F.lds), args.in[4] + (size_t)D * EIN, EIN, 2560, args.in[1] + 2 * D);
        combine_rows(F, args, j, j == 1);
    }; body_(); if (REPK(14)) body_(); }
    if (j == 0) SEAM(pb + 14);
}

__global__ void __launch_bounds__(NTHR, 2) fwd(Args args) {
    extern __shared__ __attribute__((aligned(16))) unsigned char lds_raw[];
    Frame F;
    F.lds = (LAS unsigned char*)lds_raw; F.MISC = (volatile LAS unsigned*)(F.lds + MISC_OFF);
    F.tid = threadIdx.x; F.lane = F.tid & 63; F.wave = __builtin_amdgcn_readfirstlane(F.tid >> 6);
    F.G = gridDim.x; { const int bx = blockIdx.x; F.vcu = (F.G % 8 == 0) ? (bx % 8) * (F.G / 8) + bx / 8 : bx; }
    F.ws = args.ws; F.ctl = (gu32*)(args.ws + WS_CTL);
    for (int u = F.tid; u < (LDS_BYTES - RING_BYTES) / 4; u += NTHR) ((LAS unsigned*)(F.lds + RING_BYTES))[u] = 0u;
    __syncthreads();
    const int lo = args.ph_lo, hi = args.ph_hi;
    const bool multi = (hi - lo) > 1;
    XcdBarrier bar; bar.bar = (unsigned*)(F.ctl + CW_BAR); bar.x = 0; bar.st = nullptr;
    if (multi) bar = xcd_barrier_post((unsigned*)(F.ctl + CW_BAR), F.MISC + 8);
    if (PHC(15) && IN(0)) { convert_dense(F, args); __syncthreads(); p0_rows(F, args); }
    SEAM(0);
    pair_body<0>(F, args, lo, hi, bar, lds_raw);
    pair_body<1>(F, args, lo, hi, bar, lds_raw);
}
#undef IN
#undef SEAM
}
extern "C" void kernel_launch(void* const* d_in, const int* in_sizes, int n_in, void* d_out, int out_size, void* d_ws, size_t ws_size, hipStream_t stream) {
    static int grid = 0;
    if (grid == 0) {
        if (n_in != 26 || out_size != 16384 * 1024 || ws_size < (size_t)896 * 1024 * 1024) { fprintf(stderr, "kernel_launch: unexpected sizes n_in %d out %d ws %zu\n", n_in, out_size, ws_size); grid = -1; return; }
        int dev = 0, cus = 0, per_cu = 0;
        if (hipGetDevice(&dev) != hipSuccess || hipDeviceGetAttribute(&cus, hipDeviceAttributeMultiprocessorCount, dev) != hipSuccess) { grid = -1; return; }
        if (hipFuncSetAttribute((const void*)fk::fwd, hipFuncAttributeMaxDynamicSharedMemorySize, fk::LDS_BYTES) != hipSuccess) { fprintf(stderr, "kernel_launch: hipFuncSetAttribute failed\n"); grid = -1; return; }
        if (hipOccupancyMaxActiveBlocksPerMultiprocessor(&per_cu, (const void*)fk::fwd, fk::NTHR, fk::LDS_BYTES) != hipSuccess || per_cu < 1) fprintf(stderr, "kernel_launch: occupancy query says %d\n", per_cu);
        (void)hipGetLastError();
        grid = cus;
    }
    if (grid < 0) return;
    (void)hipMemsetAsync((char*)d_ws + fk::WS_CTL, 0, fk::CTL_ZERO_BYTES, stream);
    fk::Args a{};
    for (int i = 0; i < 26; ++i) a.in[i] = (const float*)d_in[i];
    a.out = (float*)d_out; a.ws = (unsigned char*)d_ws; a.ph_lo = 0; a.ph_hi = fk::N_PHASES;
    hipLaunchKernelGGL(fk::fwd, dim3(grid), dim3(fk::NTHR), fk::LDS_BYTES, stream, a);
#ifdef PROF_PHASES
    { const int plist[] = {PROF_PHASES};
      for (int r = 0; r < PROF_REP; ++r) for (int ph : plist) { a.ph_lo = ph; a.ph_hi = ph + 1; hipLaunchKernelGGL(fk::fwd, dim3(grid), dim3(fk::NTHR), fk::LDS_BYTES, stream, a); } }
#endif
}
```

```cpp
#include <hip/hip_runtime.h>
#include <cstdio>
#include <cstdint>
#include <hip/hip_bf16.h>
#include <cmath>
#ifndef BUILD_MODE
#define BUILD_MODE 0
#endif
#define GAS __attribute__((address_space(1)))
#define LAS __attribute__((address_space(3)))
typedef unsigned short bf16_t;
typedef short bf16x8 __attribute__((ext_vector_type(8)));
typedef short s16x4 __attribute__((ext_vector_type(4)));
typedef float f32x4 __attribute__((ext_vector_type(4)));
typedef float f32x2 __attribute__((ext_vector_type(2)));
typedef float f32x16 __attribute__((ext_vector_type(16)));
typedef unsigned u32x4 __attribute__((ext_vector_type(4)));
typedef unsigned u32x2 __attribute__((ext_vector_type(2)));
typedef int i32x8 __attribute__((ext_vector_type(8)));
typedef int i32x4 __attribute__((ext_vector_type(4)));
typedef GAS unsigned gu32;
#define RLX_AGENT __ATOMIC_RELAXED, __HIP_MEMORY_SCOPE_AGENT
#define LDS_WAIT() asm volatile("s_waitcnt lgkmcnt(0)" ::: "memory")
#define VM_WAIT() asm volatile("s_waitcnt vmcnt(0)" ::: "memory")
__device__ __forceinline__ unsigned cvt_pk_bf16(float lo, float hi) { unsigned r; asm volatile("v_cvt_pk_bf16_f32 %0, %1, %2" : "=v"(r) : "v"(lo), "v"(hi)); return r; }
__device__ __forceinline__ float bf2f(bf16_t v) { return __uint_as_float(((unsigned)v) << 16); }
__device__ __forceinline__ float bflo(unsigned w) { return __uint_as_float(w << 16); }
__device__ __forceinline__ float bfhi(unsigned w) { return __uint_as_float(w & 0xffff0000u); }
__device__ __forceinline__ float wave_sum(float v) {
#pragma unroll
    for (int o = 1; o < 64; o <<= 1) v += __shfl_xor(v, o);
    return v;
}
__device__ __forceinline__ float fast_exp(float x) { return __builtin_amdgcn_exp2f(x * 1.4426950408889634f); }
__device__ __forceinline__ float fast_sigm(float x) { return __builtin_amdgcn_rcpf(1.f + __builtin_amdgcn_exp2f(-x * 1.4426950408889634f)); }
__device__ __forceinline__ float fast_silu(float x) { return x * fast_sigm(x); }

#define XB_TMO      128
#define XB_XCNT(j)  (256  + 64 * (j))
#define XB_XSUB(j)  (1280 + 64 * (j))
#define XB_XGEN(j)  (2304 + 64 * (j))
#define XB_TOP      3328
#define XB_TOPGEN   3392
#define XCD_BAR_WORDS 3456
#define XB_SPIN_CAP (1u << 18)

__device__ __forceinline__ unsigned xb_ld(unsigned* p)              { return __hip_atomic_load(p, __ATOMIC_RELAXED, __HIP_MEMORY_SCOPE_AGENT); }
__device__ __forceinline__ unsigned xb_add(unsigned* p, unsigned v) { return __hip_atomic_fetch_add(p, v, __ATOMIC_RELAXED, __HIP_MEMORY_SCOPE_AGENT); }
__device__ __forceinline__ unsigned xb_xcc_id() { return (unsigned)__builtin_amdgcn_s_getreg((3 << 11) | 20) & 0xFu; }
#define XB_SPIN(cond, bar) do { unsigned _sp = 0; while (cond) { __builtin_amdgcn_s_sleep(1); \
    if ((++_sp & 255u) == 0u) { if (xb_ld(&(bar)[XB_TMO])) break; if (_sp > XB_SPIN_CAP) { atomicAdd(&(bar)[XB_TMO], 1u); break; } } } } while (0)

struct XcdBarrier {
    unsigned* bar; unsigned x;
    volatile LAS unsigned* st;
};
__device__ __forceinline__ XcdBarrier xcd_barrier_post(unsigned* bar, volatile LAS unsigned* st) {
    XcdBarrier b; b.bar = bar; b.x = xb_xcc_id(); b.st = st;
    if (threadIdx.x == 0) (void)xb_add(&bar[XB_XCNT(b.x)], 1u);
    return b;
}
__device__ __forceinline__ void xcd_barrier_complete(unsigned* bar, unsigned x, unsigned& nloc, unsigned& nx) {
    const unsigned G = gridDim.x * gridDim.y * gridDim.z;
    unsigned sum, cnt, mine, sp = 0u;
    for (;;) {
        sum = 0u; cnt = 0u; mine = 0u;
#pragma unroll
        for (unsigned j = 0; j < 16; ++j) { const unsigned c = xb_ld(&bar[XB_XCNT(j)]); sum += c; cnt += (c > 0u) ? 1u : 0u; mine = (j == x) ? c : mine; }
        if (sum == G) break;
        __builtin_amdgcn_s_sleep(1);
        if ((++sp & 255u) == 0u) { if (xb_ld(&bar[XB_TMO])) break; if (sp > XB_SPIN_CAP) { atomicAdd(&bar[XB_TMO], 1u); break; } }
    }
    nloc = mine > 0u ? mine : 1u; nx = cnt > 0u ? cnt : 1u;
}
__device__ __forceinline__ void xcd_barrier(const XcdBarrier& b) {
    asm volatile("s_waitcnt vmcnt(0)" ::: "memory");
    __syncthreads();
    if (threadIdx.x == 0) {
        unsigned* bar = b.bar;
        __builtin_amdgcn_s_waitcnt(0);
        unsigned nloc = b.st[0], nx = b.st[1];
        if (nloc == 0u) { xcd_barrier_complete(bar, b.x, nloc, nx); b.st[0] = nloc; b.st[1] = nx; }
        const unsigned old = xb_add(&bar[XB_XSUB(b.x)], 1u);
        const unsigned gen = old / nloc;
        if (old + 1u == (gen + 1u) * nloc) {
            __builtin_amdgcn_fence(__ATOMIC_RELEASE, "agent");
            asm volatile("s_waitcnt vmcnt(0)" ::: "memory");
            const unsigned og = xb_add(&bar[XB_TOP], 1u);
            const unsigned tg = og / nx;
            if (og + 1u == (tg + 1u) * nx) xb_add(&bar[XB_TOPGEN], 1u);
            else XB_SPIN(xb_ld(&bar[XB_TOPGEN]) == tg, bar);
            __builtin_amdgcn_fence(__ATOMIC_ACQUIRE, "agent");
            xb_add(&bar[XB_XGEN(b.x)], 1u);
            asm volatile("s_waitcnt vmcnt(0)" ::: "memory");
        } else {
            XB_SPIN(xb_ld(&bar[XB_XGEN(b.x)]) == gen, bar);
            __builtin_amdgcn_fence(__ATOMIC_ACQUIRE, "agent");
            asm volatile("s_waitcnt vmcnt(0)" ::: "memory");
        }
    }
    __syncthreads();
}

struct XcdSplit { unsigned gen; bool leader; };
__device__ __forceinline__ XcdSplit xcd_arrive(const XcdBarrier& b) {
    XcdSplit s; s.leader = false;
    unsigned* bar = b.bar;
    unsigned nloc = b.st[0], nx = b.st[1];
    if (nloc == 0u) { xcd_barrier_complete(bar, b.x, nloc, nx); b.st[0] = nloc; b.st[1] = nx; }
    const unsigned old = xb_add(&bar[XB_XSUB(b.x)], 1u);
    s.gen = old / nloc;
    if (old + 1u == (s.gen + 1u) * nloc) { s.leader = true;
        __builtin_amdgcn_fence(__ATOMIC_RELEASE, "agent");
        asm volatile("s_waitcnt vmcnt(0)" ::: "memory");
        const unsigned og = xb_add(&bar[XB_TOP], 1u); const unsigned tg = og / nx;
        if (og + 1u == (tg + 1u) * nx) xb_add(&bar[XB_TOPGEN], 1u); }
    return s;
}
__device__ __forceinline__ void xcd_wait(const XcdBarrier& b, const XcdSplit& s) {
    unsigned* bar = b.bar;
    XB_SPIN(xb_ld(&bar[XB_TOPGEN]) == s.gen, bar);
    __builtin_amdgcn_fence(__ATOMIC_ACQUIRE, "agent");
    if (s.leader) xb_add(&bar[XB_XGEN(b.x)], 1u);
    asm volatile("s_waitcnt vmcnt(0)" ::: "memory");
}
__device__ __forceinline__ void split_arrive(unsigned* ctr) {
    asm volatile("s_waitcnt vmcnt(0)" ::: "memory");
    __syncthreads();
    if (threadIdx.x == 0) { __builtin_amdgcn_fence(__ATOMIC_RELEASE, "agent"); asm volatile("s_waitcnt vmcnt(0)" ::: "memory"); (void)xb_add(ctr, 1u); }
}
__device__ __forceinline__ void split_wait(unsigned* ctr, unsigned* bar) {
    if (threadIdx.x == 0) { const unsigned G = gridDim.x * gridDim.y * gridDim.z; XB_SPIN(xb_ld(ctr) < G, bar);
        __builtin_amdgcn_fence(__ATOMIC_ACQUIRE, "agent"); asm volatile("s_waitcnt vmcnt(0)" ::: "memory"); }
    __syncthreads();
}

namespace pg8 {
constexpr int BM = 256, BK = 64, HALF = 128, HTB = HALF * BK * 2  , STAGE_BYTES = 8 * HTB, NXCD = 8, WGM = 8;
__host__ __device__ __forceinline__ int lds_byte(int r, int c) { const int st = (r >> 4) * 2 + (c >> 5), rr = r & 15, cc = c & 31, ob = rr * 64 + cc * 2; return st * 1024 + (ob ^ (((ob >> 9) & 1) << 5)); }
__host__ __device__ __forceinline__ void stage_rc(int b, int& R, int& C) { const int st = b / 1024, sb = b % 1024, swz = sb ^ (((sb >> 9) & 1) << 5); R = (st >> 1) * 16 + swz / 64; C = (st & 1) * 32 + (swz % 64) / 2; }
__host__ __device__ __forceinline__ int perm32(int rho) { const int n = rho >> 4, i = rho & 15; return 8 * (i >> 2) + 4 * n + (i & 3); }

struct Unit { int pm, pn; };
__device__ __forceinline__ bool static_unit(int i, int G, int c, int nM, int nN, Unit& u) {
    const int nwg = nM * nN; const long L = (long)i * G + c; if (L >= nwg) return false;
    int wgid = (int)L; { const int q = nwg / NXCD, r = nwg % NXCD, xcd = wgid % NXCD, off = wgid / NXCD; wgid = (xcd < r ? xcd * (q + 1) : r * (q + 1) + (xcd - r) * q) + off; }
    const int nig = WGM * nN, gid = wgid / nig, fm = gid * WGM, gsz = (nM - fm) < WGM ? (nM - fm) : WGM;
    u.pm = fm + ((wgid % nig) % gsz); u.pn = (wgid % nig) / gsz; return true;
}
struct DenseSched {
    static constexpr bool GATHER = false;
    const char* A; const char* Bt; int nM, nN, G, c; size_t tstep;
    __device__ __forceinline__ void init(const void* A_, const void* Bt_, int M, int N, int K, int G_, int c_, int es = 2) { A = (const char*)A_; Bt = (const char*)Bt_; nM = M / BM; nN = N / BM; G = G_; c = c_; tstep = (size_t)BM * K * es; }
    __device__ __forceinline__ bool next(int i, Unit& u) const { return static_unit(i, G, c, nM, nN, u); }
    __device__ __forceinline__ const char* a_base(const Unit& u) const { return A + (size_t)u.pm * tstep; }
    __device__ __forceinline__ const char* b_base(const Unit& u) const { return Bt + (size_t)u.pn * tstep; }
    __device__ __forceinline__ void rows(const Unit&, const int (&)[2], int, unsigned (&)[2][2]) const {}
};
template <bool GATH> struct MoeSched {
    static constexpr bool GATHER = GATH;
    const char* A; const char* Bt; int nM, nN, G, c; size_t tstepA, tstepB, estride; int K2;
    int ncol; size_t ksoff;
    const LAS int* tab;
    const int* TL;
    const LAS unsigned* rowtab;
    __device__ __forceinline__ int expert(int pm) const { int e = 0;
#pragma unroll
        for (int k = 1; k < 8; ++k) e += (pm >= tab[k]) ? 1 : 0; return e; }
    __device__ __forceinline__ bool next(int i, Unit& u) const { return static_unit(i, G, c, nM, nN, u); }
    __device__ __forceinline__ const char* a_base(const Unit& u) const { return GATH ? A : A + (size_t)u.pm * tstepA + (size_t)(u.pn / ncol) * ksoff; }
    __device__ __forceinline__ const char* b_base(const Unit& u) const { return Bt + (size_t)__builtin_amdgcn_readfirstlane(expert(u.pm)) * estride + (size_t)(u.pn % ncol) * tstepB + (size_t)(u.pn / ncol) * ksoff; }
    __device__ __forceinline__ void rows(const Unit&, const int (&R)[2], int ord, unsigned (&v)[2][2]) const {
        if constexpr (GATH) {
#pragma unroll
            for (int h = 0; h < 2; ++h)
#pragma unroll
                for (int i = 0; i < 2; ++i) v[h][i] = rowtab[ord * 256 + h * 128 + R[i]];
        }
    }
    __device__ __forceinline__ void fill_rows(LAS unsigned* tabw) const {
        if constexpr (GATH) { Unit u;
            for (int i = 0; next(i, u); ++i) { if (threadIdx.x < 256) { const int e = expert(u.pm); const int pe = tab[e], ce = tab[16 + e]; int pos = (u.pm - pe) * 256 + (int)threadIdx.x; pos = pos < ce ? pos : ce - 1;
                    tabw[i * 256 + threadIdx.x] = (unsigned)TL[e * 16384 + pos] * (unsigned)K2; } }
            __syncthreads(); }
    }
};

constexpr float RMS_EPS = 1e-6f;
struct SumSq { const float* f; const unsigned long long* q; };
__device__ __forceinline__ float ss_value(const SumSq& s, int row) { if (s.q) { const unsigned long long v = s.q[row]; return (float)(unsigned)(v >> 32) + (float)(unsigned)v * (1.0f / 4294967296.0f); } return s.f[row]; }
__device__ __forceinline__ float inv_rms(const SumSq& s, int row) { return (s.f || s.q) ? 1.0f / sqrtf(ss_value(s, row) * (1.0f / 1024.0f) + RMS_EPS) : 1.0f; }
struct SsRaw { float f; unsigned long long q; };
__device__ __forceinline__ SsRaw ss_load(const SumSq& s, int row) { SsRaw r; r.f = 0.f; r.q = 0ull; if (s.q) r.q = s.q[row]; else if (s.f) r.f = s.f[row]; return r; }
__device__ __forceinline__ float ss_fin(const SumSq& s, const SsRaw& r) { if (s.q) return (float)(unsigned)(r.q >> 32) + (float)(unsigned)r.q * (1.0f / 4294967296.0f); return r.f; }
__device__ __forceinline__ float inv_rms_fin(const SumSq& s, const SsRaw& r) { return (s.f || s.q) ? 1.0f / sqrtf(ss_fin(s, r) * (1.0f / 1024.0f) + RMS_EPS) : 1.0f; }
constexpr int RS_TAB_OFF = 149504, CS_TAB_OFF = 151552;
struct RsRaw2 { SsRaw a, b; };

template <int MODE> struct EpiProj {
    static constexpr bool PERM = true, AFTER_DRAIN = false, ROWSCALE = (MODE != 3), COLSCALE = false;
    __device__ __forceinline__ RsRaw2 rs_load(int row) const { RsRaw2 r; r.a = ss_load(ss, row); r.b = r.a; return r; }
    __device__ __forceinline__ float rs_finish(const RsRaw2& r) const { return inv_rms_fin(ss, r.a); }
    SumSq ss; bf16_t* p0; int ld0; float qscale; bf16_t* p1;
    __device__ __forceinline__ void operator()(const f32x4 (&acc)[2][2][4][2], const Unit& u, int wr, int wc, int fr, int fq, const LAS float* rs = nullptr) const {
        bf16_t* base; int ldc, colt; float scl = 1.f;
        if constexpr (MODE == 0) { const int t = u.pn >> 1; base = p0 + (size_t)t * (8u << 20); ldc = 512; colt = (u.pn & 1) * BM; scl = (t == 2) ? qscale : 1.f; }
        else if constexpr (MODE == 1) { if (u.pn < 4) { base = p0 + (size_t)(u.pn >> 1) * (8u << 20); ldc = 512; colt = (u.pn & 1) * BM; }
                                        else { const int q = u.pn - 4; base = p0 + (size_t)(16u << 20) + (size_t)(q >> 2) * (16u << 20); ldc = 1024; colt = (q & 3) * BM; } }
        else if constexpr (MODE == 3) { base = (u.pn >> 2) ? p1 : p0; ldc = ld0; colt = (u.pn & 3) * BM; }
        else { base = p0; ldc = ld0; colt = u.pn * BM; }
        const int row0 = u.pm * BM + wr * 64 + fr, col0 = colt + wc * 32 + 8 * fq;
#pragma unroll
        for (int ai = 0; ai < 2; ++ai)
#pragma unroll
            for (int m = 0; m < 4; ++m) { const int row = row0 + ai * HALF + m * 16; const float s = (rs ? rs[wr * 64 + fr + ai * HALF + m * 16] : inv_rms(ss, row)) * scl; bf16_t* rowp = base + (size_t)row * ldc + col0;
#pragma unroll
                for (int bj = 0; bj < 2; ++bj) { const f32x4 v0 = acc[ai][bj][m][0] * s, v1 = acc[ai][bj][m][1] * s;
                    u32x4 w; w.x = cvt_pk_bf16(v0[0], v0[1]); w.y = cvt_pk_bf16(v0[2], v0[3]); w.z = cvt_pk_bf16(v1[0], v1[1]); w.w = cvt_pk_bf16(v1[2], v1[3]);
                    *(u32x4*)(rowp + bj * HALF) = w; } }
    }
};
__device__ __forceinline__ unsigned q4_i8(float a, float b, float c, float d, float qs) {
    unsigned w = 0;
    w = __builtin_amdgcn_cvt_pk_u8_f32(__builtin_rintf(fmaf(a, qs, 128.f)), 0, w); w = __builtin_amdgcn_cvt_pk_u8_f32(__builtin_rintf(fmaf(b, qs, 128.f)), 1, w);
    w = __builtin_amdgcn_cvt_pk_u8_f32(__builtin_rintf(fmaf(c, qs, 128.f)), 2, w); w = __builtin_amdgcn_cvt_pk_u8_f32(__builtin_rintf(fmaf(d, qs, 128.f)), 3, w);
    return w ^ 0x80808080u; }
#ifndef I8_CLIP_V
#define I8_CLIP_V 6.0f
#endif
constexpr float I8_CLIP = I8_CLIP_V;
__device__ __forceinline__ float i8_act_step(const SumSq& ssin, int row) { return I8_CLIP * sqrtf(ss_value(ssin, row) * (1.0f / 1024.0f) + RMS_EPS) * (1.0f / 127.0f); }
template <int MODE> struct EpiProjI8 {
    static constexpr bool PERM = true, AFTER_DRAIN = false, ROWSCALE = true, COLSCALE = true;
    __device__ __forceinline__ float cs_load(const Unit& u, int c) const { return wmax[u.pn * BM + c]; }
    __device__ __forceinline__ RsRaw2 rs_load(int row) const { RsRaw2 r; r.a = ss_load(ss, row); if (stepv) { r.b.f = stepv[row]; r.b.q = 0ull; } else r.b = ss_load(ssin, row); return r; }
    __device__ __forceinline__ float rs_finish(const RsRaw2& r) const { return inv_rms_fin(ss, r.a) * (stepv ? r.b.f : I8_CLIP * sqrtf(ss_fin(ssin, r.b) * (1.0f / 1024.0f) + RMS_EPS) * (1.0f / 127.0f)); }
    SumSq ss; SumSq ssin; const float* wmax; bf16_t* p0; int ld0; float qscale; const float* stepv;
    __device__ __forceinline__ void operator()(const f32x4 (&acc)[2][2][4][2], const Unit& u, int wr, int wc, int fr, int fq, const LAS float* rs = nullptr, const LAS float* cs = nullptr) const {
        bf16_t* base; int ldc, colt; float scl = 1.f;
        if constexpr (MODE == 0) { const int t = u.pn >> 1; base = p0 + (size_t)t * (8u << 20); ldc = 512; colt = (u.pn & 1) * BM; scl = (t == 2) ? qscale : 1.f; }
        else if constexpr (MODE == 1) { if (u.pn < 4) { base = p0 + (size_t)(u.pn >> 1) * (8u << 20); ldc = 512; colt = (u.pn & 1) * BM; }
                                        else { const int q = u.pn - 4; base = p0 + (size_t)(16u << 20) + (size_t)(q >> 2) * (16u << 20); ldc = 1024; colt = (q & 3) * BM; } }
        else { base = p0; ldc = ld0; colt = u.pn * BM; }
        const int row0 = u.pm * BM + wr * 64 + fr, col0 = colt + wc * 32 + 8 * fq;
        const float* wp = wmax + u.pn * BM + wc * 32 + 8 * fq;
#pragma unroll
        for (int ai = 0; ai < 2; ++ai)
#pragma unroll
            for (int m = 0; m < 4; ++m) { const int row = row0 + ai * HALF + m * 16; const float s = (rs ? rs[wr * 64 + fr + ai * HALF + m * 16] : inv_rms(ss, row) * (stepv ? stepv[row] : i8_act_step(ssin, row))) * scl * (1.0f / 127.0f); bf16_t* rowp = base + (size_t)row * ldc + col0;
#pragma unroll
                for (int bj = 0; bj < 2; ++bj) { const i32x4 i0 = __builtin_bit_cast(i32x4, acc[ai][bj][m][0]), i1 = __builtin_bit_cast(i32x4, acc[ai][bj][m][1]);
                    f32x4 w0, w1; if (cs) { const LAS float* cp = cs + wc * 32 + 8 * fq + bj * HALF; w0 = *(const LAS f32x4*)cp; w1 = *(const LAS f32x4*)(cp + 4); } else { w0 = *(const f32x4*)(wp + bj * HALF); w1 = *(const f32x4*)(wp + bj * HALF + 4); }
                    u32x4 w; w.x = cvt_pk_bf16((float)i0[0] * (s * w0[0]), (float)i0[1] * (s * w0[1])); w.y = cvt_pk_bf16((float)i0[2] * (s * w0[2]), (float)i0[3] * (s * w0[3]));
                    w.z = cvt_pk_bf16((float)i1[0] * (s * w1[0]), (float)i1[1] * (s * w1[1])); w.w = cvt_pk_bf16((float)i1[2] * (s * w1[2]), (float)i1[3] * (s * w1[3]));
                    *(u32x4*)(rowp + bj * HALF) = w; } }
    }
};
struct EpiGluI8 {
    static constexpr bool PERM = true, AFTER_DRAIN = false, ROWSCALE = true, COLSCALE = true;
    __device__ __forceinline__ float cs_load(const Unit& u, int c) const { return sw[u.pn * BM + c]; }
    __device__ __forceinline__ RsRaw2 rs_load(int row) const { RsRaw2 r; r.a = ss_load(ss, row); r.b = ss_load(ssin, row); return r; }
    __device__ __forceinline__ float rs_finish(const RsRaw2& r) const { return inv_rms_fin(ss, r.a) * (I8_CLIP * sqrtf(ss_fin(ssin, r.b) * (1.0f / 1024.0f) + RMS_EPS) * (1.0f / 127.0f)); }
    SumSq ss; SumSq ssin; const float* sw; bf16_t* O; int ldc;
    __device__ __forceinline__ void operator()(const f32x4 (&acc)[2][2][4][2], const Unit& u, int wr, int wc, int fr, int fq, const LAS float* rs = nullptr, const LAS float* cs = nullptr) const {
        const int row0 = u.pm * BM + wr * 64 + fr, col0 = u.pn * HALF + wc * 32 + 8 * fq;
        const float* swp = sw + u.pn * BM + wc * 32 + 8 * fq;
        f32x2 nw1[4], c13[4];
#pragma unroll
        for (int n = 0; n < 2; ++n) { f32x4 w1, w3; if (cs) { const LAS float* cp = cs + wc * 32 + 8 * fq; w1 = *(const LAS f32x4*)(cp + 4 * n); w3 = *(const LAS f32x4*)(cp + HALF + 4 * n); } else { w1 = *(const f32x4*)(swp + 4 * n); w3 = *(const f32x4*)(swp + HALF + 4 * n); }
#pragma unroll
            for (int h = 0; h < 2; ++h) { const f32x2 a = (f32x2){w1[2 * h], w1[2 * h + 1]}, b = (f32x2){w3[2 * h], w3[2 * h + 1]}; nw1[2 * n + h] = a * (-1.4426950408889634f); c13[2 * n + h] = a * b; } }
#pragma unroll
        for (int ai = 0; ai < 2; ++ai)
#pragma unroll
            for (int m = 0; m < 4; ++m) { const int row = row0 + ai * HALF + m * 16; const float s = (rs ? rs[wr * 64 + fr + ai * HALF + m * 16] : inv_rms(ss, row) * i8_act_step(ssin, row)) * (1.0f / 127.0f);
                const float s2 = s * s; f32x2 o[4];
#pragma unroll
                for (int n = 0; n < 2; ++n) { const i32x4 ia = __builtin_bit_cast(i32x4, acc[ai][0][m][n]), ib = __builtin_bit_cast(i32x4, acc[ai][1][m][n]);
#pragma unroll
                    for (int h = 0; h < 2; ++h) { const f32x2 af = (f32x2){(float)ia[2 * h], (float)ia[2 * h + 1]}, bf = (f32x2){(float)ib[2 * h], (float)ib[2 * h + 1]};
                        const f32x2 t = (af * nw1[2 * n + h]) * s; f32x2 d = (f32x2){__builtin_amdgcn_exp2f(t.x), __builtin_amdgcn_exp2f(t.y)} + 1.0f;
                        const f32x2 r = (f32x2){__builtin_amdgcn_rcpf(d.x), __builtin_amdgcn_rcpf(d.y)};
                        o[2 * n + h] = (((af * bf) * c13[2 * n + h]) * r) * s2; } }
                u32x4 w; w.x = cvt_pk_bf16(o[0].x, o[0].y); w.y = cvt_pk_bf16(o[1].x, o[1].y); w.z = cvt_pk_bf16(o[2].x, o[2].y); w.w = cvt_pk_bf16(o[3].x, o[3].y); *(u32x4*)(O + (size_t)row * ldc + col0) = w; }
    }
};
__device__ __forceinline__ unsigned pk4_fp8(float a, float b, float c, float d) { int w = __builtin_amdgcn_cvt_pk_fp8_f32(a, b, 0, false); w = __builtin_amdgcn_cvt_pk_fp8_f32(c, d, w, true); return (unsigned)w; }
template <bool F8> struct EpiGluT {
    static constexpr bool PERM = true, AFTER_DRAIN = false, ROWSCALE = false, COLSCALE = false;
    SumSq ss; void* O; int ldc;
    __device__ __forceinline__ void operator()(const f32x4 (&acc)[2][2][4][2], const Unit& u, int wr, int wc, int fr, int fq, const LAS float* rs = nullptr) const {
        const int row0 = u.pm * BM + wr * 64 + fr, col0 = u.pn * HALF + wc * 32 + 8 * fq;
#pragma unroll
        for (int ai = 0; ai < 2; ++ai)
#pragma unroll
            for (int m = 0; m < 4; ++m) { const int row = row0 + ai * HALF + m * 16; const float s = inv_rms(ss, row); const float nls = -1.4426950408889634f * s, s2 = s * s;
                float o[8];
#pragma unroll
                for (int n = 0; n < 2; ++n)
#pragma unroll
                    for (int h = 0; h < 2; ++h) { const f32x2 af = (f32x2){acc[ai][0][m][n][2 * h], acc[ai][0][m][n][2 * h + 1]}, bf = (f32x2){acc[ai][1][m][n][2 * h], acc[ai][1][m][n][2 * h + 1]};
                        const f32x2 t = af * nls; f32x2 d = (f32x2){__builtin_amdgcn_exp2f(t.x), __builtin_amdgcn_exp2f(t.y)} + 1.0f;
                        const f32x2 r = (f32x2){__builtin_amdgcn_rcpf(d.x), __builtin_amdgcn_rcpf(d.y)}; const f32x2 ov = ((af * bf) * r) * s2; o[n * 4 + 2 * h] = ov.x; o[n * 4 + 2 * h + 1] = ov.y; }
                if constexpr (F8) { u32x2 w; w.x = pk4_fp8(o[0], o[1], o[2], o[3]); w.y = pk4_fp8(o[4], o[5], o[6], o[7]); *(u32x2*)((unsigned char*)O + (size_t)row * ldc + col0) = w; }
                else { u32x4 w; w.x = cvt_pk_bf16(o[0], o[1]); w.y = cvt_pk_bf16(o[2], o[3]); w.z = cvt_pk_bf16(o[4], o[5]); w.w = cvt_pk_bf16(o[6], o[7]); *(u32x4*)((bf16_t*)O + (size_t)row * ldc + col0) = w; } }
    }
};
typedef EpiGluT<false> EpiGlu;
template <bool BF16_RES> struct EpiResT {
    static constexpr bool PERM = false, AFTER_DRAIN = false, ROWSCALE = false, COLSCALE = false;
    const float* basef; const bf16_t* baseb; float* out; bf16_t* outb; unsigned long long* ss; unsigned char* outq; SumSq ssin;
    __device__ __forceinline__ void operator()(const f32x4 (&acc)[2][2][4][2], const Unit& u, int wr, int wc, int fr, int fq, const LAS float* rs = nullptr) const {
        const int row0 = u.pm * BM + wr * 64 + fr, col0 = u.pn * BM + wc * 32 + 4 * fq;
        const bool fbase = !BF16_RES || basef != nullptr;
#pragma unroll
        for (int ai = 0; ai < 2; ++ai)
#pragma unroll
          for (int mh = 0; mh < 2; ++mh) {
            f32x4 res[2][2][2];
#pragma unroll
            for (int mm = 0; mm < 2; ++mm)
#pragma unroll
                for (int bj = 0; bj < 2; ++bj)
#pragma unroll
                    for (int n = 0; n < 2; ++n) { const size_t o2 = (size_t)(row0 + ai * HALF + (2 * mh + mm) * 16) * 1024 + col0 + bj * HALF + n * 16;
                        if (fbase) res[mm][bj][n] = *(const f32x4*)(basef + o2);
                        else { const u32x2 w = *(const u32x2*)(baseb + o2); res[mm][bj][n] = (f32x4){bflo(w.x), bfhi(w.x), bflo(w.y), bfhi(w.y)}; } }
#pragma unroll
            for (int mm = 0; mm < 2; ++mm) { const int m = 2 * mh + mm; const int row = row0 + ai * HALF + m * 16; const size_t off = (size_t)row * 1024 + col0; float rs = 0.f; const bool qi8 = ssin.f || ssin.q; const float qs = (outq && qi8) ? 1.0f / i8_act_step(ssin, row) : 0.f;
#pragma unroll
                for (int bj = 0; bj < 2; ++bj)
#pragma unroll
                    for (int n = 0; n < 2; ++n) { const size_t o2 = off + bj * HALF + n * 16; const f32x4 r = res[mm][bj][n] + acc[ai][bj][m][n];
                        if (!BF16_RES) *(f32x4*)(out + o2) = r;
                        rs += (r[0] * r[0] + r[1] * r[1]) + (r[2] * r[2] + r[3] * r[3]);
                        if (outb) { u32x2 w; w.x = cvt_pk_bf16(r[0], r[1]); w.y = cvt_pk_bf16(r[2], r[3]); *(u32x2*)(outb + o2) = w; }
                        if (outq) *(unsigned*)(outq + o2) = qi8 ? q4_i8(r[0], r[1], r[2], r[3], qs) : pk4_fp8(r[0], r[1], r[2], r[3]); }
                if (ss) { rs += __shfl_xor(rs, 16); rs += __shfl_xor(rs, 32); if (fq == 0) { const unsigned hi_ = (unsigned)rs; const unsigned lo_ = (unsigned)((rs - (float)hi_) * 4294967296.0f);
                        __hip_atomic_fetch_add(ss + row, ((unsigned long long)hi_ << 32) | lo_, __ATOMIC_RELAXED, __HIP_MEMORY_SCOPE_AGENT); } } }
            asm volatile("" ::: "memory"); }
    }
};

template <bool FBASE> struct EpiResB {
    static constexpr bool PERM = true, AFTER_DRAIN = false, ROWSCALE = true, COLSCALE = false;
    __device__ __forceinline__ RsRaw2 rs_load(int row) const { RsRaw2 r; r.a = ss_load(ssin, row); r.b = r.a; return r; }
    __device__ __forceinline__ float rs_finish(const RsRaw2& r) const { return (ssin.f || ssin.q) ? 1.0f / (I8_CLIP * sqrtf(ss_fin(ssin, r.a) * (1.0f / 1024.0f) + RMS_EPS) * (1.0f / 127.0f)) : 0.f; }
    const float* basef; const bf16_t* baseb; float* out; bf16_t* outb; unsigned long long* ss; unsigned char* outq; SumSq ssin;
    struct Raw { u32x4 b; f32x4 f0, f1; };
    __device__ __forceinline__ void load_batch(Raw (&R)[2][2], int rowb, int col0) const {
#pragma unroll
        for (int mm = 0; mm < 2; ++mm)
#pragma unroll
            for (int bj = 0; bj < 2; ++bj) { const size_t o2 = (size_t)(rowb + mm * 16) * 1024 + col0 + bj * HALF;
                if constexpr (FBASE) { R[mm][bj].f0 = *(const f32x4*)(basef + o2); R[mm][bj].f1 = *(const f32x4*)(basef + o2 + 4); } else R[mm][bj].b = *(const u32x4*)(baseb + o2); }
    }
    __device__ __forceinline__ void operator()(const f32x4 (&acc)[2][2][4][2], const Unit& u, int wr, int wc, int fr, int fq, const LAS float* rst = nullptr) const {
        const int row0 = u.pm * BM + wr * 64 + fr, col0 = u.pn * BM + wc * 32 + 8 * fq;
        const bool qi8 = ssin.f || ssin.q;
        Raw R[2][2][2];
        load_batch(R[0], row0, col0);
#pragma unroll
        for (int s = 0; s < 4; ++s) { const int ai = s >> 1, mh = s & 1; const int rowb = row0 + ai * HALF + mh * 32;
            if (s < 3) load_batch(R[(s + 1) & 1], row0 + ((s + 1) >> 1) * HALF + ((s + 1) & 1) * 32, col0);
#pragma unroll
            for (int mm = 0; mm < 2; ++mm) { const int m = 2 * mh + mm; const int row = rowb + mm * 16; float rs = 0.f; const float qs = (outq && qi8) ? (rst ? rst[wr * 64 + fr + ai * HALF + m * 16] : 1.0f / i8_act_step(ssin, row)) : 0.f;
#pragma unroll
                for (int bj = 0; bj < 2; ++bj) { const Raw& q = R[s & 1][mm][bj]; f32x4 b0, b1;
                    if constexpr (FBASE) { b0 = q.f0; b1 = q.f1; } else { b0 = (f32x4){bflo(q.b.x), bfhi(q.b.x), bflo(q.b.y), bfhi(q.b.y)}; b1 = (f32x4){bflo(q.b.z), bfhi(q.b.z), bflo(q.b.w), bfhi(q.b.w)}; }
                    const f32x4 r0 = b0 + acc[ai][bj][m][0], r1 = b1 + acc[ai][bj][m][1]; const size_t o2 = (size_t)row * 1024 + col0 + bj * HALF;
                    rs += ((r0[0] * r0[0] + r0[1] * r0[1]) + (r0[2] * r0[2] + r0[3] * r0[3])) + ((r1[0] * r1[0] + r1[1] * r1[1]) + (r1[2] * r1[2] + r1[3] * r1[3]));
                    if (outb) { u32x4 w; w.x = cvt_pk_bf16(r0[0], r0[1]); w.y = cvt_pk_bf16(r0[2], r0[3]); w.z = cvt_pk_bf16(r1[0], r1[1]); w.w = cvt_pk_bf16(r1[2], r1[3]); *(u32x4*)(outb + o2) = w; }
                    if (outq) { u32x2 w; w.x = qi8 ? q4_i8(r0[0], r0[1], r0[2], r0[3], qs) : pk4_fp8(r0[0], r0[1], r0[2], r0[3]); w.y = qi8 ? q4_i8(r1[0], r1[1], r1[2], r1[3], qs) : pk4_fp8(r1[0], r1[1], r1[2], r1[3]); *(u32x2*)(outq + o2) = w; } }
                if (ss) { rs += __shfl_xor(rs, 16); rs += __shfl_xor(rs, 32); if (fq == 0) { const unsigned hi_ = (unsigned)rs; const unsigned lo_ = (unsigned)((rs - (float)hi_) * 4294967296.0f);
                        __hip_atomic_fetch_add(ss + row, ((unsigned long long)hi_ << 32) | lo_, __ATOMIC_RELAXED, __HIP_MEMORY_SCOPE_AGENT); } } }
            asm volatile("" ::: "memory"); }
    }
};


template <class Epi, class Sched, bool ALIGN_EPI, bool SP2, int ES = 2, bool I8 = false>
__device__ __forceinline__ void gemm_phase(LAS unsigned char* lds, const int K, const int LD, const Sched& S, const Epi& E, const int wscale = 0x7f7f7f7f) {
    int tid_ = threadIdx.x; asm volatile("" : "+v"(tid_));
    const int tid = tid_, wid = __builtin_amdgcn_readfirstlane(tid >> 6), lane = tid & 63, wr = wid >> 2, wc = wid & 3, fr = lane & 15, fq = lane >> 4;
    const int nt = K * ES / (BK * 2);
    constexpr bool GATH = Sched::GATHER;
    const size_t kstep = (size_t)(BK * 2);
    const size_t hstep = (size_t)HALF * LD * ES;
    unsigned voffB[2]; unsigned vA[2][2], vAn[2][2]; int RA[2]; unsigned CA2[2];
#pragma unroll
    for (int i = 0; i < 2; ++i) { int R, C; stage_rc(tid * 16 + i * 8192, R, C); const int Rb = Epi::PERM ? ((R & ~31) + perm32(R & 31)) : R;
        RA[i] = R; CA2[i] = (unsigned)C * 2u; voffB[i] = (unsigned)(Rb * LD * ES + C * 2);
        vA[0][i] = (unsigned)(R * LD * ES + C * 2); vA[1][i] = vA[0][i] + (unsigned)hstep; vAn[0][i] = vA[0][i]; vAn[1][i] = vA[1][i]; }
    const unsigned ldsw = (unsigned)wid * 1024u;
    int aoffk[2], boffk[2];
#pragma unroll
    for (int k = 0; k < 2; ++k) { aoffk[k] = lds_byte(wr * 64 + fr, 32 * k + 8 * fq); boffk[k] = lds_byte(wc * 32 + fr, 32 * k + 8 * fq); }
#define PG8_SA(b, h) (((b) * 2 + (h)) * HTB)
#define PG8_SB(b, h) ((4 + (b) * 2 + (h)) * HTB)
#define PG8_STAGE2(bufoff, gbase, o0, o1) do { \
        __builtin_amdgcn_global_load_lds((const unsigned*)((const char*)(gbase) + (o0)), (LAS unsigned*)(lds + (bufoff) + ldsw), 16, 0, 0); \
        __builtin_amdgcn_global_load_lds((const unsigned*)((const char*)(gbase) + (o1)), (LAS unsigned*)(lds + (bufoff) + ldsw + 8192), 16, 0, 0); } while (0)
#define PG8_STAGEB(bufoff, gbase) PG8_STAGE2(bufoff, gbase, voffB[0], voffB[1])
#define PG8_STAGEA(bufoff, gbase, h) PG8_STAGE2(bufoff, gbase, vA[h][0], vA[h][1])
#define PG8_STAGEAX(bufoff, gbase, h, nx) PG8_STAGE2(bufoff, gbase, ((nx) ? vAn[h][0] : vA[h][0]), ((nx) ? vAn[h][1] : vA[h][1]))
#define PG8_LDA(dst, b, h) do { _Pragma("unroll") for (int m = 0; m < 4; ++m) { const i32x4 l_ = *(const LAS i32x4*)(lds + PG8_SA(b, h) + aoffk[0] + m * 2048), h_ = *(const LAS i32x4*)(lds + PG8_SA(b, h) + aoffk[1] + m * 2048); \
        if constexpr (ES == 1 && !I8) dst##8[m] = __builtin_shufflevector(l_, h_, 0, 1, 2, 3, 4, 5, 6, 7); else { dst##4[m][0] = l_; dst##4[m][1] = h_; } } } while (0)
#define PG8_LDB(dst, b, h) do { _Pragma("unroll") for (int n = 0; n < 2; ++n) { const i32x4 l_ = *(const LAS i32x4*)(lds + PG8_SB(b, h) + boffk[0] + n * 2048), h_ = *(const LAS i32x4*)(lds + PG8_SB(b, h) + boffk[1] + n * 2048); \
        if constexpr (ES == 1 && !I8) dst##8[n] = __builtin_shufflevector(l_, h_, 0, 1, 2, 3, 4, 5, 6, 7); else { dst##4[n][0] = l_; dst##4[n][1] = h_; } } } while (0)
#define PG8_MMA(ai, bj, At, Bt) do { __builtin_amdgcn_s_setprio(1); _Pragma("unroll") for (int m = 0; m < 4; ++m) _Pragma("unroll") for (int n = 0; n < 2; ++n) { \
        if constexpr (ES == 2) { _Pragma("unroll") for (int k = 0; k < 2; ++k) \
            acc[ai][bj][m][n] = __builtin_amdgcn_mfma_f32_16x16x32_bf16(__builtin_bit_cast(bf16x8, Bt##4[n][k]), __builtin_bit_cast(bf16x8, At##4[m][k]), acc[ai][bj][m][n], 0, 0, 0); } \
        else if constexpr (I8) { i32x4 c_ = __builtin_bit_cast(i32x4, acc[ai][bj][m][n]); \
            _Pragma("unroll") for (int k = 0; k < 2; ++k) c_ = __builtin_amdgcn_mfma_i32_16x16x64_i8(Bt##4[n][k], At##4[m][k], c_, 0, 0, 0); \
            acc[ai][bj][m][n] = __builtin_bit_cast(f32x4, c_); } \
        else { asm volatile("v_mfma_scale_f32_16x16x128_f8f6f4 %0, %1, %2, %0, %3, %4 op_sel_hi:[0,0,0]" : "+v"(acc[ai][bj][m][n]) : "v"(Bt##8[n]), "v"(At##8[m]), "v"(wsc_), "v"(one_)); } } \
        __builtin_amdgcn_s_setprio(0); } while (0)
#define PG8_WAIT_V(n) asm volatile("s_waitcnt vmcnt(" #n ")" ::: "memory")
#define PG8_WAIT_L(n) asm volatile("s_waitcnt lgkmcnt(" #n ")" ::: "memory")
#define PG8_BAR __builtin_amdgcn_s_barrier()
#define PG8_SCHED __builtin_amdgcn_sched_barrier(0)
    Unit cur, nxt; int ui = 0;
    if (!S.next(0, cur)) return;
    f32x4 acc[2][2][4][2];
#pragma unroll
    for (int a = 0; a < 2; ++a)
#pragma unroll
        for (int b = 0; b < 2; ++b)
#pragma unroll
            for (int m = 0; m < 4; ++m)
#pragma unroll
                for (int n = 0; n < 2; ++n) { acc[a][b][m][n] = (f32x4){0.f, 0.f, 0.f, 0.f}; if constexpr (ES == 1) asm volatile("" : "+v"(acc[a][b][m][n])); }
    int wsc_ = wscale, one_ = 0x7f7f7f7f; asm volatile("" : "+v"(wsc_), "+v"(one_));
    i32x4 At4[4][2], B04[2][2], B14[2][2];
    i32x8 At8[4], B08[2], B18[2];
    const char* cA = S.a_base(cur); const char* cB = S.b_base(cur);
    constexpr bool RS = Epi::ROWSCALE && !GATH;
    LAS float* rstab = (LAS float*)(lds + RS_TAB_OFF); RsRaw2 rsraw; rsraw.a.f = 0.f; rsraw.a.q = 0ull; rsraw.b = rsraw.a;
    constexpr bool CS = Epi::COLSCALE && !GATH;
    LAS float* cstab = (LAS float*)(lds + CS_TAB_OFF); float csraw = 0.f;
    if constexpr (CS) { if (tid >= 256) cstab[tid - 256] = E.cs_load(cur, tid - 256); }
    if constexpr (RS) { if (tid < 256) rstab[tid] = E.rs_finish(E.rs_load(cur.pm * BM + tid)); }
    if constexpr (GATH) { S.rows(cur, RA, 0, vA);
#pragma unroll
        for (int h = 0; h < 2; ++h)
#pragma unroll
            for (int i = 0; i < 2; ++i) vA[h][i] += CA2[i]; }
    if constexpr (SP2) {
        PG8_STAGEB(PG8_SB(0, 0), cB); PG8_STAGEB(PG8_SB(0, 1), cB + hstep); PG8_STAGEA(PG8_SA(0, 0), cA, 0); PG8_STAGEA(PG8_SA(0, 1), cA, 1);
        if (wr == 1) PG8_BAR;
        PG8_WAIT_V(2); PG8_BAR;
        PG8_STAGEB(PG8_SB(1, 0), cB + kstep); PG8_STAGEA(PG8_SA(1, 0), cA + kstep, 0); PG8_STAGEB(PG8_SB(1, 1), cB + hstep + kstep);
        PG8_WAIT_V(6); PG8_BAR;
    } else {
        PG8_STAGEB(PG8_SB(0, 0), cB); PG8_STAGEA(PG8_SA(0, 0), cA, 0); PG8_STAGEB(PG8_SB(0, 1), cB + hstep); PG8_STAGEA(PG8_SA(0, 1), cA, 1);
        if (wr == 1) PG8_BAR;
        PG8_WAIT_V(4); PG8_BAR;
        PG8_STAGEB(PG8_SB(1, 0), cB + kstep); PG8_STAGEA(PG8_SA(1, 0), cA + kstep, 0); PG8_STAGEB(PG8_SB(1, 1), cB + hstep + kstep);
        PG8_WAIT_V(6); PG8_BAR;
    }
    for (;;) {
        const bool has_next = S.next(ui + 1, nxt);
        const char* nA = has_next ? S.a_base(nxt) : cA; const char* nB = has_next ? S.b_base(nxt) : cB;
        if constexpr (GATH) { if (has_next) { S.rows(nxt, RA, ui + 1, vAn);
#pragma unroll
                for (int h = 0; h < 2; ++h)
#pragma unroll
                    for (int i = 0; i < 2; ++i) vAn[h][i] += CA2[i]; } else {
#pragma unroll
                for (int h = 0; h < 2; ++h)
#pragma unroll
                    for (int i = 0; i < 2; ++i) vAn[h][i] = vA[h][i]; } }
        for (int t = 0; t < nt; t += 2) {
            const bool last = (t == nt - 2);
            const char* a1 = cA + (size_t)(t + 1) * kstep;
            const char* a2 = last ? nA : cA + (size_t)(t + 2) * kstep; const char* b2 = last ? nB : cB + (size_t)(t + 2) * kstep;
            const char* a3 = a2 + kstep; const char* b3 = b2 + kstep;
            const bool nx = GATH && last;
            if constexpr (SP2) {
            PG8_LDB(B0, 0, 0); PG8_LDB(B1, 0, 1); PG8_SCHED; PG8_LDA(At, 0, 0); PG8_STAGEA(PG8_SA(1, 1), a1, 1);
            PG8_WAIT_V(8); PG8_WAIT_L(0); PG8_BAR; PG8_MMA(0, 0, At, B0); PG8_MMA(0, 1, At, B1); PG8_BAR; PG8_SCHED;
            PG8_LDA(At, 0, 1); PG8_STAGEB(PG8_SB(0, 0), b2); PG8_STAGEB(PG8_SB(0, 1), b2 + hstep); PG8_STAGEAX(PG8_SA(0, 0), a2, 0, nx);
            PG8_WAIT_V(8); PG8_WAIT_L(0); PG8_BAR; PG8_MMA(1, 0, At, B0); PG8_MMA(1, 1, At, B1); PG8_BAR; PG8_SCHED;
            PG8_LDB(B0, 1, 0); PG8_LDB(B1, 1, 1); PG8_SCHED; PG8_LDA(At, 1, 0); PG8_STAGEAX(PG8_SA(0, 1), a2, 1, nx);
            PG8_WAIT_V(8); PG8_WAIT_L(0); PG8_BAR; PG8_MMA(0, 0, At, B0); PG8_MMA(0, 1, At, B1); PG8_BAR; PG8_SCHED;
            PG8_LDA(At, 1, 1); PG8_STAGEB(PG8_SB(1, 0), b3); PG8_STAGEB(PG8_SB(1, 1), b3 + hstep); PG8_STAGEAX(PG8_SA(1, 0), a3, 0, nx);
            PG8_WAIT_V(8); PG8_WAIT_L(0); PG8_BAR; PG8_MMA(1, 0, At, B0); PG8_MMA(1, 1, At, B1); PG8_BAR; PG8_SCHED;
            } else {
            PG8_LDB(B0, 0, 0); PG8_SCHED; PG8_LDA(At, 0, 0); PG8_STAGEA(PG8_SA(1, 1), a1, 1);
            PG8_WAIT_L(8); PG8_BAR; PG8_WAIT_L(0); PG8_MMA(0, 0, At, B0); PG8_BAR; PG8_SCHED;
            PG8_LDB(B1, 0, 1); PG8_STAGEB(PG8_SB(0, 0), b2);
            PG8_BAR; PG8_WAIT_L(0); PG8_MMA(0, 1, At, B1); PG8_BAR;
            PG8_LDA(At, 0, 1); PG8_STAGEAX(PG8_SA(0, 0), a2, 0, nx);
            PG8_BAR; PG8_WAIT_L(0); PG8_MMA(1, 0, At, B0); PG8_BAR; PG8_SCHED;
            PG8_STAGEB(PG8_SB(0, 1), b2 + hstep);
            PG8_WAIT_V(6); PG8_BAR; PG8_MMA(1, 1, At, B1); PG8_BAR;
            PG8_LDB(B0, 1, 0); PG8_SCHED; PG8_LDA(At, 1, 0); PG8_STAGEAX(PG8_SA(0, 1), a2, 1, nx);
            PG8_WAIT_L(8); PG8_BAR; PG8_WAIT_L(0); PG8_MMA(0, 0, At, B0); PG8_BAR; PG8_SCHED;
            PG8_LDB(B1, 1, 1); PG8_STAGEB(PG8_SB(1, 0), b3);
            PG8_BAR; PG8_WAIT_L(0); PG8_MMA(0, 1, At, B1); PG8_BAR;
            PG8_LDA(At, 1, 1); PG8_STAGEAX(PG8_SA(1, 0), a3, 0, nx);
            PG8_BAR; PG8_WAIT_L(0); PG8_MMA(1, 0, At, B0); PG8_BAR; PG8_SCHED;
            PG8_STAGEB(PG8_SB(1, 1), b3 + hstep);
            PG8_WAIT_V(6); PG8_BAR; PG8_MMA(1, 1, At, B1); PG8_BAR;
            }
        }
        if constexpr (ALIGN_EPI) { if (wr == 0) PG8_BAR; }
        if constexpr (ES == 1 && !I8) asm volatile("s_nop 15\n\ts_nop 15" ::: "memory");
        if constexpr (RS) { if (has_next && tid < 256) rsraw = E.rs_load(nxt.pm * BM + tid); }
        if constexpr (CS) { if (has_next && tid >= 256) csraw = E.cs_load(nxt, tid - 256); }
        if constexpr (CS) E(acc, cur, wr, wc, fr, fq, rstab + (ui & 1) * 256, cstab + (ui & 1) * 256); else if constexpr (RS) E(acc, cur, wr, wc, fr, fq, rstab + (ui & 1) * 256); else E(acc, cur, wr, wc, fr, fq);
        if (!has_next) break;
        if constexpr (RS) { if (tid < 256) rstab[((ui + 1) & 1) * 256 + tid] = E.rs_finish(rsraw); }
        if constexpr (CS) { if (tid >= 256) cstab[((ui + 1) & 1) * 256 + tid - 256] = csraw; }
#pragma unroll
        for (int a = 0; a < 2; ++a)
#pragma unroll
            for (int b = 0; b < 2; ++b)
#pragma unroll
                for (int m = 0; m < 4; ++m)
#pragma unroll
                    for (int n = 0; n < 2; ++n) { acc[a][b][m][n] = (f32x4){0.f, 0.f, 0.f, 0.f}; if constexpr (ES == 1) asm volatile("" : "+v"(acc[a][b][m][n])); }
        cur = nxt; cA = nA; cB = nB; ++ui;
        if constexpr (GATH) {
#pragma unroll
            for (int h = 0; h < 2; ++h)
#pragma unroll
                for (int i = 0; i < 2; ++i) vA[h][i] = vAn[h][i]; }
        if constexpr (ALIGN_EPI) { if (wr == 1) PG8_BAR; }
    }
    PG8_WAIT_V(0);
    if constexpr (!ALIGN_EPI) { if (wr == 0) PG8_BAR; }
    PG8_BAR;
#undef PG8_SA
#undef PG8_SB
#undef PG8_STAGE2
#undef PG8_STAGEA
#undef PG8_STAGEAX
#undef PG8_STAGEB
#undef PG8_LDA
#undef PG8_LDB
#undef PG8_MMA
#undef PG8_WAIT_V
#undef PG8_WAIT_L
#undef PG8_BAR
#undef PG8_SCHED
}
}
#ifndef BF16_RESID
#define BF16_RESID 1
#endif
#ifndef FFN_DN_FP8
#define FFN_DN_FP8 0
#endif
#ifndef IN_O_I8
#define IN_O_I8 2
#endif
#ifndef FFN_UP_I8
#define FFN_UP_I8 1
#endif
#ifndef FFN_UP_FP8
#define FFN_UP_FP8 0
#endif
namespace fk {
constexpr int NWAVES = 8, NTHR = 512;
constexpr int T = 16384, D = 1024, SEQ = 4096, NBATCH = 4;
constexpr int EIN = 2568, OIN = 3088, DFF = 2816, DFE = 3584, NE = 8;
constexpr float EPS = 1e-6f;
constexpr float LOG2E = 1.4426950408889634f;
constexpr float C2 = 0.125f * LOG2E;
constexpr float GLA_QS = 0.08838834764831845f;

constexpr size_t MiB = 1u << 20;
constexpr size_t WS_CTL = 0, CTL_ZERO_BYTES = 2 * MiB;
constexpr int CW_TMO = 0, CW_CODE = 1;
constexpr int CW_BAR = 4096;
constexpr int CW_SPLIT = 8448;
constexpr int CW_CNT = 8192;
constexpr size_t CTL_WMAXE = 1664 * 1024;
constexpr size_t CTL_WMAXO = 1600 * 1024;
constexpr size_t CTL_WMAX = 1536 * 1024;
constexpr size_t CTL_SS = 1 * MiB;
constexpr size_t WS_HB8E = 538 * MiB;
constexpr size_t WS_H = 66 * MiB, WS_HB = 130 * MiB, WS_HB8 = 394 * MiB, WS_HB8O = 492 * MiB;
constexpr size_t WS_WINE = 162 * MiB, WS_WOUTE = 172 * MiB, WS_W13F = 176 * MiB, WS_W2F = 198 * MiB, WS_WINO = 209 * MiB, WS_WOUTO = 221 * MiB, WS_SMALL = 225 * MiB;
constexpr size_t SM_WLR = 0, SM_GAT = 128 * 1024, SM_GXT = 256 * 1024, SM_SSA = 384 * 1024;
constexpr size_t SM_KMAX = 600 * 1024;
constexpr size_t SM_STEPE = 448 * 1024;
constexpr size_t SM_STEPO = 640 * 1024;
constexpr size_t SM_SSF = 512 * 1024;
constexpr size_t W13E_PAIR = 56 * MiB;
constexpr size_t WS_W13E = 226 * MiB, WS_W2E = 338 * MiB;
constexpr size_t WS_ACT = 394 * MiB;
constexpr size_t WS_XR = 394 * MiB, WS_YR = 410 * MiB, WS_Q = 426 * MiB, WS_K = 442 * MiB, WS_V = 458 * MiB, WS_YLG = 474 * MiB, WS_PG = 490 * MiB, WS_Y = 506 * MiB, WS_HF = 538 * MiB, WS_ESM = 626 * MiB;
constexpr size_t ES_FLOG = 0, ES_CP = 512 * 1024, ES_AGG = 1024 * 1024;
constexpr size_t WS_GQ = 394 * MiB, WS_GK = 410 * MiB, WS_GV = 426 * MiB, WS_GG = 458 * MiB, WS_LR = 490 * MiB, WS_DEC = 491 * MiB, WS_KVT = 492 * MiB, WS_SNT = 556 * MiB;
constexpr size_t WS_OG = 652 * MiB, WS_XN = 684 * MiB, WS_RT = 716 * MiB, WS_YM = 718 * MiB, WS_HM = 394 * MiB, WS_YM1 = 632 * MiB;
constexpr size_t RT_TS = 0, RT_TW = 128 * 1024, RT_TL = 256 * 1024;
constexpr size_t WS_END = 840 * MiB;
static_assert(WS_YM + (size_t)34816 * 1024 * 2 <= WS_END && WS_HM + (size_t)34816 * 3584 * 2 <= WS_OG, "ws map");

constexpr int LDS_BYTES = 153600;
constexpr int RING_BYTES = 131072, MISC_OFF = 147456; static_assert(pg8::RS_TAB_OFF == MISC_OFF + 2048 && pg8::CS_TAB_OFF == pg8::RS_TAB_OFF + 2048 && pg8::CS_TAB_OFF + 2048 == LDS_BYTES, "row-scale table");

#ifndef E1_I8
#define E1_I8 1
#endif
struct Args { const float* in[26]; float* out; unsigned char* ws; int ph_lo, ph_hi, p0sub, pad; };

struct Frame {
    LAS unsigned char* lds; volatile LAS unsigned* MISC; gu32* ctl; unsigned char* ws;
    int tid, lane, wave, vcu, G;
};

constexpr float W13_MUL = 64.f, W2_MUL = 256.f; constexpr int W13_SCALE = 0x79797979, W2_SCALE = 0x77777777;
__device__ __forceinline__ unsigned f2bf(float f) { unsigned u = __builtin_bit_cast(unsigned, f); return (u + 0x7fffu + ((u >> 16) & 1u)) >> 16; }
__device__ __forceinline__ unsigned pk2(float lo, float hi) { return f2bf(lo) | (f2bf(hi) << 16); }

struct TrReg { float v[64]; };
template <bool HASG> __device__ __forceinline__ void transpose_load(TrReg& t, const float* W, int ldw, int c0, const float* g, int kb, int nb, int lane) {
    const float* p = W + (size_t)(128 * kb) * ldw + c0 + 32 * nb;
    const int lo = (lane >> 5) * ldw + (lane & 31);
#pragma unroll
    for (int i = 0; i < 64; ++i) { float v = (p + (size_t)(2 * i) * ldw)[lo]; if (HASG) v *= g[128 * kb + 2 * i + (lane >> 5)]; t.v[i] = v; }
}
template <int MODE, bool F8> __device__ __forceinline__ void transpose_store(const TrReg& t, int K, void* WTv, int half, LAS float* scr, int kb, int nb, int lane, float wmul, const unsigned* wmax = nullptr) {
    const int k0 = 128 * kb, n0 = 32 * nb;
#pragma unroll
    for (int i = 0; i < 64; ++i) scr[(2 * i + (lane >> 5)) * 33 + (lane & 31)] = t.v[i];
    LDS_WAIT(); asm volatile("" ::: "memory");
    const int c = lane & 7;
#pragma unroll
    for (int j = 0; j < 4; ++j) { const int n = (lane >> 3) + 8 * j; const LAS float* s = scr + (16 * c) * 33 + n;
        const int col = n0 + n; const int orow = MODE == 0 ? col : (256 * (col >> 7) + 128 * half + (col & 127));
        float v[16];
#pragma unroll
        for (int e = 0; e < 16; ++e) v[e] = s[e * 33] * wmul;
        if (wmax) { const float mx = __uint_as_float(wmax[orow]); const float qs = mx > 0.f ? 127.0f / mx : 0.f;
            u32x4 o; o.x = pg8::q4_i8(v[0], v[1], v[2], v[3], qs); o.y = pg8::q4_i8(v[4], v[5], v[6], v[7], qs); o.z = pg8::q4_i8(v[8], v[9], v[10], v[11], qs); o.w = pg8::q4_i8(v[12], v[13], v[14], v[15], qs);
            *(GAS u32x4*)((unsigned char*)WTv + (size_t)orow * K + k0 + 16 * c) = o; }
        else if constexpr (F8) { u32x4 o; o.x = pg8::pk4_fp8(v[0], v[1], v[2], v[3]); o.y = pg8::pk4_fp8(v[4], v[5], v[6], v[7]); o.z = pg8::pk4_fp8(v[8], v[9], v[10], v[11]); o.w = pg8::pk4_fp8(v[12], v[13], v[14], v[15]);
            *(GAS u32x4*)((unsigned char*)WTv + (size_t)orow * K + k0 + 16 * c) = o; }
        else { bf16_t* WT = (bf16_t*)WTv; u32x4 o0, o1; o0.x = cvt_pk_bf16(v[0], v[1]); o0.y = cvt_pk_bf16(v[2], v[3]); o0.z = cvt_pk_bf16(v[4], v[5]); o0.w = cvt_pk_bf16(v[6], v[7]);
            o1.x = cvt_pk_bf16(v[8], v[9]); o1.y = cvt_pk_bf16(v[10], v[11]); o1.z = cvt_pk_bf16(v[12], v[13]); o1.w = cvt_pk_bf16(v[14], v[15]);
            *(GAS u32x4*)(WT + (size_t)orow * K + k0 + 16 * c) = o0; *(GAS u32x4*)(WT + (size_t)orow * K + k0 + 16 * c + 8) = o1; } }
    LDS_WAIT(); asm volatile("" ::: "memory");
}
template <int MODE, bool F8 = false> __device__ __forceinline__ void convert_matrix(Frame& F, const float* W, int K, int ldw, int c0, int ncols, const float* g, void* WT, int half, int& itbase, float wmul = 1.f, const unsigned* wmax = nullptr) {
    LAS float* scr = (LAS float*)(F.lds + F.wave * 16896);
    const int gw = F.vcu * NWAVES + F.wave, NGW = F.G * NWAVES; const int nblk = ncols / 32, nit = (K / 128) * nblk;
    int it = (gw - (itbase % NGW) + NGW) % NGW;
    itbase += nit;
    if (it >= nit) return;
    TrReg r0, r1;
    auto LOADI = [&](TrReg& t, int i_) { if (g) transpose_load<true>(t, W, ldw, c0, g, i_ / nblk, i_ % nblk, F.lane); else transpose_load<false>(t, W, ldw, c0, g, i_ / nblk, i_ % nblk, F.lane); };
    LOADI(r0, it);
    for (;;) {
        if (it + NGW < nit) LOADI(r1, it + NGW);
        transpose_store<MODE, F8>(r0, K, WT, half, scr, it / nblk, it % nblk, F.lane, wmul, wmax);
        it += NGW; if (it >= nit) break;
        r0 = r1;
    }
}
template <int MODE> __device__ __forceinline__ void colmax_matrix(Frame& F, const float* W, int K, int ldw, int ncols, const float* g, unsigned* wmax, int half, int& itbase) {
    const int gw = F.vcu * NWAVES + F.wave, NGW = F.G * NWAVES; const int nblk = ncols / 32, nit = (K / 128) * nblk;
    int it = (gw - (itbase % NGW) + NGW) % NGW; itbase += nit;
    for (; it < nit; it += NGW) { TrReg r; transpose_load<true>(r, W, ldw, 0, g, it / nblk, it % nblk, F.lane); float m = 0.f;
#pragma unroll
        for (int i = 0; i < 64; ++i) m = fmaxf(m, fabsf(r.v[i]));
        m = fmaxf(m, __shfl_xor(m, 32));
        if (F.lane < 32) { const int col = 32 * (it % nblk) + F.lane; const int orow = MODE == 0 ? col : (256 * (col >> 7) + 128 * half + (col & 127)); atomicMax(wmax + orow, __float_as_uint(m)); } }
}

__device__ __forceinline__ void quantize_wino(Frame& F, const Args& a, int j) {
    int itb = 0; convert_matrix<0, true>(F, a.in[17] + (size_t)j * D * OIN, D, OIN, 0, 3072, a.in[1] + (2 * j + 1) * D, (unsigned char*)(F.ws + WS_WINO) + (size_t)j * 3072 * D, 0, itb, 1.f, (const unsigned*)(F.ws + CTL_WMAXO) + j * 3072);
}
__device__ __forceinline__ void quantize_w13(Frame& F, const Args& a, int j) {
    int itb = 0; const unsigned* wm = (const unsigned*)(F.ws + CTL_WMAX) + j * 2 * DFF;
    convert_matrix<1, true>(F, a.in[14] + (size_t)j * D * DFF, D, DFF, 0, DFF, a.in[2] + (2 * j) * D, (unsigned char*)(F.ws + WS_W13F) + (size_t)j * 2 * DFF * D, 0, itb, 1.f, wm);
    convert_matrix<1, true>(F, a.in[15] + (size_t)j * D * DFF, D, DFF, 0, DFF, a.in[2] + (2 * j) * D, (unsigned char*)(F.ws + WS_W13F) + (size_t)j * 2 * DFF * D, 1, itb, 1.f, wm);
}
__device__ __forceinline__ void colmax_wine(Frame& F, const Args& a) {
    int itb = 0;
    for (int j = 0; j < 2; ++j) colmax_matrix<0>(F, a.in[4] + (size_t)j * D * EIN, D, EIN, 2560, a.in[1] + (2 * j) * D, (unsigned*)(F.ws + CTL_WMAXE) + j * 2560, 0, itb);
}
__device__ __forceinline__ void convert_dense(Frame& F, const Args& a) {
    int itb = 0;
    for (int j = 0; j < 2; ++j) {
#if E1_I8
        convert_matrix<0, true>(F, a.in[4] + (size_t)j * D * EIN, D, EIN, 0, 2560, a.in[1] + (2 * j) * D, (unsigned char*)(F.ws + WS_WINE) + (size_t)j * 2560 * D, 0, itb, 1.f, (const unsigned*)(F.ws + CTL_WMAXE) + j * 2560);
#else
        convert_matrix<0>(F, a.in[4] + (size_t)j * D * EIN, D, EIN, 0, 2560, a.in[1] + (2 * j) * D, (bf16_t*)(F.ws + WS_WINE) + (size_t)j * 2560 * D, 0, itb);
#endif
        convert_matrix<0>(F, a.in[13] + (size_t)j * D * D, D, D, 0, D, nullptr, (bf16_t*)(F.ws + WS_WOUTE) + (size_t)j * D * D, 0, itb);
#if FFN_UP_I8
        colmax_matrix<1>(F, a.in[14] + (size_t)j * D * DFF, D, DFF, DFF, a.in[2] + (2 * j) * D, (unsigned*)(F.ws + CTL_WMAX) + j * 2 * DFF, 0, itb);
        colmax_matrix<1>(F, a.in[15] + (size_t)j * D * DFF, D, DFF, DFF, a.in[2] + (2 * j) * D, (unsigned*)(F.ws + CTL_WMAX) + j * 2 * DFF, 1, itb);
#elif FFN_UP_FP8
        convert_matrix<1, true>(F, a.in[14] + (size_t)j * D * DFF, D, DFF, 0, DFF, a.in[2] + (2 * j) * D, (unsigned char*)(F.ws + WS_W13F) + (size_t)j * 2 * DFF * D, 0, itb, W13_MUL);
        convert_matrix<1, true>(F, a.in[15] + (size_t)j * D * DFF, D, DFF, 0, DFF, a.in[2] + (2 * j) * D, (unsigned char*)(F.ws + WS_W13F) + (size_t)j * 2 * DFF * D, 1, itb, W13_MUL);
#else
        convert_matrix<1>(F, a.in[14] + (size_t)j * D * DFF, D, DFF, 0, DFF, a.in[2] + (2 * j) * D, (bf16_t*)(F.ws + WS_W13F) + (size_t)j * 2 * DFF * D, 0, itb);
        convert_matrix<1>(F, a.in[15] + (size_t)j * D * DFF, D, DFF, 0, DFF, a.in[2] + (2 * j) * D, (bf16_t*)(F.ws + WS_W13F) + (size_t)j * 2 * DFF * D, 1, itb);
#endif
#if FFN_DN_FP8
        convert_matrix<0, true>(F, a.in[16] + (size_t)j * DFF * D, DFF, D, 0, D, nullptr, (unsigned char*)(F.ws + WS_W2F) + (size_t)j * D * DFF, 0, itb, W2_MUL);
#else
        convert_matrix<0>(F, a.in[16] + (size_t)j * DFF * D, DFF, D, 0, D, nullptr, (bf16_t*)(F.ws + WS_W2F) + (size_t)j * D * DFF, 0, itb);
#endif
#if IN_O_I8
        colmax_matrix<0>(F, a.in[17] + (size_t)j * D * OIN, D, OIN, 3072, a.in[1] + (2 * j + 1) * D, (unsigned*)(F.ws + CTL_WMAXO) + j * 3072, 0, itb);
#else
        convert_matrix<0>(F, a.in[17] + (size_t)j * D * OIN, D, OIN, 0, 3072, a.in[1] + (2 * j + 1) * D, (bf16_t*)(F.ws + WS_WINO) + (size_t)j * 3072 * D, 0, itb);
#endif
        convert_matrix<0>(F, a.in[21] + (size_t)j * D * D, D, D, 0, D, nullptr, (bf16_t*)(F.ws + WS_WOUTO) + (size_t)j * D * D, 0, itb);
    }
    const int gt = (F.vcu * NTHR + F.tid), NT_ = F.G * NTHR;
    for (int idx = gt; idx < 2 * 16 * 1024; idx += NT_) { const int j = idx >> 14, c = (idx >> 10) & 15, k = idx & 1023;
        ((bf16_t*)(F.ws + WS_SMALL + SM_WLR))[idx] = (bf16_t)f2bf(a.in[17][(size_t)j * D * OIN + (size_t)k * OIN + 3072 + c] * a.in[1][(2 * j + 1) * D + k]); }
    for (int idx = gt; idx < 2 * 8 * 64 * 64; idx += NT_) { const int jn = idx >> 12, jj = (idx >> 6) & 63, i = idx & 63;
        ((bf16_t*)(F.ws + WS_SMALL + SM_GAT))[idx] = (bf16_t)f2bf(a.in[7][(size_t)jn * 4096 + i * 64 + jj]);
        ((bf16_t*)(F.ws + WS_SMALL + SM_GXT))[idx] = (bf16_t)f2bf(a.in[9][(size_t)jn * 4096 + i * 64 + jj]); }
}
constexpr int CV_PER_MAT = 896, CV_W13 = NE * 2 * CV_PER_MAT  , CV_ITEMS = NE * 3 * CV_PER_MAT;
struct CvItem { const float* W; unsigned char* WT; int K, ldw, kb, nb, half, mode; float mul; };
__device__ __forceinline__ CvItem cv_decode(const Args& a, unsigned char* ws, int j, int g) {
    CvItem c;
    if (g < CV_W13) { const int e = g / (2 * CV_PER_MAT), r = g % (2 * CV_PER_MAT), mat = r / CV_PER_MAT, it = r % CV_PER_MAT; const size_t eo = (size_t)j * NE + e;
        c.W = a.in[23 + mat] + eo * D * DFE; c.WT = ws + WS_W13E + (size_t)j * W13E_PAIR + (size_t)e * 2 * DFE * D; c.K = D; c.ldw = DFE; c.kb = it / 112; c.nb = it % 112; c.half = mat; c.mode = 1; c.mul = W13_MUL; }
    else { const int q = g - CV_W13, e = q / CV_PER_MAT, it = q % CV_PER_MAT; const size_t eo = (size_t)j * NE + e;
        c.W = a.in[25] + eo * DFE * D; c.WT = ws + WS_W2E + (size_t)e * D * DFE; c.K = DFE; c.ldw = D; c.kb = it / 32; c.nb = it % 32; c.half = 0; c.mode = 0; c.mul = W2_MUL; }
    return c;
}
__device__ __forceinline__ void convert_experts_range(Frame& F, const Args& a, int j, int lo, int hi, int wk, int nw) {
    LAS float* scr = (LAS float*)(F.lds + F.wave * 16896);
    int g = lo + wk; if (g >= hi) return;
    TrReg r0, r1; CvItem c0 = cv_decode(a, F.ws, j, g), c1 = c0;
    transpose_load<false>(r0, c0.W, c0.ldw, 0, nullptr, c0.kb, c0.nb, F.lane);
    for (;;) {
        const bool more = g + nw < hi;
        if (more) { c1 = cv_decode(a, F.ws, j, g + nw); transpose_load<false>(r1, c1.W, c1.ldw, 0, nullptr, c1.kb, c1.nb, F.lane); }
        if (c0.mode == 1) transpose_store<1, true>(r0, c0.K, c0.WT, c0.half, scr, c0.kb, c0.nb, F.lane, c0.mul); else transpose_store<0, true>(r0, c0.K, c0.WT, c0.half, scr, c0.kb, c0.nb, F.lane, c0.mul);
        if (!more) break;
        g += nw; r0 = r1; c0 = c1;
    }
}
#ifndef CV_T1_V
#define CV_T1_V (E1_I8 ? 3072 : (FFN_UP_I8 ? 5120 : 4096))
#endif
#ifndef CV_O4B_V
#define CV_O4B_V 4096
#endif
constexpr int CV_O4B = CV_O4B_V;
constexpr int CV_T1 = CV_T1_V, CV_T2 = FFN_UP_I8 ? 3072 : 4096, CV_PRE = 6144;
constexpr int SEAM_ITEMS = 1024, FILL0_LO = CV_T1 + CV_T2, FILL_END = FILL0_LO + 13 * SEAM_ITEMS, FILL1_LO = CV_PRE + CV_O4B + CV_T1 + CV_T2;
static_assert(FILL_END <= CV_ITEMS && FILL1_LO + 3 * SEAM_ITEMS == FILL_END && FILL0_LO + 7 * SEAM_ITEMS <= CV_W13 + SEAM_ITEMS && FILL1_LO >= CV_W13, "seam filler ranges");
__device__ __forceinline__ void seam_fill(Frame& F0, const Args& a, int k, int jj, int base, const XcdBarrier& bar) {
    asm volatile("s_waitcnt vmcnt(0)" ::: "memory");
    __syncthreads();
    Frame F = F0; { int t_ = threadIdx.x; asm volatile("" : "+v"(t_)); F.tid = t_; F.lane = t_ & 63; }
    const int wk = F.wave * F.G + F.vcu; const bool has = wk < SEAM_ITEMS;
    TrReg r; const CvItem c = cv_decode(a, F.ws, jj, base + (has ? wk : 0));
    if (has) transpose_load<false>(r, c.W, c.ldw, 0, nullptr, c.kb, c.nb, F.lane);
    XcdSplit sp; sp.gen = 0u; sp.leader = false;
    if (F.tid == 0) sp = xcd_arrive(bar);
    if (has) { LAS float* scr = (LAS float*)(F.lds + F.wave * 16896);
        if (c.mode == 1) transpose_store<1, true>(r, c.K, c.WT, c.half, scr, c.kb, c.nb, F.lane, c.mul); else transpose_store<0, true>(r, c.K, c.WT, c.half, scr, c.kb, c.nb, F.lane, c.mul); }
    if (F.tid == 0) xcd_wait(bar, sp);
    __syncthreads();
    (void)k;
}
__device__ __forceinline__ int tail_first(int nwg) { const int rounds = (nwg + 255) >> 8; const int full = nwg - (rounds - 1) * 256; return full; }

struct RowV { f32x4 v[4]; };
__device__ __forceinline__ void row_load(RowV& r, const float* p, int lane) { const GAS f32x4* x = (const GAS f32x4*)p + lane;
#pragma unroll
    for (int j = 0; j < 4; ++j) r.v[j] = x[64 * j]; }
__device__ __forceinline__ void row_load_bf16(RowV& r, const bf16_t* p, int lane) { const GAS u32x2* x = (const GAS u32x2*)p + lane;
#pragma unroll
    for (int j = 0; j < 4; ++j) { const u32x2 w = x[64 * j]; r.v[j] = (f32x4){bflo(w.x), bfhi(w.x), bflo(w.y), bfhi(w.y)}; } }
__device__ __forceinline__ float row_sumsq(const RowV& r) { float s = 0.f;
#pragma unroll
    for (int j = 0; j < 4; ++j) s += (r.v[j].x * r.v[j].x + r.v[j].y * r.v[j].y) + (r.v[j].z * r.v[j].z + r.v[j].w * r.v[j].w);
    return wave_sum(s); }
__device__ __forceinline__ void row_store_f32(const RowV& r, float* p, int lane) { GAS f32x4* x = (GAS f32x4*)p + lane;
#pragma unroll
    for (int j = 0; j < 4; ++j) x[64 * j] = r.v[j]; }
__device__ __forceinline__ void row_store_bf16(const RowV& r, bf16_t* p, int lane) { GAS u32x2* x = (GAS u32x2*)p + lane;
#pragma unroll
    for (int j = 0; j < 4; ++j) { u32x2 w; w.x = cvt_pk_bf16(r.v[j].x, r.v[j].y); w.y = cvt_pk_bf16(r.v[j].z, r.v[j].w); x[64 * j] = w; } }
__device__ __forceinline__ void row_store_fp8(const RowV& r, unsigned char* p, int lane) { GAS unsigned* x = (GAS unsigned*)p + lane;
#pragma unroll
    for (int j = 0; j < 4; ++j) x[64 * j] = pg8::pk4_fp8(r.v[j].x, r.v[j].y, r.v[j].z, r.v[j].w); }
__device__ __forceinline__ float row_store_i8max(const RowV& r, unsigned char* p, int lane) { float mx = 0.f;
#pragma unroll
    for (int j = 0; j < 4; ++j) mx = fmaxf(fmaxf(mx, fmaxf(fabsf(r.v[j].x), fabsf(r.v[j].y))), fmaxf(fabsf(r.v[j].z), fabsf(r.v[j].w)));
#pragma unroll
    for (int o = 32; o >= 1; o >>= 1) mx = fmaxf(mx, __shfl_xor(mx, o));
    const float qs = mx > 0.f ? 127.0f / mx : 0.f; GAS unsigned* x = (GAS unsigned*)p + lane;
#pragma unroll
    for (int j = 0; j < 4; ++j) x[64 * j] = pg8::q4_i8(r.v[j].x, r.v[j].y, r.v[j].z, r.v[j].w, qs);
    return mx * (1.0f / 127.0f); }
template <int NC> __device__ __forceinline__ void row_dots(const RowV& r, const LAS float* Wl, int lane, float (&out)[NC]) {
#pragma unroll
    for (int c = 0; c < NC; ++c) { float s = 0.f;
#pragma unroll
        for (int j = 0; j < 4; ++j) { const f32x4 w = *(const LAS f32x4*)(Wl + c * 1024 + 4 * lane + 256 * j); s += (r.v[j].x * w.x + r.v[j].y * w.y) + (r.v[j].z * w.z + r.v[j].w * w.w); }
        out[c] = wave_sum(s); }
}
template <int NC, int NR> __device__ __forceinline__ void row_dots_n(const RowV (&r)[NR], const LAS float* Wl, int lane, float (&out)[NR][NC]) {
#pragma unroll
    for (int c = 0; c < NC; ++c) { f32x4 w[4];
#pragma unroll
        for (int j = 0; j < 4; ++j) w[j] = *(const LAS f32x4*)(Wl + c * 1024 + 4 * lane + 256 * j);
#pragma unroll
        for (int u = 0; u < NR; ++u) { float s = 0.f;
#pragma unroll
            for (int j = 0; j < 4; ++j) s += (r[u].v[j].x * w[j].x + r[u].v[j].y * w[j].y) + (r[u].v[j].z * w[j].z + r[u].v[j].w * w[j].w);
            out[u][c] = wave_sum(s); } }
}
__device__ __forceinline__ void stage_table8(Frame& F, LAS float* Wl, const float* W, int ldw, int c0, const float* g) {
    for (int idx = F.tid; idx < 8192; idx += NTHR) { const int k = idx >> 3, c = idx & 7; Wl[c * 1024 + k] = W[(size_t)k * ldw + c0 + c] * (g ? g[k] : 1.f); }
    __syncthreads();
}
__device__ __forceinline__ void p0_rows(Frame& F, const Args& a) {
    LAS float* Wl = (LAS float*)(F.lds);
    stage_table8(F, Wl, a.in[4], EIN, 2560, a.in[1]);
    float* ssa = (float*)(F.ws + WS_SMALL + SM_SSA); bf16_t* hb = (bf16_t*)(F.ws + WS_HB); float* flog = (float*)(F.ws + WS_ESM + ES_FLOG);
    const int gw = F.vcu * NWAVES + F.wave, NGW = F.G * NWAVES;
    for (int m0 = gw; m0 < T; m0 += 4 * NGW) {
        RowV rr[4];
#pragma unroll
        for (int u = 0; u < 4; ++u) { const int m = m0 + u * NGW; if (m < T) row_load(rr[u], a.in[0] + (size_t)m * D, F.lane); }
        float dta[4][8]; row_dots_n<8, 4>(rr, Wl, F.lane, dta);
#pragma unroll
        for (int u = 0; u < 4; ++u) { const int m = m0 + u * NGW; if (m < T) { const RowV& r = rr[u];
            const float ss = row_sumsq(r); const float inv = 1.0f / sqrtf(ss * (1.f / D) + EPS);
            if (!E1_I8 || BUILD_MODE != 0 || a.pad != 0) row_store_bf16(r, hb + (size_t)m * D, F.lane);
#if E1_I8
            { const float st = row_store_i8max(r, (unsigned char*)(F.ws + WS_HB8E) + (size_t)m * D, F.lane); if (F.lane == 0) ((float*)(F.ws + WS_SMALL + SM_STEPE))[m] = st; }
#endif
            float dts[8];
#pragma unroll
            for (int c = 0; c < 8; ++c) dts[c] = dta[u][c];
            if (F.lane == 0) ssa[m] = ss;
            if (F.lane < 8) { float v = dts[0];
#pragma unroll
                for (int c = 1; c < 8; ++c) v = (F.lane == c) ? dts[c] : v;
                flog[m * 8 + F.lane] = v * inv; } } }
    }
    __syncthreads();
}
}
#ifndef ATTN_EXIT
#define ATTN_EXIT 1
#endif
namespace attn_body {
using bf16=__hip_bfloat16;
constexpr int BATCH=4,NHEAD=8,SEQ=4096,D=64,DM=NHEAD*D,ODM=1024,OCOL=512;
constexpr int NW=8,QBLK=32,QB=QBLK*NW,KVBLK=64,NQB=SEQ/QB;
constexpr int ATTN_PITCH=DM, ATTN_UNIT_ROWS=QB;
__device__ __forceinline__ int crow(int r,int hi){return (r&3)+8*(r>>2)+4*hi;}
#define SBAR() __builtin_amdgcn_sched_barrier(0)
__device__ __forceinline__ void cmask(f32x16&p0,f32x16&p1,int jb,int qrel,int hi){
  const float NEG=-INFINITY; int kb=64*jb+4*hi;
  #pragma unroll
  for(int r=0;r<16;++r){int kv=kb+(r&3)+8*(r>>2); if(kv>qrel)p0[r]=NEG; if(kv+32>qrel)p1[r]=NEG;}
}

constexpr int NSLOT=3, SLOTB=8192;
constexpr int LDS_K=0, LDS_V=NSLOT*SLOTB, LDS_WS=2*NSLOT*SLOTB, LDS_OST=LDS_WS+NW*64*4, LDS_CB=LDS_OST+NW*4096, LDS_STOP=LDS_CB+SEQ*4, LDS_BYTES=LDS_STOP+64;
constexpr float C2=0.125f*1.4426950408889634f;
__device__ __forceinline__ void glds16(const void*gsrc,unsigned lds_dst){unsigned keep;
  asm volatile("s_mov_b32 %0, m0\n\ts_mov_b32 m0, %2\n\ts_nop 0\n\tglobal_load_lds_dwordx4 %1, off\n\ts_mov_b32 m0, %0":"=&s"(keep):"v"(gsrc),"s"(lds_dst):"memory");}
__device__ __forceinline__ float max3f(float a,float b,float c){float r;asm("v_max3_f32 %0, %1, %2, %3":"=v"(r):"v"(a),"v"(b),"v"(c));return r;}
__device__ __forceinline__ float max2f(float a,float b){float r;asm("v_max_f32_e32 %0, %1, %2":"=v"(r):"v"(a),"v"(b));return r;}
__device__ __forceinline__ float fadd_s(float a,float b){float r;asm("v_add_f32_e32 %0, %1, %2":"=v"(r):"v"(a),"v"(b));return r;}
__device__ __forceinline__ float fsub_s(float a,float b){float r;asm("v_sub_f32_e32 %0, %1, %2":"=v"(r):"v"(a),"v"(b));return r;}
typedef float f32x2_t __attribute__((ext_vector_type(2))); typedef __bf16 bf16x2_t __attribute__((ext_vector_type(2)));
__device__ __forceinline__ unsigned cvtpk_s(float lo,float hi){f32x2_t v={lo,hi};bf16x2_t b=__builtin_convertvector(v,bf16x2_t);return __builtin_bit_cast(unsigned,b);}
#define WAIT_BAR(N) asm volatile("s_waitcnt vmcnt(" #N ") lgkmcnt(0)\n\ts_barrier":::"memory")

__device__ __forceinline__ void qkt(f32x16&p0,f32x16&p1,const char*Kslot,const bf16x8*qr,const f32x16&negm,int r32,int hi){
  const char*kb=Kslot+hi*1024+r32*16;
  #pragma unroll
  for(int d0=0;d0<4;++d0){
    const bf16x8 b0=*reinterpret_cast<const bf16x8*>(kb+d0*2048);
    const bf16x8 b1=*reinterpret_cast<const bf16x8*>(kb+d0*2048+512);
    if(d0==0){p0=__builtin_amdgcn_mfma_f32_32x32x16_bf16(b0,qr[0],negm,0,0,0);p1=__builtin_amdgcn_mfma_f32_32x32x16_bf16(b1,qr[0],negm,0,0,0);}
    else{p0=__builtin_amdgcn_mfma_f32_32x32x16_bf16(b0,qr[d0],p0,0,0,0);p1=__builtin_amdgcn_mfma_f32_32x32x16_bf16(b1,qr[d0],p1,0,0,0);}}
}
typedef __attribute__((address_space(3))) const char* lds_cptr;
typedef short v4i16_t __attribute__((ext_vector_type(4)));
__device__ __forceinline__ void kload8(bf16x8*kf,lds_cptr kp){
  kf[0]=*(const __attribute__((address_space(3))) bf16x8*)(kp);      kf[1]=*(const __attribute__((address_space(3))) bf16x8*)(kp+512);
  kf[2]=*(const __attribute__((address_space(3))) bf16x8*)(kp+2048); kf[3]=*(const __attribute__((address_space(3))) bf16x8*)(kp+2560);
  kf[4]=*(const __attribute__((address_space(3))) bf16x8*)(kp+4096); kf[5]=*(const __attribute__((address_space(3))) bf16x8*)(kp+4608);
  kf[6]=*(const __attribute__((address_space(3))) bf16x8*)(kp+6144); kf[7]=*(const __attribute__((address_space(3))) bf16x8*)(kp+6656);
}
__device__ __forceinline__ void kload2(bf16x8*kf,lds_cptr kp,int j){ kf[2*j]=*(const __attribute__((address_space(3))) bf16x8*)(kp+j*2048); kf[2*j+1]=*(const __attribute__((address_space(3))) bf16x8*)(kp+j*2048+512); }
__device__ __forceinline__ s16x4 vtr(lds_cptr p){ return __builtin_bit_cast(s16x4,__builtin_amdgcn_ds_read_tr16_b64_v4i16((__attribute__((address_space(3))) v4i16_t*)p)); }
__device__ __forceinline__ float rowmax(const f32x16&p0,const f32x16&p1){
  float a=max3f(p0[0],p0[1],p1[0]),b=max3f(p0[2],p0[3],p1[1]);a=max3f(a,p1[2],p1[3]);
  #pragma unroll
  for(int r=4;r<16;r+=4){a=max3f(a,p0[r],p0[r+1]);b=max3f(b,p0[r+2],p0[r+3]);a=max3f(a,p1[r],p1[r+1]);b=max3f(b,p1[r+2],p1[r+3]);}
  const float m=max2f(a,b);
  auto rr=__builtin_amdgcn_permlane32_swap(__float_as_uint(m),__float_as_uint(m),false,false);
  return max2f(__uint_as_float(rr[0]),__uint_as_float(rr[1]));
}
__device__ __forceinline__ void pv(f32x16*o,int vb,bf16x8 pa0,bf16x8 pa1,bf16x8 pa2,bf16x8 pa3){
  #pragma unroll
  for(int d0=0;d0<2;++d0){s16x4 lo[4],hi[4];
    #pragma unroll
    for(int ks=0;ks<4;++ks){
      asm volatile("ds_read_b64_tr_b16 %0,%1 offset:%c2":"=&v"(lo[ks]):"v"(vb),"i"(d0*4096+ks*1024):"memory");
      asm volatile("ds_read_b64_tr_b16 %0,%1 offset:%c2":"=&v"(hi[ks]):"v"(vb),"i"(d0*4096+ks*1024+512):"memory");}
    asm volatile("s_waitcnt lgkmcnt(0)":::"memory");SBAR();
    #define PK(k) (bf16x8){lo[k][0],lo[k][1],lo[k][2],lo[k][3],hi[k][0],hi[k][1],hi[k][2],hi[k][3]}
    o[d0]=__builtin_amdgcn_mfma_f32_32x32x16_bf16(pa0,PK(0),o[d0],0,0,0);
    o[d0]=__builtin_amdgcn_mfma_f32_32x32x16_bf16(pa1,PK(1),o[d0],0,0,0);
    o[d0]=__builtin_amdgcn_mfma_f32_32x32x16_bf16(pa2,PK(2),o[d0],0,0,0);
    o[d0]=__builtin_amdgcn_mfma_f32_32x32x16_bf16(pa3,PK(3),o[d0],0,0,0);
    #undef PK
  }
}

#ifndef ATTN_STORE16
#define ATTN_STORE16(p,v) (*(u32x4*)(p)=(v))
#endif
template<int THRL> __device__ __forceinline__ void attn_unit(int b,int h,int qb,const bf16*Q,const bf16*__restrict__ K,const bf16*__restrict__ V,bf16*O,const float*CPbh,const float*segt,const float kmax,char*shm){
  int tid_=threadIdx.x; asm volatile("":"+v"(tid_));
  const int tid=tid_,lane=tid&63,r32=lane&31,hi=lane>>5; const int wid=__builtin_amdgcn_readfirstlane(tid>>6);
  const long rowbase=(long)b*SEQ; const int q0=qb*QB;
  const bf16*Qw=Q+(rowbase+q0+wid*QBLK)*DM+h*D;
  const bf16*Kh=K+rowbase*DM+h*D,*Vh=V+rowbase*DM+h*D;
  const unsigned lds0=(unsigned)(uintptr_t)shm;
  float*wsf=(float*)(shm+LDS_WS)+wid*64;
  const bf16*ksrc=Kh+(long)lane*DM+wid*8;
  const bf16*vsrc=Vh+(long)(16*(wid&3)+(lane>>2))*DM+(wid>>2)*32+(lane&3)*8;
  const unsigned kdst=lds0+LDS_K+wid*1024, vdst=lds0+LDS_V+wid*1024;
  #define PT(x) (NT-1-(x))
  #define DMA_K(t,slot) glds16(ksrc+(long)PT(t)*KVBLK*DM,(unsigned)__builtin_amdgcn_readfirstlane(kdst+(slot)))
  #define DMA_V(t,slot) glds16(vsrc+(long)PT(t)*KVBLK*DM,(unsigned)__builtin_amdgcn_readfirstlane(vdst+(slot)))
  const int vb0=(int)(lds0+LDS_V)+((lane>>4)&1)*32+(lane&3)*8+(4*hi+((lane&15)>>2))*64;
  const char*Kbase=shm+LDS_K; bf16x8 kf[8];
  const lds_cptr shm3=(lds_cptr)shm; const lds_cptr kp0=shm3+LDS_K+hi*1024+r32*16; const lds_cptr vp0=shm3+LDS_V+((lane>>4)&1)*32+(lane&3)*8+(4*hi+((lane&15)>>2))*64;
  const int NT=(q0+QB)/KVBLK;
  DMA_K(0,0);DMA_V(0,0);DMA_K(1,SLOTB);
  bf16x8 qr[4];
  #pragma unroll
  for(int d0=0;d0<4;++d0)qr[d0]=*reinterpret_cast<const bf16x8*>(&Qw[(long)r32*DM+d0*16+hi*8]);
  { __attribute__((address_space(3))) f32x4* dst=(__attribute__((address_space(3))) f32x4*)((__attribute__((address_space(3))) char*)shm+LDS_CB); const f32x4* src=(const f32x4*)CPbh; const int n4=(q0+QB)/4;
    float sg[8]; _Pragma("unroll") for(int q_=0;q_<8;++q_) sg[q_]=segt[q_];
    float ofa=0.f,ofb=0.f; { const int sa_=tid>>7; float run_=0.f; _Pragma("unroll") for(int q_=0;q_<8;++q_){ if(q_==sa_)ofa=run_; if(q_==sa_+4)ofb=run_; run_+=sg[q_]; } }
    if(tid<n4){ f32x4 v=src[tid]; v=v+ofa; dst[tid]=v; } if(tid+NW*64<n4){ f32x4 v=src[tid+NW*64]; v=v+ofb; dst[tid+NW*64]=v; } }
  const __attribute__((address_space(3))) float* cbl=(const __attribute__((address_space(3))) float*)((lds_cptr)shm+LDS_CB)+4*hi;
  #define BIAS(P0,P1,t) do{ const __attribute__((address_space(3))) float* cbp_=cbl+64*PT(t); _Pragma("unroll") for(int g_=0;g_<4;++g_){ const f32x4 b0_=*(const __attribute__((address_space(3))) f32x4*)(cbp_+8*g_), b1_=*(const __attribute__((address_space(3))) f32x4*)(cbp_+8*g_+32); \
      _Pragma("unroll") for(int q_=0;q_<4;++q_){ P0[4*g_+q_]-=b0_[q_]; P1[4*g_+q_]-=b1_[q_]; } } }while(0)
  float mhat=0.f,l_reg=0.f;f32x16 o[2];o[0]=f32x16{};o[1]=f32x16{};
  const int qrel=wid*QBLK+r32;
  #define CMASK(P0,P1,t) do{int jb_=3-(t); if(jb_>=0)cmask(P0,P1,jb_,qrel,hi);}while(0)
  bool resc=false;
  #define START(P0,P1) do{ const float rm=rowmax(P0,P1); resc=false; \
    { const float dl=(rm==-INFINITY)?0.f:rm; mhat=fadd_s(mhat,dl);     \
      _Pragma("unroll") for(int r=0;r<16;++r){P0[r]=fsub_s(P0[r],dl);P1[r]=fsub_s(P1[r],dl);} \
      } \
    _Pragma("unroll") for(int r=0;r<16;++r)P0[r]=__builtin_amdgcn_exp2f(P0[r]); }while(0)
  #define RESC() do{ if(resc){ asm volatile("s_waitcnt lgkmcnt(0)":::"memory"); \
      _Pragma("unroll") for(int d_=0;d_<2;++d_) _Pragma("unroll") for(int r=0;r<16;++r)o[d_][r]*=wsf[crow(r,hi)]; } }while(0)
  f32x16 pA0,pA1,pB0,pB1;
  int sl_prev=0,sl_cur=0,sl_next=SLOTB;
  #define ROT() do{sl_prev=sl_cur;sl_cur=sl_next;sl_next=(sl_next==(NSLOT-1)*SLOTB)?0:sl_next+SLOTB;}while(0)
  DMA_K(2,2*SLOTB);
  WAIT_BAR(3);
  { f32x16 z0_=f32x16{}; asm volatile("":"+v"(z0_)); qkt(pA0,pA1,Kbase,qr,z0_,r32,hi); }asm volatile("s_nop 15\n\ts_nop 7":"+v"(pA0),"+v"(pA1));BIAS(pA0,pA1,0);CMASK(pA0,pA1,0);
  START(pA0,pA1);
  _Pragma("unroll") for(int r=0;r<16;++r)pA1[r]=__builtin_amdgcn_exp2f(pA1[r]);
  { const float nmh_=-mhat; _Pragma("unroll") for(int g_=0;g_<4;++g_){ const f32x4 b0_=*(const __attribute__((address_space(3))) f32x4*)(cbl+64*PT(1)+8*g_), b1_=*(const __attribute__((address_space(3))) f32x4*)(cbl+64*PT(1)+8*g_+32);
      _Pragma("unroll") for(int q_=0;q_<4;++q_){ pB0[4*g_+q_]=nmh_-b0_[q_]; pB1[4*g_+q_]=nmh_-b1_[q_]; } } }
  WAIT_BAR(0);
  DMA_K(3,0);DMA_V(1,SLOTB);
  ROT();
  kload8(kf,kp0+sl_cur);
  WAIT_BAR(2);
  s16x4 vlo[8],vhi[8]; u32x4 pw0,pw1,pw2,pw3;
  #define PKW(P,B) cvtpk_s(P[B],P[B+1])
  #define PAF(k) __builtin_bit_cast(bf16x8,pw##k)
  #define VFR(i) (bf16x8){vlo[i][0],vlo[i][1],vlo[i][2],vlo[i][3],vhi[i][0],vhi[i][1],vhi[i][2],vhi[i][3]}
  #define PIN(x) asm volatile("":"+v"(x))
  #define MX3(a,b,c) __builtin_fmaxf(__builtin_fmaxf((a),(b)),(c))
  #define GAPA(MF,A0,A1,A2,A3,W0,W1,PW) do{ MF; sacc+=A0; sacc+=A1; sacc+=A2; sacc+=A3; PIN(sacc); W0; W1; PIN(PW); SBAR(); }while(0)
  #define EX(v) __builtin_amdgcn_exp2f(v)
  #define INI(GI,P,g,p,t) do{ if(GI){ const f32x4 b_=*(const __attribute__((address_space(3))) f32x4*)(cbl+64*PT((t)+1)+8*(g)+32*(p)); P[4*(g)]=nmh_-b_[0]; P[4*(g)+1]=nmh_-b_[1]; P[4*(g)+2]=nmh_-b_[2]; P[4*(g)+3]=nmh_-b_[3]; PIN(P); } }while(0)
  #define GAPB(MF,X,B,INIT) do{ MF; X[B]=EX(X[B]); X[B+1]=EX(X[B+1]); X[B+2]=EX(X[B+2]); X[B+3]=EX(X[B+3]); PIN(X); INIT; SBAR(); }while(0)
  #define VRD(i) do{ vlo[i]=vtr(vp_+(((i)>>2)*4096+((i)&3)*1024)); vhi[i]=vtr(vp_+(((i)>>2)*4096+((i)&3)*1024+512)); }while(0)
  #define KRD(G,j) do{ if(G){ kload2(kf,kp0+sl_next,j); SBAR(); } }while(0)
  #define STEP(C0,C1,P0,P1,t,GK,GV,GL) do{ SBAR(); \
    const lds_cptr vp_=vp0+sl_prev; \
    VRD(0); SBAR(); float sacc=(P0[0]+P0[1]); \
    GAPA(C0=__builtin_amdgcn_mfma_f32_32x32x16_bf16(kf[0],qr[0],C0,0,0,0), P0[2],P0[3],P0[4],P0[5],     pw0[0]=PKW(P0,0), pw0[1]=PKW(P0,2), pw0); \
    VRD(4); SBAR(); GAPA(C1=__builtin_amdgcn_mfma_f32_32x32x16_bf16(kf[1],qr[0],C1,0,0,0), P0[6],P0[7],P0[8],P0[9],     pw0[2]=PKW(P0,4), pw0[3]=PKW(P0,6), pw0); \
    VRD(1); SBAR(); GAPA(C0=__builtin_amdgcn_mfma_f32_32x32x16_bf16(kf[2],qr[1],C0,0,0,0),   P0[10],P0[11],P0[12],P0[13], pw1[0]=PKW(P0,8), pw1[1]=PKW(P0,10), pw1); \
    VRD(5); SBAR(); GAPA(C1=__builtin_amdgcn_mfma_f32_32x32x16_bf16(kf[3],qr[1],C1,0,0,0),   P0[14],P0[15],P1[0],P1[1],   pw1[2]=PKW(P0,12),pw1[3]=PKW(P0,14), pw1); \
    VRD(2); SBAR(); GAPA(C0=__builtin_amdgcn_mfma_f32_32x32x16_bf16(kf[4],qr[2],C0,0,0,0),   P1[2],P1[3],P1[4],P1[5],     pw2[0]=PKW(P1,0), pw2[1]=PKW(P1,2), pw2); \
    VRD(6); SBAR(); GAPA(C1=__builtin_amdgcn_mfma_f32_32x32x16_bf16(kf[5],qr[2],C1,0,0,0),   P1[6],P1[7],P1[8],P1[9],     pw2[2]=PKW(P1,4), pw2[3]=PKW(P1,6), pw2); \
    VRD(3); SBAR(); GAPA(C0=__builtin_amdgcn_mfma_f32_32x32x16_bf16(kf[6],qr[3],C0,0,0,0),   P1[10],P1[11],P1[12],P1[13], pw3[0]=PKW(P1,8), pw3[1]=PKW(P1,10), pw3); \
    VRD(7); SBAR(); GAPA(C1=__builtin_amdgcn_mfma_f32_32x32x16_bf16(kf[7],qr[3],C1,0,0,0),   P1[14],P1[15],0.f,0.f,       pw3[2]=PKW(P1,12),pw3[3]=PKW(P1,14), pw3); \
    l_reg+=sacc; \
    if(GK){DMA_K((t)+3,sl_cur);} if(GV){DMA_V((t)+1,sl_next);} \
    CMASK(C0,C1,t); \
    { float a=MX3(C0[0],C0[1],C1[0]),b=MX3(C0[2],C0[3],C1[1]); a=MX3(a,C1[2],C1[3]); \
      _Pragma("unroll") for(int r=4;r<16;r+=4){a=MX3(a,C0[r],C0[r+1]);b=MX3(b,C0[r+2],C0[r+3]);a=MX3(a,C1[r],C1[r+1]);b=MX3(b,C1[r+2],C1[r+3]);} \
      float rm=__builtin_fmaxf(a,b); { auto rr=__builtin_amdgcn_permlane32_swap(__float_as_uint(rm),__float_as_uint(rm),false,false); rm=__builtin_fmaxf(__uint_as_float(rr[0]),__uint_as_float(rr[1])); } \
      resc=false; \
      if(__builtin_expect(__any(rm>(float)THRL),0)){ const float dl=__builtin_fmaxf(rm,0.f); mhat+=dl; \
        _Pragma("unroll") for(int r=0;r<16;++r){C0[r]-=dl;C1[r]-=dl;} \
        const float f=__builtin_amdgcn_exp2f(-dl); l_reg*=f; if(hi==0)wsf[r32]=f; resc=true; } } \
    const float nmh_=-mhat; SBAR(); \
    GAPB(o[0]=__builtin_amdgcn_mfma_f32_32x32x16_bf16(PAF(0),VFR(0),o[0],0,0,0), C0,0, INI(GL,P0,0,0,t)); \
    GAPB(o[1]=__builtin_amdgcn_mfma_f32_32x32x16_bf16(PAF(0),VFR(4),o[1],0,0,0), C0,4, INI(GL,P0,1,0,t)); \
    KRD(GL,0); GAPB(o[0]=__builtin_amdgcn_mfma_f32_32x32x16_bf16(PAF(1),VFR(1),o[0],0,0,0), C0,8, INI(GL,P0,2,0,t)); \
    KRD(GL,1); GAPB(o[1]=__builtin_amdgcn_mfma_f32_32x32x16_bf16(PAF(1),VFR(5),o[1],0,0,0), C0,12, INI(GL,P0,3,0,t)); \
    KRD(GL,2); GAPB(o[0]=__builtin_amdgcn_mfma_f32_32x32x16_bf16(PAF(2),VFR(2),o[0],0,0,0), C1,0, INI(GL,P1,0,1,t)); \
    KRD(GL,3); GAPB(o[1]=__builtin_amdgcn_mfma_f32_32x32x16_bf16(PAF(2),VFR(6),o[1],0,0,0), C1,4, INI(GL,P1,1,1,t)); \
    GAPB(o[0]=__builtin_amdgcn_mfma_f32_32x32x16_bf16(PAF(3),VFR(3),o[0],0,0,0), C1,8, INI(GL,P1,2,1,t)); \
    GAPB(o[1]=__builtin_amdgcn_mfma_f32_32x32x16_bf16(PAF(3),VFR(7),o[1],0,0,0), C1,12, INI(GL,P1,3,1,t)); \
    }while(0)
  float qnk;
  { float s2=0.f;
    _Pragma("unroll") for(int d0=0;d0<4;++d0){ _Pragma("unroll") for(int e=0;e<8;++e){ const float v=__uint_as_float(((unsigned)(unsigned short)qr[d0][e])<<16); s2+=v*v; } }
    auto rr=__builtin_amdgcn_permlane32_swap(__float_as_uint(s2),__float_as_uint(s2),false,false); s2=__uint_as_float(rr[0])+__uint_as_float(rr[1]);
    qnk=sqrtf(s2)*kmax; }
  const __attribute__((address_space(3))) float* cb0=(const __attribute__((address_space(3))) float*)((lds_cptr)shm+LDS_CB);
  __attribute__((address_space(3))) unsigned* stopf=(__attribute__((address_space(3))) unsigned*)((__attribute__((address_space(3))) char*)shm+LDS_STOP);
  #define ENDW(tt) do{ if((tt)+3<NT){WAIT_BAR(2);} else if((tt)+2<NT){WAIT_BAR(1);} else {WAIT_BAR(0);} }while(0)
  #define DRAIN(P0,P1,slot) do{ float sacc=P0[0]+P0[1]; _Pragma("unroll") for(int r=2;r<16;++r)sacc+=P0[r]; _Pragma("unroll") for(int r=0;r<16;++r)sacc+=P1[r]; l_reg+=sacc; \
    pw0=(u32x4){PKW(P0,0),PKW(P0,2),PKW(P0,4),PKW(P0,6)};pw1=(u32x4){PKW(P0,8),PKW(P0,10),PKW(P0,12),PKW(P0,14)};pw2=(u32x4){PKW(P1,0),PKW(P1,2),PKW(P1,4),PKW(P1,6)};pw3=(u32x4){PKW(P1,8),PKW(P1,10),PKW(P1,12),PKW(P1,14)}; \
    SBAR(); pv(o,vb0+(slot),PAF(0),PAF(1),PAF(2),PAF(3)); }while(0)
  int t=1; bool stopped=false;
  for(;t+1<NT;t+=2){
    STEP(pB0,pB1,pA0,pA1,t,(t+3<NT),(t+1<NT),(t+1<NT));       ENDW(t);   RESC(); ROT();
    STEP(pA0,pA1,pB0,pB1,t+1,(t+4<NT),(t+2<NT),(t+2<NT));
    { bool ok=(t+2<NT) && ATTN_EXIT; if(ok){ const float cl=cb0[64*PT(t+2)+63]; ok=__all((qnk-cl-mhat)<-160.f); } if(lane==0)stopf[wid]=ok?1u:0u; }
    ENDW(t+1); RESC(); ROT();
    { const u32x4 f0=*(const __attribute__((address_space(3))) u32x4*)stopf, f1=*(const __attribute__((address_space(3))) u32x4*)(stopf+4);
      if((f0.x&f0.y&f0.z&f0.w&f1.x&f1.y&f1.z&f1.w)!=0u){ stopped=true; break; } }
  }
  if(!stopped){ STEP(pB0,pB1,pA0,pA1,NT-1,false,false,false); RESC(); DRAIN(pB0,pB1,sl_cur); }
  else { asm volatile("s_waitcnt vmcnt(0)":::"memory"); DRAIN(pA0,pA1,sl_prev); }
  #undef DRAIN
  #undef PKW
  #undef PAF
  #undef VFR
  #undef PIN
  #undef MX3
  #undef GAPA
  #undef GAPB
  #undef INI
  #undef EX
  #undef VRD
  #undef KRD
  #undef STEP
  #undef ENDW
  {auto rr=__builtin_amdgcn_permlane32_swap(__float_as_uint(l_reg),__float_as_uint(l_reg),false,false);l_reg=__uint_as_float(rr[0])+__uint_as_float(rr[1]);}
  if(hi==0)wsf[32+r32]=l_reg;asm volatile("s_waitcnt lgkmcnt(0)":::"memory");
  float rli[16];
  #pragma unroll
  for(int r=0;r<16;++r)rli[r]=__builtin_amdgcn_rcpf(wsf[32+crow(r,hi)]);
  bf16*Ow=O+(rowbase+q0+wid*QBLK)*ODM+OCOL+h*D;
  { bf16*stg=(bf16*)(shm+LDS_OST)+wid*2048;
    #pragma unroll
    for(int r=0;r<16;++r){const int orow=crow(r,hi);
      #pragma unroll
      for(int d0=0;d0<2;++d0)stg[orow*64+d0*32+r32]=__float2bfloat16(o[d0][r]*rli[r]);}
    asm volatile("s_waitcnt lgkmcnt(0)":::"memory");
    #pragma unroll
    for(int i=0;i<4;++i){const int row=i*8+(lane>>3),ch=lane&7; const u32x4 v=*(const u32x4*)(stg+row*64+ch*8); ATTN_STORE16(Ow+(long)row*ODM+ch*8,v);} }
  asm volatile("s_waitcnt lgkmcnt(0)\n\ts_barrier":::"memory");
  #undef BIAS
  #undef PT
  #undef DMA_K
  #undef DMA_V
  #undef CMASK
  #undef START
  #undef RESC
  #undef ROT
}
constexpr int ATTN_LDS_BYTES=LDS_BYTES;
#undef SBAR
#undef WAIT_BAR
}
namespace fk {
__device__ __forceinline__ float gelu_tanh_fast(float x) {
    const float z = 0.7978845608028654f * (x + 0.044715f * x * x * x);
    const float e = __builtin_amdgcn_exp2f(2.f * LOG2E * z);
    const float th = 1.f - 2.f * __builtin_amdgcn_rcpf(1.f + e);
    return 0.5f * x * (1.f + th);
}
__device__ __forceinline__ bf16_t bf1(float v) { return (bf16_t)cvt_pk_bf16(v, 0.f); }
__device__ __forceinline__ f32x16 zero16v() { f32x16 z = f32x16{}; asm volatile("" : "+v"(z)); return z; }
__device__ __forceinline__ int crow32f(int r, int hi) { return (r & 3) + 8 * (r >> 2) + 4 * hi; }
__device__ __forceinline__ float logsigm_acc(float z) {
    const float e = __builtin_amdgcn_exp2f(-fabsf(z) * LOG2E); return fminf(z, 0.f) - 0.6931471805599453f * __builtin_amdgcn_logf(1.f + e); }

constexpr int LW_STRIDE = 13312, LW_XRT = 0, LW_XCI = 4480, LW_YRT = 9088, LW_OUT = 0;
static_assert(8 * LW_STRIDE <= RING_BYTES && LW_YRT + 4096 <= LW_STRIDE, "lru wave lds");
__device__ __forceinline__ void lru_wave_task(Frame& F, const Args& a, int j, int task) {
    int lane0_ = F.lane; asm volatile("" : "+v"(lane0_));
    const int lane = lane0_, r31 = lane & 31, hi = lane >> 5;
    LAS unsigned char* L = F.lds + F.wave * LW_STRIDE;
    const int c = task >> 5, bn = task & 31, b = bn >> 3, n = bn & 7;
    const bf16_t* XR = (const bf16_t*)(F.ws + WS_XR); const bf16_t* YR = (const bf16_t*)(F.ws + WS_YR);
    bf16_t* YLG = (bf16_t*)(F.ws + WS_YLG); bf16_t* PGo = (bf16_t*)(F.ws + WS_PG); float* AGG = (float*)(F.ws + WS_ESM + ES_AGG);
    const bf16_t* GAT = (const bf16_t*)(F.ws + WS_SMALL + SM_GAT) + (size_t)(j * 8 + n) * 4096; const bf16_t* GXT = (const bf16_t*)(F.ws + WS_SMALL + SM_GXT) + (size_t)(j * 8 + n) * 4096;
    float cb[2], w0[2], w1[2], w2[2], w3[2], gab[2], gxb[2], sp[2];
#pragma unroll
    for (int nbk = 0; nbk < 2; ++nbk) { const int gch = n * 64 + 32 * nbk + r31; const float* cw = a.in[5] + j * 2048;
        cb[nbk] = a.in[6][j * 512 + gch]; w0[nbk] = cw[gch]; w1[nbk] = cw[512 + gch]; w2[nbk] = cw[1024 + gch]; w3[nbk] = cw[1536 + gch];
        gab[nbk] = a.in[8][j * 512 + gch]; gxb[nbk] = a.in[10][j * 512 + gch];
        const float lam = a.in[11][j * 512 + gch]; sp[nbk] = 0.6931471805599453f * __builtin_amdgcn_logf(1.f + __builtin_amdgcn_exp2f(-lam * LOG2E));
    }
    float Pc[2] = {1.f, 1.f}, yc[2] = {0.f, 0.f};
    for (int hb = 0; hb < 2; ++hb) {
        int row0 = b * SEQ + c * 64 + hb * 32;
        asm volatile("" : "+s"(row0));
#pragma unroll
        for (int i = 0; i < 5; ++i) { const int q = lane + 64 * i; if (q < 280) { const int r = q >> 3, c8 = q & 7; u32x4 v = (u32x4){0u, 0u, 0u, 0u};
                if (c > 0 || hb > 0 || r >= 3) v = *(const GAS u32x4*)(XR + (size_t)(row0 - 3 + r) * 512 + n * 64 + c8 * 8);
                *(LAS u32x4*)(L + LW_XRT + q * 16) = v; } }
#pragma unroll
        for (int i = 0; i < 4; ++i) { const int q = lane + 64 * i, r = q >> 3, c8 = q & 7; *(LAS u32x4*)(L + LW_YRT + q * 16) = *(const GAS u32x4*)(YR + (size_t)(row0 + r) * 512 + n * 64 + c8 * 8); }
        float xc[2][16];
        const LAS bf16_t* xt = (const LAS bf16_t*)(L + LW_XRT); LAS bf16_t* xi = (LAS bf16_t*)(L + LW_XCI);
#pragma unroll
        for (int nbk = 0; nbk < 2; ++nbk) { const int ch = 32 * nbk + r31;
#pragma unroll
            for (int g4 = 0; g4 < 4; ++g4) { const int t0 = 8 * g4 + 4 * hi; float xv[7];
#pragma unroll
                for (int q = 0; q < 7; ++q) xv[q] = bf2f(xt[(t0 + q) * 64 + ch]);
#pragma unroll
                for (int q = 0; q < 4; ++q) { const float v = cb[nbk] + w0[nbk] * xv[q] + w1[nbk] * xv[q + 1] + w2[nbk] * xv[q + 2] + w3[nbk] * xv[q + 3]; xc[nbk][4 * g4 + q] = v; xi[(t0 + q) * 72 + ch] = bf1(v); } } }
        f32x16 ra[2], rx[2];
#pragma unroll
        for (int nbk = 0; nbk < 2; ++nbk) { ra[nbk] = zero16v(); rx[nbk] = zero16v(); }
        { bf16x8 ba[2][4], bx[2][4];
#pragma unroll
          for (int nbk = 0; nbk < 2; ++nbk)
#pragma unroll
              for (int s = 0; s < 4; ++s) { const size_t bo = (size_t)(32 * nbk + r31) * 64 + 16 * s + 8 * hi; ba[nbk][s] = *(const GAS bf16x8*)(GAT + bo); bx[nbk][s] = *(const GAS bf16x8*)(GXT + bo); }
#pragma unroll
          for (int s = 0; s < 4; ++s) { const bf16x8 af = *(const LAS bf16x8*)(L + LW_XCI + (r31 * 72 + 16 * s + 8 * hi) * 2);
#pragma unroll
              for (int nbk = 0; nbk < 2; ++nbk) { ra[nbk] = __builtin_amdgcn_mfma_f32_32x32x16_bf16(af, ba[nbk][s], ra[nbk], 0, 0, 0); rx[nbk] = __builtin_amdgcn_mfma_f32_32x32x16_bf16(af, bx[nbk][s], rx[nbk], 0, 0, 0); } } }
#pragma unroll
        for (int nbk = 0; nbk < 2; ++nbk)
#pragma unroll
            for (int r = 0; r < 16; ++r) { const float rg = fast_sigm(ra[nbk][r] + gab[nbk]), ig = fast_sigm(rx[nbk][r] + gxb[nbk]);
                const float la = -8.0f * rg * sp[nbk]; const float av = fast_exp(la);
                const float x2 = 2.f * la; const float om = x2 > -0.02f ? -x2 * (1.f + x2 * (0.5f + x2 * (1.f / 6.f))) : 1.f - av * av;
                ra[nbk][r] = av; rx[nbk][r] = __builtin_amdgcn_sqrtf(om) * (ig * xc[nbk][r]); }
#pragma unroll
        for (int nbk = 0; nbk < 2; ++nbk) {
#pragma unroll
            for (int g4 = 0; g4 < 4; ++g4) {
#pragma unroll
                for (int q = 1; q < 4; ++q) { const int r = 4 * g4 + q; rx[nbk][r] = ra[nbk][r] * rx[nbk][r - 1] + rx[nbk][r]; ra[nbk][r] = ra[nbk][r] * ra[nbk][r - 1]; }
                const float P4 = ra[nbk][4 * g4 + 3], y4 = rx[nbk][4 * g4 + 3];
                float Pin = Pc[nbk], yin = yc[nbk];
                { const float yo = P4 * yin + y4, Po = P4 * Pin;
                  const auto sy = __builtin_amdgcn_permlane32_swap(__float_as_uint(yo), __float_as_uint(yo), false, false); const auto sP = __builtin_amdgcn_permlane32_swap(__float_as_uint(Po), __float_as_uint(Po), false, false);
                  const float y_lo = __uint_as_float(sy[0]), P_lo = __uint_as_float(sP[0]);
                  if (hi) { Pin = P_lo; yin = y_lo; }
                  const float y1 = P4 * yin + y4, P1 = P4 * Pin;
                  const auto ty = __builtin_amdgcn_permlane32_swap(__float_as_uint(y1), __float_as_uint(y1), false, false); const auto tP = __builtin_amdgcn_permlane32_swap(__float_as_uint(P1), __float_as_uint(P1), false, false);
                  yc[nbk] = __uint_as_float(ty[1]); Pc[nbk] = __uint_as_float(tP[1]); }
#pragma unroll
                for (int q = 0; q < 4; ++q) { const int r = 4 * g4 + q; rx[nbk][r] = ra[nbk][r] * yin + rx[nbk][r]; ra[nbk][r] = ra[nbk][r] * Pin; }
            }
        }
        { const LAS bf16_t* yt = (const LAS bf16_t*)(L + LW_YRT); LAS bf16_t* o0 = (LAS bf16_t*)(L + LW_OUT); LAS bf16_t* o1 = (LAS bf16_t*)(L + LW_OUT + 4096);
#pragma unroll
          for (int nbk = 0; nbk < 2; ++nbk) { const int ch = 32 * nbk + r31;
#pragma unroll
              for (int r = 0; r < 16; ++r) { const int t = crow32f(r, hi); const float g = gelu_tanh_fast(bf2f(yt[t * 64 + ch]));
                  o0[t * 64 + ch] = bf1(rx[nbk][r] * g); o1[t * 64 + ch] = bf1(ra[nbk][r] * g); } }
#pragma unroll
          for (int i = 0; i < 4; ++i) { const int q = lane + 64 * i, r = q >> 3, c8 = q & 7; const size_t go = (size_t)(row0 + r) * 512 + n * 64 + c8 * 8;
              *(GAS u32x4*)(YLG + go) = *(const LAS u32x4*)(L + LW_OUT + q * 16); *(GAS u32x4*)(PGo + go) = *(const LAS u32x4*)(L + LW_OUT + 4096 + q * 16); }
          asm volatile("s_waitcnt lgkmcnt(0)" ::: "memory"); }
    }
    if (hi == 0) {
#pragma unroll
        for (int nbk = 0; nbk < 2; ++nbk) { float* ag = AGG + ((size_t)(b * 64 + c) * 512 + n * 64 + 32 * nbk + r31) * 2; *(GAS f32x2*)ag = (f32x2){Pc[nbk], yc[nbk]}; } }
}

__device__ __forceinline__ void fox_cumsum(Frame& F, const Args& a, int j, int item) {
    const int bh = item >> 3, seg = item & 7, b = bh >> 3, h = bh & 7; const float fb = a.in[12][j * 8 + h];
    const float* flog = (const float*)(F.ws + WS_ESM + ES_FLOG); float* CP = (float*)(F.ws + WS_ESM + ES_CP) + (size_t)bh * SEQ;
    const bf16_t* Kb = (const bf16_t*)(F.ws + WS_K);
    LAS float* wt = (LAS float*)(F.lds);
    const int t = seg * 512 + F.tid;
    const float run = logsigm_acc(flog[(size_t)(b * SEQ + t) * 8 + h] + fb);
    float kmx = 0.f;
    { const GAS u32x4* kr = (const GAS u32x4*)(Kb + (size_t)(b * SEQ + t) * 512 + h * 64);
#pragma unroll
      for (int q = 0; q < 8; ++q) { const u32x4 w = kr[q]; kmx += bflo(w.x) * bflo(w.x) + bfhi(w.x) * bfhi(w.x) + bflo(w.y) * bflo(w.y) + bfhi(w.y) * bfhi(w.y) + bflo(w.z) * bflo(w.z) + bfhi(w.z) * bfhi(w.z) + bflo(w.w) * bflo(w.w) + bfhi(w.w) * bfhi(w.w); } }
    float inc = run;
#pragma unroll
    for (int o = 1; o < 64; o <<= 1) { const float u = __shfl_up(inc, o); if (F.lane >= o) inc += u; }
#pragma unroll
    for (int o = 32; o; o >>= 1) kmx = fmaxf(kmx, __shfl_xor(kmx, o));
    if (F.lane == 63) { wt[F.wave] = inc; wt[8 + F.wave] = kmx; }
    __syncthreads();
    float base = 0.f;
    for (int w = 0; w < F.wave; ++w) base += wt[w];
    CP[t] = (base + inc) * LOG2E;
    if (F.tid == 0) { float m = 0.f, tot = 0.f; for (int w = 0; w < 8; ++w) { m = fmaxf(m, wt[8 + w]); tot += wt[w]; }
        ((float*)(F.ws + WS_SMALL + SM_KMAX))[bh * 8 + seg] = m; ((float*)(F.ws + WS_SMALL + SM_KMAX))[256 + bh * 8 + seg] = tot * LOG2E; }
    __syncthreads();
}

__device__ __forceinline__ void lru_fixup(Frame& F, int b, int c) {
    const float* AGG = (const float*)(F.ws + WS_ESM + ES_AGG);
    const bf16_t* YLG = (const bf16_t*)(F.ws + WS_YLG); const bf16_t* PGi = (const bf16_t*)(F.ws + WS_PG); bf16_t* Y = (bf16_t*)(F.ws + WS_Y);
    LAS float* HIN = (LAS float*)(F.lds);
    { const int ch = F.tid; float hh = 0.f;
      for (int cc = 0; cc < c; ++cc) { const f32x2 g = *(const GAS f32x2*)(AGG + ((size_t)(b * 64 + cc) * 512 + ch) * 2); hh = g.x * hh + g.y; }
      HIN[ch] = hh; }
    __syncthreads();
    const int rbase = b * SEQ + c * 64;
#pragma unroll 2
    for (int i = 0; i < 8; ++i) { const int q = F.tid + NTHR * i, r = q >> 6, c8 = q & 63; const size_t off = (size_t)(rbase + r) * 512 + c8 * 8;
        const u32x4 yl = *(const GAS u32x4*)(YLG + off), pg = *(const GAS u32x4*)(PGi + off);
        const f32x4 h0 = *(const LAS f32x4*)(HIN + c8 * 8), h1 = *(const LAS f32x4*)(HIN + c8 * 8 + 4);
        u32x4 o;
        o.x = cvt_pk_bf16(bflo(yl.x) + bflo(pg.x) * h0.x, bfhi(yl.x) + bfhi(pg.x) * h0.y);
        o.y = cvt_pk_bf16(bflo(yl.y) + bflo(pg.y) * h0.z, bfhi(yl.y) + bfhi(pg.y) * h0.w);
        o.z = cvt_pk_bf16(bflo(yl.z) + bflo(pg.z) * h1.x, bfhi(yl.z) + bfhi(pg.z) * h1.y);
        o.w = cvt_pk_bf16(bflo(yl.w) + bflo(pg.w) * h1.z, bfhi(yl.w) + bfhi(pg.w) * h1.w);
        *(GAS u32x4*)(Y + (size_t)(rbase + r) * 1024 + c8 * 8) = o; }
    __syncthreads();
}
}
namespace fk {
__device__ __forceinline__ float fast_logsigm(float z) {
    const float az = fabsf(z); const float e = __builtin_amdgcn_exp2f(-az * LOG2E);
    return fminf(z, 0.f) - 0.6931471805599453f * __builtin_amdgcn_logf(1.f + e);
}
__device__ __forceinline__ s16x4 tr16(const LAS void* p) { typedef short v4i16_t __attribute__((ext_vector_type(4))); return __builtin_bit_cast(s16x4, __builtin_amdgcn_ds_read_tr16_b64_v4i16((LAS v4i16_t*)p)); }
#define MFMA32(a, b, c) __builtin_amdgcn_mfma_f32_32x32x16_bf16(a, b, c, 0, 0, 0)
__device__ __forceinline__ f32x16 zero16() { f32x16 z = f32x16{}; asm volatile("" : "+v"(z)); return z; }
__device__ __forceinline__ int crow32(int r, int hi) { return (r & 3) + 8 * (r >> 2) + 4 * hi; }

__device__ __forceinline__ void skinny_lr(Frame& F, int j, int rb, const pg8::SumSq ss) {
    const bf16_t* hb = (const bf16_t*)(F.ws + WS_HB); const bf16_t* Wt = (const bf16_t*)(F.ws + WS_SMALL + SM_WLR) + (size_t)j * 16 * 1024; float* LR = (float*)(F.ws + WS_LR);
    const int lane = F.lane, w = F.wave, fr = lane & 15, fq = lane >> 4, mb = w & 3, kh = w >> 2;
    const bf16_t* ap = hb + (size_t)(rb * 64 + mb * 16 + fr) * D + kh * 512 + 8 * fq; const bf16_t* bp = Wt + (size_t)fr * D + kh * 512 + 8 * fq;
    f32x4 acc = (f32x4){0.f, 0.f, 0.f, 0.f};
#pragma unroll 8
    for (int s = 0; s < 16; ++s) { const bf16x8 av = *(const GAS bf16x8*)(ap + 32 * s), bv = *(const GAS bf16x8*)(bp + 32 * s); acc = __builtin_amdgcn_mfma_f32_16x16x32_bf16(av, bv, acc, 0, 0, 0); }
    LAS float* red = (LAS float*)(F.lds);
#pragma unroll
    for (int r = 0; r < 4; ++r) red[w * 256 + (4 * fq + r) * 16 + fr] = acc[r];
    __syncthreads();
#pragma unroll
    for (int i = 0; i < 2; ++i) { const int o = F.tid + NTHR * i, row = o >> 4, col = o & 15, m = row >> 4, rr = row & 15;
        const float v = red[m * 256 + rr * 16 + col] + red[(4 + m) * 256 + rr * 16 + col]; const int grow = rb * 64 + row;
        LR[(size_t)grow * 16 + col] = v * pg8::inv_rms(ss, grow); }
    __syncthreads();
}

constexpr int GA_KST = 0;
constexpr int GA_VT = 18432;
constexpr int GA_LR = GA_VT + 36864;
constexpr int GA_QT = GA_LR + 4096;
constexpr int GA_QS = GA_QT + 2048;
constexpr int GA_KS = GA_QS + 17408;
constexpr int GA_OUT = GA_VT;
static_assert(GA_KS + 17408 <= RING_BYTES && GA_OUT + 69632 <= GA_KS + 17408, "gla prep lds");
struct GlaPrepRegs { u32x4 v[4], q[2], k[2]; f32x4 lr; float gw[16]; float gb; int gh; };
__device__ __forceinline__ void gla_prep_load(Frame& F, int item, GlaPrepRegs& R) {
    const int tid = F.tid; const int bh = item >> 6, n = item & 63, b = bh >> 2, h = bh & 3; const int r0 = b * SEQ + n * 64;
    const bf16_t* GQ = (const bf16_t*)(F.ws + WS_GQ); const bf16_t* GK = (const bf16_t*)(F.ws + WS_GK); const bf16_t* GV = (const bf16_t*)(F.ws + WS_GV); const float* LR = (const float*)(F.ws + WS_LR);
#pragma unroll
    for (int i = 0; i < 4; ++i) { const int q = tid + NTHR * i, t = q >> 5, c8 = q & 31; R.v[i] = *(const GAS u32x4*)(GV + (size_t)(r0 + t) * 1024 + h * 256 + c8 * 8); }
#pragma unroll
    for (int i = 0; i < 2; ++i) { const int q = tid + NTHR * i, t = q >> 4, c8 = q & 15; const size_t go = (size_t)(r0 + t) * 512 + h * 128 + c8 * 8; R.q[i] = *(const GAS u32x4*)(GQ + go); R.k[i] = *(const GAS u32x4*)(GK + go); }
    R.lr = *(const GAS f32x4*)(LR + (size_t)r0 * 16 + (tid & 255) * 4);
}
__device__ __forceinline__ void gla_prep(Frame& F, const Args& a, int j, int item, int next_item, GlaPrepRegs& R) {
    const int tid = F.tid, lane = F.lane, w = F.wave; LAS unsigned char* L = F.lds;
    const int bh = item >> 6, n = item & 63, b = bh >> 2, h = bh & 3; const int r0 = b * SEQ + n * 64;
    bf16_t* GQ = (bf16_t*)(F.ws + WS_GQ); bf16_t* GK = (bf16_t*)(F.ws + WS_GK);
    float* DEC = (float*)(F.ws + WS_DEC); bf16_t* KVT = (bf16_t*)(F.ws + WS_KVT) + (size_t)item * 32768;
    if (R.gh != h) { const int gd_ = h * 128 + (tid & 127);
#pragma unroll
        for (int r = 0; r < 16; ++r) R.gw[r] = a.in[18][(size_t)j * 8192 + r * 512 + gd_];
        R.gb = a.in[19][j * 512 + gd_]; R.gh = h; }
#pragma unroll
    for (int i = 0; i < 4; ++i) { const int q = tid + NTHR * i, t = q >> 5, c8 = q & 31; *(LAS u32x4*)(L + GA_VT + t * 576 + c8 * 16) = R.v[i]; }
#pragma unroll
    for (int i = 0; i < 2; ++i) { const int q = tid + NTHR * i, t = q >> 4, c8 = q & 15; *(LAS u32x4*)(L + GA_QS + t * 272 + c8 * 16) = R.q[i]; *(LAS u32x4*)(L + GA_KS + t * 272 + c8 * 16) = R.k[i]; }
    if (tid < 256) *(LAS f32x4*)(L + GA_LR + tid * 16) = R.lr;
    __syncthreads();
    if (next_item >= 0) gla_prep_load(F, next_item, R);
    const int d = tid & 127, tq = tid >> 7, gd = h * 128 + d;
    float gw[16];
#pragma unroll
    for (int r = 0; r < 16; ++r) gw[r] = R.gw[r];
    const float gb = R.gb; (void)gd;
    float bl[16]; float run = 0.f;
#pragma unroll
    for (int i = 0; i < 16; ++i) { const int t = 16 * tq + i; const LAS f32x4* lp = (const LAS f32x4*)(L + GA_LR + t * 64); float z = gb;
#pragma unroll
        for (int r4 = 0; r4 < 4; ++r4) { const f32x4 x = lp[r4]; z = fmaf(x.x, gw[4 * r4], z); z = fmaf(x.y, gw[4 * r4 + 1], z); z = fmaf(x.z, gw[4 * r4 + 2], z); z = fmaf(x.w, gw[4 * r4 + 3], z); }
        run += fast_logsigm(z) * (1.f / 16.f); bl[i] = run; }
    LAS float* QT = (LAS float*)(L + GA_QT);
    QT[tq * 128 + d] = run;
    __syncthreads();
    float offs = 0.f, blast = 0.f;
#pragma unroll
    for (int q = 0; q < 4; ++q) { const float v = QT[q * 128 + d]; blast += v; if (q < tq) offs += v; }
    if (tq == 0) DEC[(size_t)item * 128 + d] = fast_exp(blast);
    { LAS bf16_t* qs = (LAS bf16_t*)(L + GA_QS); LAS bf16_t* ks_ = (LAS bf16_t*)(L + GA_KS);
      unsigned ks[8];
#pragma unroll
      for (int i = 0; i < 16; i += 2) {
          float kst[2];
#pragma unroll
          for (int u = 0; u < 2; ++u) { const int t = 16 * tq + i + u; const float bb = bl[i + u] + offs;
              const float qv = bf2f(qs[t * 136 + d]), kv = bf2f(ks_[t * 136 + d]); const float eb = fast_exp(bb);
              qs[t * 136 + d] = (bf16_t)f2bf(qv * GLA_QS * eb); ks_[t * 136 + d] = (bf16_t)f2bf(kv * __builtin_amdgcn_rcpf(eb)); kst[u] = kv * fast_exp(blast - bb); }
          ks[i >> 1] = cvt_pk_bf16(kst[0], kst[1]); }
      *(LAS u32x4*)(L + GA_KST + d * 144 + tq * 32) = (u32x4){ks[0], ks[1], ks[2], ks[3]};
      *(LAS u32x4*)(L + GA_KST + d * 144 + tq * 32 + 16) = (u32x4){ks[4], ks[5], ks[6], ks[7]}; }
    __syncthreads();
#pragma unroll
    for (int i = 0; i < 2; ++i) { const int q = tid + NTHR * i, t = q >> 4, c8 = q & 15; const size_t go = (size_t)(r0 + t) * 512 + h * 128 + c8 * 8;
        *(GAS u32x4*)(GQ + go) = *(const LAS u32x4*)(L + GA_QS + t * 272 + c8 * 16); *(GAS u32x4*)(GK + go) = *(const LAS u32x4*)(L + GA_KS + t * 272 + c8 * 16); }
    const int r = lane & 31, hh = lane >> 5, g = lane >> 4, i16 = lane & 15;
    f32x16 acc[4];
#pragma unroll
    for (int nb = 0; nb < 4; ++nb) acc[nb] = zero16();
#pragma unroll
    for (int s = 0; s < 4; ++s) {
        const LAS unsigned char* vp = L + GA_VT + (16 * s + 8 * (g >> 1) + (i16 >> 2)) * 576 + (32 * w + 16 * (g & 1) + 4 * (i16 & 3)) * 2;
        const s16x4 lo = tr16(vp), hi4 = tr16(vp + 4 * 576);
        const bf16x8 af = (bf16x8){lo[0], lo[1], lo[2], lo[3], hi4[0], hi4[1], hi4[2], hi4[3]};
#pragma unroll
        for (int nb = 0; nb < 4; ++nb) { const bf16x8 bf = *(const LAS bf16x8*)(L + GA_KST + (32 * nb + r) * 144 + (16 * s + 8 * hh) * 2); acc[nb] = MFMA32(bf, af, acc[nb]); }
    }
    __syncthreads();
    asm volatile("s_nop 15\n\ts_nop 7" : "+v"(acc[0]), "+v"(acc[1]), "+v"(acc[2]), "+v"(acc[3]));
#pragma unroll
    for (int nb = 0; nb < 4; ++nb)
#pragma unroll
        for (int q = 0; q < 4; ++q) { u32x2 o; o.x = cvt_pk_bf16(acc[nb][4 * q], acc[nb][4 * q + 1]); o.y = cvt_pk_bf16(acc[nb][4 * q + 2], acc[nb][4 * q + 3]);
            *(LAS u32x2*)(L + GA_OUT + (32 * w + r) * 272 + (32 * nb + 8 * q + 4 * hh) * 2) = o; }
    __syncthreads();
#pragma unroll
    for (int i = 0; i < 8; ++i) { const int q = tid + NTHR * i, dv = q >> 4, c8 = q & 15; *(GAS u32x4*)(KVT + (size_t)dv * 128 + c8 * 8) = *(const LAS u32x4*)(L + GA_OUT + dv * 272 + c8 * 16); }
    __syncthreads();
}

__device__ __forceinline__ void gla_state(Frame& F, int gtid) {
    const int bh = gtid >> 13, rem = gtid & 8191; const size_t eo = (size_t)(rem >> 5) * 128 + (rem & 31) * 4; const int dk0 = (rem & 31) * 4;
    const bf16_t* KVT = (const bf16_t*)(F.ws + WS_KVT) + (size_t)bh * 64 * 32768 + eo; bf16_t* SNT = (bf16_t*)(F.ws + WS_SNT) + (size_t)bh * 64 * 32768 + eo;
    const float* DEC = (const float*)(F.ws + WS_DEC) + (size_t)bh * 64 * 128 + dk0;
    f32x4 s = (f32x4){0.f, 0.f, 0.f, 0.f};
    for (int n0 = 0; n0 < 64; n0 += 8) {
        u32x2 kv[8]; f32x4 dc[8];
#pragma unroll
        for (int u = 0; u < 8; ++u) { kv[u] = *(const GAS u32x2*)(KVT + (size_t)(n0 + u) * 32768); dc[u] = *(const GAS f32x4*)(DEC + (size_t)(n0 + u) * 128); }
#pragma unroll
        for (int u = 0; u < 8; ++u) { u32x2 o; o.x = cvt_pk_bf16(s.x, s.y); o.y = cvt_pk_bf16(s.z, s.w); *(GAS u32x2*)(SNT + (size_t)(n0 + u) * 32768) = o;
            s.x = dc[u].x * s.x + bflo(kv[u].x); s.y = dc[u].y * s.y + bfhi(kv[u].x); s.z = dc[u].z * s.z + bflo(kv[u].y); s.w = dc[u].w * s.w + bfhi(kv[u].y); }
    }
}

constexpr int GC_QD = 0;
constexpr int GC_KI = 17408;
constexpr int GC_VT = 34816;
constexpr int GC_XT = GC_VT + 36864;
constexpr int GC_GT = GC_XT + 9216;
constexpr int GC_SQ = GC_GT + 33792;
constexpr int GC_HN = GC_SQ + 2048;
static_assert(GC_HN + 1024 <= RING_BYTES, "gla lds");
struct GlaOutRegs { u32x4 qd[2], ki[2], vt[4], gt[4]; bf16x8 sn[8]; };
__device__ __forceinline__ void gla_out_load(Frame& F, int item, GlaOutRegs& R) {
    const int tid = F.tid, lane = F.lane, w = F.wave; const int bh = item >> 6, n = item & 63, b = bh >> 2, h = bh & 3; const int r0 = b * SEQ + n * 64;
    const bf16_t* GQ = (const bf16_t*)(F.ws + WS_GQ); const bf16_t* GK = (const bf16_t*)(F.ws + WS_GK); const bf16_t* GV = (const bf16_t*)(F.ws + WS_GV); const bf16_t* GG = (const bf16_t*)(F.ws + WS_GG);
    const bf16_t* SNT = (const bf16_t*)(F.ws + WS_SNT) + (size_t)item * 32768;
#pragma unroll
    for (int i = 0; i < 2; ++i) { const int q = tid + NTHR * i, t = q >> 4, c8 = q & 15; const size_t go = (size_t)(r0 + t) * 512 + h * 128 + c8 * 8; R.qd[i] = *(const GAS u32x4*)(GQ + go); R.ki[i] = *(const GAS u32x4*)(GK + go); }
#pragma unroll
    for (int i = 0; i < 4; ++i) { const int q = tid + NTHR * i, t = q >> 5, c8 = q & 31; const size_t go = (size_t)(r0 + t) * 1024 + h * 256 + c8 * 8; R.vt[i] = *(const GAS u32x4*)(GV + go); R.gt[i] = *(const GAS u32x4*)(GG + go); }
    const int r = lane & 31, hh = lane >> 5;
#pragma unroll
    for (int s = 0; s < 8; ++s) R.sn[s] = *(const GAS bf16x8*)(SNT + (size_t)(32 * w + r) * 128 + 16 * s + 8 * hh);
}
__device__ __forceinline__ void gla_out(Frame& F, const Args& a, int j, int item, int next_item, GlaOutRegs& R) {
    const int tid = F.tid, lane = F.lane, w = F.wave; LAS unsigned char* L = F.lds;
    const int bh = item >> 6, n = item & 63, b = bh >> 2, h = bh & 3; const int r0 = b * SEQ + n * 64;
    bf16_t* OG = (bf16_t*)(F.ws + WS_OG);
#pragma unroll
    for (int i = 0; i < 2; ++i) { const int q = tid + NTHR * i, t = q >> 4, c8 = q & 15; *(LAS u32x4*)(L + GC_QD + t * 272 + c8 * 16) = R.qd[i]; *(LAS u32x4*)(L + GC_KI + t * 272 + c8 * 16) = R.ki[i]; }
#pragma unroll
    for (int i = 0; i < 4; ++i) { const int q = tid + NTHR * i, t = q >> 5, c8 = q & 31; *(LAS u32x4*)(L + GC_VT + t * 576 + c8 * 16) = R.vt[i]; *(LAS u32x4*)(L + GC_GT + t * 528 + c8 * 16) = R.gt[i]; }
    __syncthreads();
    const int r = lane & 31, hh = lane >> 5, g = lane >> 4, i16 = lane & 15;
    if (w < 4) {
        const int jb = w >> 1, ib = w & 1;
        f32x16 x = zero16();
        if (!(jb == 1 && ib == 0)) {
#pragma unroll
            for (int s = 0; s < 8; ++s) { const bf16x8 af = *(const LAS bf16x8*)(L + GC_KI + (32 * jb + r) * 272 + (16 * s + 8 * hh) * 2), bf = *(const LAS bf16x8*)(L + GC_QD + (32 * ib + r) * 272 + (16 * s + 8 * hh) * 2);
                x = MFMA32(af, bf, x); }
        }
        const int i = 32 * ib + r;
#pragma unroll
        for (int q4 = 0; q4 < 4; ++q4) { float v[4];
#pragma unroll
            for (int q = 0; q < 4; ++q) { const int jj = 32 * jb + 8 * q4 + 4 * hh + q; v[q] = (jj <= i) ? x[4 * q4 + q] : 0.f; }
            u32x2 o; o.x = cvt_pk_bf16(v[0], v[1]); o.y = cvt_pk_bf16(v[2], v[3]);
            *(LAS u32x2*)(L + GC_XT + i * 144 + (32 * jb + 8 * q4 + 4 * hh) * 2) = o; }
    }
    f32x16 acc[2]; acc[0] = zero16(); acc[1] = zero16();
#pragma unroll
    for (int s = 0; s < 8; ++s) {
#pragma unroll
        for (int ib = 0; ib < 2; ++ib) { const bf16x8 bf = *(const LAS bf16x8*)(L + GC_QD + (32 * ib + r) * 272 + (16 * s + 8 * hh) * 2); acc[ib] = MFMA32(R.sn[s], bf, acc[ib]); } }
    if (next_item >= 0) gla_out_load(F, next_item, R);
    __syncthreads();
#pragma unroll
    for (int s = 0; s < 4; ++s) {
        const LAS unsigned char* vp = L + GC_VT + (16 * s + 8 * (g >> 1) + (i16 >> 2)) * 576 + (32 * w + 16 * (g & 1) + 4 * (i16 & 3)) * 2;
        const s16x4 lo = tr16(vp), hi4 = tr16(vp + 4 * 576);
        const bf16x8 af = (bf16x8){lo[0], lo[1], lo[2], lo[3], hi4[0], hi4[1], hi4[2], hi4[3]};
#pragma unroll
        for (int ib = 0; ib < 2; ++ib) { const bf16x8 bf = *(const LAS bf16x8*)(L + GC_XT + (32 * ib + r) * 144 + (16 * s + 8 * hh) * 2); acc[ib] = MFMA32(af, bf, acc[ib]); } }
    LAS float* SQ = (LAS float*)(L + GC_SQ);
#pragma unroll
    for (int ib = 0; ib < 2; ++ib) { float s2 = 0.f;
#pragma unroll
        for (int rr = 0; rr < 16; ++rr) s2 += acc[ib][rr] * acc[ib][rr];
        s2 += __shfl_xor(s2, 32);
        if (hh == 0) SQ[w * 64 + 32 * ib + r] = s2; }
    __syncthreads();
    const LAS float* hn = (const LAS float*)(L + GC_HN);
#pragma unroll
    for (int ib = 0; ib < 2; ++ib) { const int i = 32 * ib + r; float tot = 0.f;
#pragma unroll
        for (int ww = 0; ww < 8; ++ww) tot += SQ[ww * 64 + i];
        const float inv = 1.0f / sqrtf(tot * (1.f / 256.f) + EPS);
#pragma unroll
        for (int q4 = 0; q4 < 4; ++q4) { const int dv = 32 * w + 8 * q4 + 4 * hh; LAS u32x2* gp = (LAS u32x2*)(L + GC_GT + i * 528 + dv * 2);
            const u32x2 gv = *gp; const f32x4 hw = *(const LAS f32x4*)(hn + dv);
            const float o0 = acc[ib][4 * q4 + 0] * inv * hw.x * fast_silu(bflo(gv.x)), o1 = acc[ib][4 * q4 + 1] * inv * hw.y * fast_silu(bfhi(gv.x));
            const float o2 = acc[ib][4 * q4 + 2] * inv * hw.z * fast_silu(bflo(gv.y)), o3 = acc[ib][4 * q4 + 3] * inv * hw.w * fast_silu(bfhi(gv.y));
            u32x2 o; o.x = cvt_pk_bf16(o0, o1); o.y = cvt_pk_bf16(o2, o3); *gp = o; } }
    __syncthreads();
    for (int q = tid; q < 2048; q += NTHR) { const int t = q >> 5, c8 = q & 31; *(GAS u32x4*)(OG + (size_t)(r0 + t) * 1024 + h * 256 + c8 * 8) = *(const LAS u32x4*)(L + GC_GT + t * 528 + c8 * 16); }
    __syncthreads();
}
}
namespace fk {
constexpr int RP_TAB = 0;
#ifndef RP_NR
#define RP_NR 4
#endif
constexpr int RP_SEL = 32768;
__device__ __forceinline__ void router_rows(Frame& F, const Args& a, int j, int rb, const f32x4 (&gk)[4]) {
    const int lane = F.lane, w = F.wave; LAS unsigned char* L = F.lds;
    const float* H = (const float*)(F.ws + WS_H); unsigned char* XN = (unsigned char*)(F.ws + WS_XN);
    LAS int* SEL = (LAS int*)(L + RP_SEL); LAS float* SELW = (LAS float*)(L + RP_SEL + 512);
    for (int r0 = 0; r0 < 8; r0 += RP_NR) {
        RowV rv[RP_NR];
#pragma unroll
        for (int u = 0; u < RP_NR; ++u) { if (BF16_RESID) row_load_bf16(rv[u], (const bf16_t*)(F.ws + WS_HB) + (size_t)(rb * 64 + w * 8 + r0 + u) * D, lane); else row_load(rv[u], H + (size_t)(rb * 64 + w * 8 + r0 + u) * D, lane); }
        float lga[RP_NR][8]; row_dots_n<8, RP_NR>(rv, (const LAS float*)(L + RP_TAB), lane, lga);
#pragma unroll
        for (int u = 0; u < RP_NR; ++u) { const int lrow = w * 8 + r0 + u, m = rb * 64 + lrow; RowV r = rv[u];
            const float ss = row_sumsq(r); const float inv = 1.0f / sqrtf(ss * (1.f / D) + EPS);
            float lg[8];
#pragma unroll
            for (int e = 0; e < 8; ++e) lg[e] = lga[u][e];
#pragma unroll
            for (int e = 0; e < 8; ++e) lg[e] *= inv;
            int i1 = 0; float v1 = lg[0];
#pragma unroll
            for (int e = 1; e < 8; ++e) if (lg[e] > v1) { v1 = lg[e]; i1 = e; }
            int i2 = -1; float v2 = -INFINITY;
#pragma unroll
            for (int e = 0; e < 8; ++e) if (e != i1 && (i2 < 0 || lg[e] > v2)) { v2 = lg[e]; i2 = e; }
            const float w1 = 1.f / (1.f + expf(v2 - v1)), w2 = 1.f - w1;
            if (lane == 0) { SEL[lrow * 2] = i1; SEL[lrow * 2 + 1] = i2; SELW[lrow * 2] = w1; SELW[lrow * 2 + 1] = w2; }
#pragma unroll
            for (int jj = 0; jj < 4; ++jj) r.v[jj] = r.v[jj] * gk[jj] * inv;
            row_store_fp8(r, XN + (size_t)m * D, lane); }
    }
    __syncthreads();
    if (w == 0) {
        unsigned* cnt = (unsigned*)(F.ctl + CW_CNT + 64 * j);
        int* TS = (int*)(F.ws + WS_RT + RT_TS); float* TW = (float*)(F.ws + WS_RT + RT_TW); int* TL = (int*)(F.ws + WS_RT + RT_TL);
        const int e0 = SEL[lane * 2], e1 = SEL[lane * 2 + 1]; const int m = rb * 64 + lane;
        int p0 = 0, p1 = 0; unsigned tot = 0;
        unsigned long long mk0[8], mk1[8];
#pragma unroll
        for (int e = 0; e < 8; ++e) { mk0[e] = __ballot(e0 == e); mk1[e] = __ballot(e1 == e); const unsigned c = (unsigned)(__popcll(mk0[e]) + __popcll(mk1[e])); tot = (lane == e) ? c : tot; }
        unsigned base = 0;
        if (lane < 8 && tot > 0) base = __hip_atomic_fetch_add(cnt + lane, tot, RLX_AGENT);
        const unsigned long long lt = (1ull << lane) - 1ull;
#pragma unroll
        for (int e = 0; e < 8; ++e) { const int be = (int)__shfl(base, e);
            if (e0 == e) p0 = be + __popcll(mk0[e] & lt);
            if (e1 == e) p1 = be + __popcll(mk0[e]) + __popcll(mk1[e] & lt); }
        TL[e0 * T + p0] = m; TL[e1 * T + p1] = m;
        TS[m * 2] = e0 * T + p0; TS[m * 2 + 1] = e1 * T + p1;
        TW[m * 2] = SELW[lane * 2]; TW[m * 2 + 1] = SELW[lane * 2 + 1];
    }
    __syncthreads();
}
constexpr int ROWTAB_OFF = RING_BYTES + 1024;
static_assert(ROWTAB_OFF + 15 * 1024 <= LDS_BYTES, "row table");
constexpr int MT_OFF = MISC_OFF + 256;
__device__ __forceinline__ void moe_tables(Frame& F, int j) {
    LAS int* tab = (LAS int*)(F.lds + MT_OFF);
    if (F.tid == 0) { const unsigned* cnt = (const unsigned*)(F.ctl + CW_CNT + 64 * j); int run = 0;
        for (int e = 0; e < 8; ++e) { const int c = (int)__hip_atomic_load(cnt + e, RLX_AGENT); tab[16 + e] = c; tab[e] = run; run += (c + 255) >> 8; }
        tab[8] = run; }
    __syncthreads();
}
__device__ __forceinline__ void combine_rows(Frame& F, const Args& a, int j, bool last) {
    const LAS int* tab = (const LAS int*)(F.lds + MT_OFF);
    float* H = (float*)(F.ws + WS_H); bf16_t* HB = (bf16_t*)(F.ws + WS_HB); float* ssa = (float*)(F.ws + WS_SMALL + SM_SSA); float* flog = (float*)(F.ws + WS_ESM + ES_FLOG);
    const int* TS = (const int*)(F.ws + WS_RT + RT_TS); const float* TW = (const float*)(F.ws + WS_RT + RT_TW); const bf16_t* YM = (const bf16_t*)(F.ws + WS_YM); const bf16_t* YM1 = (const bf16_t*)(F.ws + WS_YM1);
    const LAS float* Wl = (const LAS float*)(F.lds);
    const int gw = F.vcu * NWAVES + F.wave, NGW = F.G * NWAVES, lane = F.lane;
    f32x4 gf[4];
#pragma unroll
    for (int jj = 0; jj < 4; ++jj) gf[jj] = last ? *(const GAS f32x4*)(a.in[3] + 4 * lane + 256 * jj) : (f32x4){0.f, 0.f, 0.f, 0.f};
    for (int m0 = gw; m0 < T; m0 += 2 * NGW) {
        int sl[2][2]; float wv[2][2]; RowV rr[2]; u32x2 ya[2][2][4], yb[2][2][4];
#pragma unroll
        for (int u = 0; u < 2; ++u) { const int m = m0 + u * NGW; if (m < T) { const int s0 = TS[m * 2], s1 = TS[m * 2 + 1]; wv[u][0] = TW[m * 2]; wv[u][1] = TW[m * 2 + 1];
                sl[u][0] = 256 * tab[s0 >> 14] + (s0 & 16383); sl[u][1] = 256 * tab[s1 >> 14] + (s1 & 16383); } }
#pragma unroll
        for (int u = 0; u < 2; ++u) { const int m = m0 + u * NGW; if (m < T) { if (BF16_RESID) row_load_bf16(rr[u], HB + (size_t)m * D, lane); else row_load(rr[u], H + (size_t)m * D, lane);
#pragma unroll
                for (int k = 0; k < 2; ++k) { const GAS u32x2* y0 = (const GAS u32x2*)(YM + (size_t)sl[u][k] * D) + lane; const GAS u32x2* z0 = (const GAS u32x2*)(YM1 + (size_t)sl[u][k] * D) + lane;
#pragma unroll
                    for (int jj = 0; jj < 4; ++jj) { ya[u][k][jj] = y0[64 * jj]; yb[u][k][jj] = z0[64 * jj]; } } } }
#pragma unroll
        for (int u = 0; u < 2; ++u) { const int m = m0 + u * NGW; if (m < T) { RowV& r = rr[u]; const float w0 = wv[u][0], w1 = wv[u][1];
#pragma unroll
            for (int jj = 0; jj < 4; ++jj) { const u32x2 a0 = ya[u][0][jj], a1 = ya[u][1][jj], b0 = yb[u][0][jj], b1 = yb[u][1][jj];
                r.v[jj].x += w0 * (bflo(a0.x) + bflo(b0.x)) + w1 * (bflo(a1.x) + bflo(b1.x)); r.v[jj].y += w0 * (bfhi(a0.x) + bfhi(b0.x)) + w1 * (bfhi(a1.x) + bfhi(b1.x));
                r.v[jj].z += w0 * (bflo(a0.y) + bflo(b0.y)) + w1 * (bflo(a1.y) + bflo(b1.y)); r.v[jj].w += w0 * (bfhi(a0.y) + bfhi(b0.y)) + w1 * (bfhi(a1.y) + bfhi(b1.y)); } } }
        float dta[2][8];
        if (!last) row_dots_n<8, 2>(rr, Wl, lane, dta);
#pragma unroll
        for (int u = 0; u < 2; ++u) { const int m = m0 + u * NGW; if (m < T) { RowV r = rr[u];
            const float ss = row_sumsq(r); const float inv = 1.0f / sqrtf(ss * (1.f / D) + EPS);
            if (!last) {
                if (!BF16_RESID) row_store_f32(r, H + (size_t)m * D, lane); row_store_bf16(r, HB + (size_t)m * D, lane);
#if E1_I8
                { const float st = row_store_i8max(r, (unsigned char*)(F.ws + WS_HB8E) + (size_t)m * D, lane); if (lane == 0) ((float*)(F.ws + WS_SMALL + SM_STEPE))[m] = st; }
#endif
                if (lane == 0) ssa[m] = ss;
                float dts[8];
#pragma unroll
                for (int c = 0; c < 8; ++c) dts[c] = dta[u][c];
                if (lane < 8) { float v = dts[0];
#pragma unroll
                    for (int c = 1; c < 8; ++c) v = (lane == c) ? dts[c] : v;
                    flog[m * 8 + lane] = v * inv; }
            } else {
#pragma unroll
                for (int jj = 0; jj < 4; ++jj) r.v[jj] = r.v[jj] * gf[jj] * inv;
                row_store_f32(r, a.out + (size_t)m * D, lane);
            } } }
    }
}

#ifndef PHMASK
#define PHMASK 0xffff
#endif
#define PHC(k) (((PHMASK) >> (k)) & 1)
#ifndef PHREP
#define PHREP 0
#endif
#define REPK(k) (((PHREP) >> (k)) & 1)
constexpr int PH_PER_PAIR = 15, N_PHASES = 1 + 2 * PH_PER_PAIR;
#ifndef PROBE_PHASE
#define PROBE_PHASE -1
#endif
#define PROBE_BEGIN(k) do { if (PROBE_PHASE == (k) && blockIdx.x == 0 && threadIdx.x == 0) pr_t0 = __builtin_amdgcn_s_memrealtime(); } while (0)
#define PROBE_END(k) do { if (PROBE_PHASE == (k) && blockIdx.x == 0 && threadIdx.x == 0) pr_acc += __builtin_amdgcn_s_memrealtime() - pr_t0; } while (0)
#define IN(k) (lo <= (k) && (k) < hi)
#ifndef SEAM_FILL
#define SEAM_FILL 0
#endif
#ifndef SEAM_REP
#define SEAM_REP 1
#endif
#define SEAMF(k, jj, base) do { if (IN(k) && IN((k) + 1)) { if (fullfill) seam_fill(F, args, (k), (jj), (base), bar); else xcd_barrier(bar); } } while (0)
#define SEAM(k) do { if (IN(k) && IN((k) + 1)) { for (int sr_ = 0; sr_ < SEAM_REP; ++sr_) xcd_barrier(bar); } } while (0)

#if BF16_RESID && !defined(EPIRES_OLD)
#define EPIRES_T(fb) pg8::EpiResB<(fb)>
#else
#define EPIRES_T(fb) pg8::EpiResT<BF16_RESID != 0>
#endif
__device__ __forceinline__ int o4b_share(int tf) { const int cap = (256 - tf) * NWAVES * 4; return cap < CV_O4B ? cap : CV_O4B; }
template <int J> __device__ __forceinline__ void pair_body(Frame& F, const Args& args, const int lo, const int hi, const XcdBarrier& bar, unsigned char* lds_raw, unsigned long long& pr_acc) {
    unsigned long long pr_t0 = 0;
    constexpr int j = J, pb = 1 + J * PH_PER_PAIR;
    const int cblk = (int)blockIdx.x;
    const bool fullfill = SEAM_FILL && lo == 0 && hi == N_PHASES && F.G == 256;
    float* H = (float*)(F.ws + WS_H); bf16_t* HB = (bf16_t*)(F.ws + WS_HB);
    float* SSA = (float*)(F.ws + WS_SMALL + SM_SSA);
    unsigned long long* SSB = (unsigned long long*)(F.ws + CTL_SS) + (size_t)j * T; unsigned long long* SSC = (unsigned long long*)(F.ws + CTL_SS) + (size_t)(2 + j) * T;
    PROBE_BEGIN(0);
    if (PHC(0) && IN(pb + 0)) { auto body_ = [&]() { Frame Fq_ = F; { int t_ = threadIdx.x; asm volatile("" : "+v"(t_)); Fq_.tid = t_; Fq_.lane = t_ & 63; } Frame& F = Fq_;
#if E1_I8
        pg8::DenseSched S; S.init(F.ws + WS_HB8E, (const unsigned char*)(F.ws + WS_WINE) + (size_t)j * 2560 * D, T, 2560, D, F.G, cblk, 1);
        pg8::EpiProjI8<0> E{pg8::SumSq{SSA, nullptr}, pg8::SumSq{nullptr, nullptr}, (const float*)(F.ws + CTL_WMAXE) + j * 2560, (bf16_t*)(F.ws + WS_XR), 512, C2, (const float*)(F.ws + WS_SMALL + SM_STEPE)};
        pg8::gemm_phase<pg8::EpiProjI8<0>, pg8::DenseSched, true, true, 1, true>(F.lds, D, D, S, E);
#else
        pg8::DenseSched S; S.init(HB, (const bf16_t*)(F.ws + WS_WINE) + (size_t)j * 2560 * D, T, 2560, D, F.G, cblk);
        pg8::EpiProj<0> E{pg8::SumSq{SSA, nullptr}, (bf16_t*)(F.ws + WS_XR), 512, C2, nullptr};
        pg8::gemm_phase<pg8::EpiProj<0>, pg8::DenseSched, true, true>(F.lds, D, D, S, E);
#endif
        { pg8::Unit u_; if (!S.next(2, u_) && F.G == 256) convert_experts_range(F, args, j, (j == 1 ? CV_PRE + CV_O4B : 0), (j == 1 ? CV_PRE + CV_O4B : 0) + CV_T1, (cblk - 128) * NWAVES + F.wave, 128 * NWAVES); }
    }; body_(); if (REPK(0)) body_(); }
    if (j == 0) SEAMF(pb + 0, 0, FILL0_LO + (1 + 0) * SEAM_ITEMS); else SEAMF(pb + 0, 1, FILL1_LO + (1 + 0) * SEAM_ITEMS);
    PROBE_END(0);
    PROBE_BEGIN(1);
    if (PHC(1) && IN(pb + 1)) { auto body_ = [&]() { Frame Fq_ = F; { int t_ = threadIdx.x; asm volatile("" : "+v"(t_)); Fq_.tid = t_; Fq_.lane = t_ & 63; } Frame& F = Fq_;
#if IN_O_I8
        quantize_wino(F, args, j);
#endif
#if FFN_UP_I8
        quantize_w13(F, args, j);
        __syncthreads();
#endif
#if IN_O_I8 && !FFN_UP_I8
        __syncthreads();
#endif
        for (int tk = F.vcu * NWAVES + F.wave; tk < 2048; tk += F.G * NWAVES) lru_wave_task(F, args, j, tk);
        __syncthreads();
        for (int it = F.vcu; it < 256; it += F.G) fox_cumsum(F, args, j, it);
    }; body_(); if (REPK(1)) body_(); }
    if (j == 0) SEAMF(pb + 1, 0, FILL0_LO + (1 + 1) * SEAM_ITEMS); else SEAMF(pb + 1, 1, FILL1_LO + (1 + 1) * SEAM_ITEMS);
    PROBE_END(1);
    PROBE_BEGIN(2);
    if (PHC(2) && IN(pb + 2)) { auto body_ = [&]() { Frame Fq_ = F; { int t_ = threadIdx.x; asm volatile("" : "+v"(t_)); Fq_.tid = t_; Fq_.lane = t_ & 63; } Frame& F = Fq_;
        for (int p = F.vcu; p < 256; p += F.G) { const int bh = p >> 3, s = p & 7; const float* cp = (const float*)(F.ws + WS_ESM + ES_CP) + (size_t)bh * SEQ; const float* ksg = (const float*)(F.ws + WS_SMALL + SM_KMAX) + bh * 8; float kmax = 0.f;
#pragma unroll
            for (int q = 0; q < 8; ++q) kmax = fmaxf(kmax, ksg[q]);
            kmax = sqrtf(kmax) * 1.002f; const float* segt = ksg + 256;
            attn_body::attn_unit<8>(bh >> 3, bh & 7, s, (const attn_body::bf16*)(F.ws + WS_Q), (const attn_body::bf16*)(F.ws + WS_K), (const attn_body::bf16*)(F.ws + WS_V), (attn_body::bf16*)(F.ws + WS_Y), cp, segt, kmax, (char*)lds_raw);
            attn_body::attn_unit<8>(bh >> 3, bh & 7, 15 - s, (const attn_body::bf16*)(F.ws + WS_Q), (const attn_body::bf16*)(F.ws + WS_K), (const attn_body::bf16*)(F.ws + WS_V), (attn_body::bf16*)(F.ws + WS_Y), cp, segt, kmax, (char*)lds_raw); }
        __syncthreads();
        for (int it = F.vcu; it < 256; it += F.G) lru_fixup(F, it >> 6, it & 63);
    }; body_(); if (REPK(2)) body_(); }
    if (j == 0) SEAMF(pb + 2, 0, FILL0_LO + (1 + 2) * SEAM_ITEMS); else SEAM(pb + 2);
    PROBE_END(2);
    PROBE_BEGIN(3);
    if (PHC(3) && IN(pb + 3)) { auto body_ = [&]() { Frame Fq_ = F; { int t_ = threadIdx.x; asm volatile("" : "+v"(t_)); Fq_.tid = t_; Fq_.lane = t_ & 63; } Frame& F = Fq_;
        pg8::DenseSched S; S.init((const bf16_t*)(F.ws + WS_Y), (const bf16_t*)(F.ws + WS_WOUTE) + (size_t)j * D * D, T, D, D, F.G, cblk);
        EPIRES_T(j == 0) E{(j == 0) ? args.in[0] : (BF16_RESID ? nullptr : H), HB, H, (FFN_UP_FP8 && !BF16_RESID) ? nullptr : HB, SSB, (FFN_UP_FP8 || FFN_UP_I8) ? (unsigned char*)(F.ws + WS_HB8) : nullptr, pg8::SumSq{FFN_UP_I8 ? SSA : nullptr, nullptr}};
        pg8::gemm_phase<EPIRES_T(j == 0), pg8::DenseSched, false, true>(F.lds, D, D, S, E);
    }; body_(); if (REPK(3)) body_(); }
    if (j == 0) SEAMF(pb + 3, 0, FILL0_LO + (1 + 3) * SEAM_ITEMS); else SEAM(pb + 3);
    PROBE_END(3);
    PROBE_BEGIN(4);
    if (PHC(4) && IN(pb + 4)) { auto body_ = [&]() { Frame Fq_ = F; { int t_ = threadIdx.x; asm volatile("" : "+v"(t_)); Fq_.tid = t_; Fq_.lane = t_ & 63; } Frame& F = Fq_;
#if FFN_UP_I8
        pg8::DenseSched S; S.init(F.ws + WS_HB8, (const unsigned char*)(F.ws + WS_W13F) + (size_t)j * 2 * DFF * D, T, 2 * DFF, D, F.G, cblk, 1);
        pg8::EpiGluI8 E{pg8::SumSq{nullptr, SSB}, pg8::SumSq{SSA, nullptr}, (const float*)(F.ws + CTL_WMAX) + j * 2 * DFF, (bf16_t*)(F.ws + WS_HF), DFF};
        pg8::gemm_phase<pg8::EpiGluI8, pg8::DenseSched, true, true, 1, true>(F.lds, D, D, S, E);
        { pg8::Unit u_; if (!S.next(5, u_) && F.G == 256) convert_experts_range(F, args, j, (j == 1 ? CV_PRE + CV_O4B : 0) + CV_T1, (j == 1 ? CV_PRE + CV_O4B : 0) + CV_T1 + CV_T2, (cblk - 128) * NWAVES + F.wave, 128 * NWAVES); }
#elif FFN_UP_FP8
        pg8::DenseSched S; S.init(F.ws + WS_HB8, (const unsigned char*)(F.ws + WS_W13F) + (size_t)j * 2 * DFF * D, T, 2 * DFF, D, F.G, cblk, 1);
        pg8::EpiGluT<FFN_DN_FP8 != 0> E{pg8::SumSq{nullptr, SSB}, (void*)(F.ws + WS_HF), DFF};
        pg8::gemm_phase<pg8::EpiGluT<FFN_DN_FP8 != 0>, pg8::DenseSched, true, true, 1>(F.lds, D, D, S, E, W13_SCALE);
        { pg8::Unit u_; if (!S.next(5, u_) && F.G == 256) convert_experts_range(F, args, j, (j == 1 ? CV_PRE + CV_O4B : 0) + CV_T1, (j == 1 ? CV_PRE + CV_O4B : 0) + CV_T1 + CV_T2, (cblk - 128) * NWAVES + F.wave, 128 * NWAVES); }
#else
        pg8::DenseSched S; S.init(HB, (const bf16_t*)(F.ws + WS_W13F) + (size_t)j * 2 * DFF * D, T, 2 * DFF, D, F.G, cblk);
        pg8::EpiGluT<FFN_DN_FP8 != 0> E{pg8::SumSq{nullptr, SSB}, (void*)(F.ws + WS_HF), DFF};
        pg8::gemm_phase<pg8::EpiGluT<FFN_DN_FP8 != 0>, pg8::DenseSched, true, true>(F.lds, D, D, S, E);
        { pg8::Unit u_; if (!S.next(5, u_) && F.G == 256) convert_experts_range(F, args, j, (j == 1 ? CV_PRE + CV_O4B : 0) + CV_T1, (j == 1 ? CV_PRE + CV_O4B : 0) + CV_T1 + CV_T2, (cblk - 128) * NWAVES + F.wave, 128 * NWAVES); }
#endif
    }; body_(); if (REPK(4)) body_(); }
    if (j == 0) SEAMF(pb + 4, 0, FILL0_LO + (1 + 4) * SEAM_ITEMS); else SEAM(pb + 4);
    PROBE_END(4);
    PROBE_BEGIN(5);
    if (PHC(5) && IN(pb + 5)) { auto body_ = [&]() { Frame Fq_ = F; { int t_ = threadIdx.x; asm volatile("" : "+v"(t_)); Fq_.tid = t_; Fq_.lane = t_ & 63; } Frame& F = Fq_;
#if FFN_DN_FP8
        pg8::DenseSched S; S.init(F.ws + WS_HF, (const unsigned char*)(F.ws + WS_W2F) + (size_t)j * D * DFF, T, D, DFF, F.G, cblk, 1);
        EPIRES_T(false) E{BF16_RESID ? nullptr : H, HB, H, HB, SSC, (IN_O_I8 == 1) ? (unsigned char*)(F.ws + WS_HB8O) : nullptr, pg8::SumSq{nullptr, (IN_O_I8 == 1) ? SSB : nullptr}};
        pg8::gemm_phase<EPIRES_T(false), pg8::DenseSched, false, true, 1>(F.lds, DFF, DFF, S, E, W2_SCALE);
#else
        pg8::DenseSched S; S.init((const bf16_t*)(F.ws + WS_HF), (const bf16_t*)(F.ws + WS_W2F) + (size_t)j * D * DFF, T, D, DFF, F.G, cblk);
        EPIRES_T(false) E{BF16_RESID ? nullptr : H, HB, H, HB, SSC, (IN_O_I8 == 1) ? (unsigned char*)(F.ws + WS_HB8O) : nullptr, pg8::SumSq{nullptr, (IN_O_I8 == 1) ? SSB : nullptr}};
        pg8::gemm_phase<EPIRES_T(false), pg8::DenseSched, false, true>(F.lds, DFF, DFF, S, E);
#endif
    }; body_(); if (REPK(5)) body_(); }
    if (j == 0) SEAMF(pb + 5, 0, FILL0_LO + (1 + 5) * SEAM_ITEMS); else SEAM(pb + 5);
    PROBE_END(5);
    PROBE_BEGIN(6);
    if (PHC(6) && IN(pb + 6)) { auto body_ = [&]() { Frame Fq_ = F; { int t_ = threadIdx.x; asm volatile("" : "+v"(t_)); Fq_.tid = t_; Fq_.lane = t_ & 63; } Frame& F = Fq_;
#if IN_O_I8 == 2
        XcdSplit o1sp; o1sp.gen = 0u; o1sp.leader = false;
        {
            const bf16_t* hbq = (const bf16_t*)(F.ws + WS_HB); unsigned char* q8 = (unsigned char*)(F.ws + WS_HB8O); float* stp = (float*)(F.ws + WS_SMALL + SM_STEPO);
            const int gwq = F.vcu * NWAVES + F.wave, NGWQ = F.G * NWAVES;
            for (int m0 = gwq; m0 < T; m0 += 4 * NGWQ) { RowV rq[4];
#pragma unroll
                for (int u = 0; u < 4; ++u) { const int m = m0 + u * NGWQ; if (m < T) row_load_bf16(rq[u], hbq + (size_t)m * D, F.lane); }
#pragma unroll
                for (int u = 0; u < 4; ++u) { const int m = m0 + u * NGWQ; if (m < T) { const float st = row_store_i8max(rq[u], q8 + (size_t)m * D, F.lane); if (F.lane == 0) stp[m] = st; } } }
            if (hi - lo > 1) { asm volatile("s_waitcnt vmcnt(0)" ::: "memory"); __syncthreads(); if (F.tid == 0) o1sp = xcd_arrive(bar); }
            else split_arrive((unsigned*)(F.ctl + CW_SPLIT + 64 * j));
        }
#endif
        {
            const int wk = F.vcu * NWAVES + F.wave, nw = F.G * NWAVES;
            if (F.G != 256) convert_experts_range(F, args, j, 0, CV_ITEMS, wk, nw);
            else if (j == 0) convert_experts_range(F, args, j, fullfill ? FILL_END : CV_T1 + CV_T2, CV_ITEMS, wk, nw);
            else { int nm0 = 0; { const unsigned* c0 = (const unsigned*)(F.ctl + CW_CNT);
#pragma unroll
                    for (int e = 0; e < 8; ++e) nm0 += ((int)__builtin_amdgcn_readfirstlane(__hip_atomic_load(c0 + e, RLX_AGENT)) + 255) >> 8; }
                if (tail_first(8 * nm0) >= 256) convert_experts_range(F, args, j, 0, CV_PRE, wk, nw);
                if (CV_O4B > 0) { const int nx = o4b_share(tail_first(28 * nm0)); if (nx < CV_O4B) convert_experts_range(F, args, j, CV_PRE + nx, CV_PRE + CV_O4B, wk, nw); }
                convert_experts_range(F, args, j, fullfill ? FILL_END : CV_PRE + CV_O4B + CV_T1 + CV_T2, CV_ITEMS, wk, nw); }
        }
        __syncthreads();
        for (int rb = F.vcu; rb < 256; rb += F.G) skinny_lr(F, j, rb, pg8::SumSq{nullptr, SSC});
#if IN_O_I8 == 2
        if (hi - lo > 1) { if (F.tid == 0) xcd_wait(bar, o1sp); __syncthreads(); } else split_wait((unsigned*)(F.ctl + CW_SPLIT + 64 * j), (unsigned*)(F.ctl + CW_BAR));
        pg8::DenseSched S; S.init(F.ws + WS_HB8O, (const unsigned char*)(F.ws + WS_WINO) + (size_t)j * 3072 * D, T, 3072, D, F.G, cblk, 1);
        pg8::EpiProjI8<1> E{pg8::SumSq{nullptr, SSC}, pg8::SumSq{nullptr, nullptr}, (const float*)(F.ws + CTL_WMAXO) + j * 3072, (bf16_t*)(F.ws + WS_GQ), 512, 1.f, (const float*)(F.ws + WS_SMALL + SM_STEPO)};
        pg8::gemm_phase<pg8::EpiProjI8<1>, pg8::DenseSched, true, true, 1, true>(F.lds, D, D, S, E);
#elif IN_O_I8
        pg8::DenseSched S; S.init(F.ws + WS_HB8O, (const unsigned char*)(F.ws + WS_WINO) + (size_t)j * 3072 * D, T, 3072, D, F.G, cblk, 1);
        pg8::EpiProjI8<1> E{pg8::SumSq{nullptr, SSC}, pg8::SumSq{nullptr, SSB}, (const float*)(F.ws + CTL_WMAXO) + j * 3072, (bf16_t*)(F.ws + WS_GQ), 512, 1.f};
        pg8::gemm_phase<pg8::EpiProjI8<1>, pg8::DenseSched, true, true, 1, true>(F.lds, D, D, S, E);
#else
        pg8::DenseSched S; S.init(HB, (const bf16_t*)(F.ws + WS_WINO) + (size_t)j * 3072 * D, T, 3072, D, F.G, cblk);
        pg8::EpiProj<1> E{pg8::SumSq{nullptr, SSC}, (bf16_t*)(F.ws + WS_GQ), 512, 1.f, nullptr};
        pg8::gemm_phase<pg8::EpiProj<1>, pg8::DenseSched, true, true>(F.lds, D, D, S, E);
#endif
    }; body_(); if (REPK(6)) body_(); }
    if (j == 0) SEAMF(pb + 6, 0, FILL0_LO + (1 + 6) * SEAM_ITEMS); else SEAM(pb + 6);
    PROBE_END(6);
    PROBE_BEGIN(7);
    if (PHC(7) && IN(pb + 7)) { auto body_ = [&]() { Frame Fq_ = F; { int t_ = threadIdx.x; asm volatile("" : "+v"(t_)); Fq_.tid = t_; Fq_.lane = t_ & 63; } Frame& F = Fq_;     GlaPrepRegs R; R.gh = -1; if (F.vcu < 1024) gla_prep_load(F, F.vcu, R); for (int it = F.vcu; it < 1024; it += F.G) gla_prep(F, args, j, it, it + F.G < 1024 ? it + F.G : -1, R); }; body_(); if (REPK(7)) body_(); }
    if (j == 0) SEAMF(pb + 7, 0, FILL0_LO + (1 + 7) * SEAM_ITEMS); else SEAM(pb + 7);
    PROBE_END(7);
    PROBE_BEGIN(8);
    if (PHC(8) && IN(pb + 8)) { auto body_ = [&]() { Frame Fq_ = F; { int t_ = threadIdx.x; asm volatile("" : "+v"(t_)); Fq_.tid = t_; Fq_.lane = t_ & 63; } Frame& F = Fq_;     for (int g = F.vcu * NTHR + F.tid; g < 131072; g += F.G * NTHR) gla_state(F, g); }; body_(); if (REPK(8)) body_(); }
    if (j == 0) SEAMF(pb + 8, 0, FILL0_LO + (1 + 8) * SEAM_ITEMS); else SEAM(pb + 8);
    PROBE_END(8);
    PROBE_BEGIN(9);
    if (PHC(9) && IN(pb + 9)) { auto body_ = [&]() { Frame Fq_ = F; { int t_ = threadIdx.x; asm volatile("" : "+v"(t_)); Fq_.tid = t_; Fq_.lane = t_ & 63; } Frame& F = Fq_;     GlaOutRegs R; int cur_h = -1; if (F.vcu < 1024) gla_out_load(F, F.vcu, R); for (int it = F.vcu; it < 1024; it += F.G) { const int ih = (it >> 6) & 3; if (ih != cur_h) { __syncthreads(); if (F.tid < 256) ((LAS float*)(F.lds + GC_HN))[F.tid] = args.in[20][j * 1024 + ih * 256 + F.tid]; cur_h = ih; }     gla_out(F, args, j, it, it + F.G < 1024 ? it + F.G : -1, R); } }; body_(); if (REPK(9)) body_(); }
    if (j == 0) SEAMF(pb + 9, 0, FILL0_LO + (1 + 9) * SEAM_ITEMS); else SEAM(pb + 9);
    PROBE_END(9);
    PROBE_BEGIN(10);
    if (PHC(10) && IN(pb + 10)) { auto body_ = [&]() { Frame Fq_ = F; { int t_ = threadIdx.x; asm volatile("" : "+v"(t_)); Fq_.tid = t_; Fq_.lane = t_ & 63; } Frame& F = Fq_;
        pg8::DenseSched S; S.init((const bf16_t*)(F.ws + WS_OG), (const bf16_t*)(F.ws + WS_WOUTO) + (size_t)j * D * D, T, D, D, F.G, cblk);
        EPIRES_T(false) E{BF16_RESID ? nullptr : H, HB, H, BF16_RESID ? HB : nullptr, nullptr, nullptr, pg8::SumSq{nullptr, nullptr}};
        pg8::gemm_phase<EPIRES_T(false), pg8::DenseSched, false, true>(F.lds, D, D, S, E);
    }; body_(); if (REPK(10)) body_(); }
    if (j == 0) SEAMF(pb + 10, 0, FILL0_LO + (1 + 10) * SEAM_ITEMS); else SEAM(pb + 10);
    PROBE_END(10);
    PROBE_BEGIN(11);
    if (PHC(11) && IN(pb + 11)) { auto body_ = [&]() { Frame Fq_ = F; { int t_ = threadIdx.x; asm volatile("" : "+v"(t_)); Fq_.tid = t_; Fq_.lane = t_ & 63; } Frame& F = Fq_;
        stage_table8(F, (LAS float*)(F.lds + RP_TAB), args.in[22] + (size_t)j * D * 8, 8, 0, args.in[2] + (2 * j + 1) * D);
        f32x4 gk[4];
#pragma unroll
        for (int jj = 0; jj < 4; ++jj) gk[jj] = *(const GAS f32x4*)(args.in[2] + (2 * j + 1) * D + 4 * F.lane + 256 * jj);
        for (int rb = F.vcu; rb < 256; rb += F.G) router_rows(F, args, j, rb, gk);
    }; body_(); if (REPK(11)) body_(); }
    if (j == 0) SEAMF(pb + 11, 0, FILL0_LO + (1 + 11) * SEAM_ITEMS); else SEAM(pb + 11);
    PROBE_END(11);
    if (IN(pb + 12) || IN(pb + 13) || IN(pb + 14)) moe_tables(F, j);
    const LAS int* tab = (const LAS int*)(F.lds + MT_OFF);
    PROBE_BEGIN(12);
    if (PHC(12) && IN(pb + 12)) { auto body_ = [&]() { Frame Fq_ = F; { int t_ = threadIdx.x; asm volatile("" : "+v"(t_)); Fq_.tid = t_; Fq_.lane = t_ & 63; } Frame& F = Fq_;
        pg8::MoeSched<true> S; S.A = (const char*)(F.ws + WS_XN); S.Bt = (const char*)(F.ws + WS_W13E + (size_t)j * W13E_PAIR); S.nM = __builtin_amdgcn_readfirstlane(tab[8]); S.nN = 2 * DFE / 256; S.G = F.G; S.c = cblk;
        S.tstepA = 0; S.tstepB = (size_t)256 * D; S.estride = (size_t)2 * DFE * D; S.K2 = D; S.ncol = 2 * DFE / 256; S.ksoff = 0; S.tab = tab; S.TL = (const int*)(F.ws + WS_RT + RT_TL); S.rowtab = (const LAS unsigned*)(F.lds + ROWTAB_OFF); S.fill_rows((LAS unsigned*)(F.lds + ROWTAB_OFF));
        pg8::EpiGluT<true> E{pg8::SumSq{nullptr, nullptr}, (void*)(F.ws + WS_HM), DFE};
        pg8::gemm_phase<pg8::EpiGluT<true>, pg8::MoeSched<true>, true, true, 1>(F.lds, D, D, S, E, W13_SCALE);
        if (j == 0 && F.G == 256 && CV_O4B > 0) { const int tf = tail_first(S.nM * S.nN); const int nx = o4b_share(tf); if (cblk >= tf) convert_experts_range(F, args, 1, CV_PRE, CV_PRE + nx, (cblk - tf) * NWAVES + F.wave, (256 - tf) * NWAVES); }
    }; body_(); if (REPK(12)) body_(); }
    SEAM(pb + 12);
    PROBE_END(12);
    PROBE_BEGIN(13);
    if (PHC(13) && IN(pb + 13)) { auto body_ = [&]() { Frame Fq_ = F; { int t_ = threadIdx.x; asm volatile("" : "+v"(t_)); Fq_.tid = t_; Fq_.lane = t_ & 63; } Frame& F = Fq_;
        pg8::MoeSched<false> S; S.A = (const char*)(F.ws + WS_HM); S.Bt = (const char*)(F.ws + WS_W2E); S.nM = __builtin_amdgcn_readfirstlane(tab[8]); S.nN = 2 * (D / 256); S.G = F.G; S.c = cblk;
        S.tstepA = (size_t)256 * DFE; S.tstepB = (size_t)256 * DFE; S.estride = (size_t)D * DFE; S.K2 = DFE; S.ncol = D / 256; S.ksoff = (size_t)(DFE / 2); S.tab = tab; S.TL = nullptr; S.rowtab = nullptr;
        pg8::EpiProj<3> E{pg8::SumSq{nullptr, nullptr}, (bf16_t*)(F.ws + WS_YM), D, 1.f, (bf16_t*)(F.ws + WS_YM1)};
        pg8::gemm_phase<pg8::EpiProj<3>, pg8::MoeSched<false>, true, true, 1>(F.lds, DFE / 2, DFE, S, E, W2_SCALE);
        if (j == 0 && F.G == 256) { const int tf = tail_first(S.nM * S.nN); if (cblk >= tf) convert_experts_range(F, args, 1, 0, CV_PRE, (cblk - tf) * NWAVES + F.wave, (256 - tf) * NWAVES); }
    }; body_(); if (REPK(13)) body_(); }
    SEAM(pb + 13);
    PROBE_END(13);
    PROBE_BEGIN(14);
    if (PHC(14) && IN(pb + 14)) { auto body_ = [&]() { Frame Fq_ = F; { int t_ = threadIdx.x; asm volatile("" : "+v"(t_)); Fq_.tid = t_; Fq_.lane = t_ & 63; } Frame& F = Fq_;
        if (j == 0) stage_table8(F, (LAS float*)(F.lds), args.in[4] + (size_t)D * EIN, EIN, 2560, args.in[1] + 2 * D);
        combine_rows(F, args, j, j == 1);
    }; body_(); if (REPK(14)) body_(); }
    if (j == 0) SEAMF(pb + 14, 1, FILL1_LO);
    PROBE_END(14);
}

__global__ void __launch_bounds__(NTHR, 2) fwd(Args args) {
    extern __shared__ __attribute__((aligned(16))) unsigned char lds_raw[];
    Frame F;
    F.lds = (LAS unsigned char*)lds_raw; F.MISC = (volatile LAS unsigned*)(F.lds + MISC_OFF);
    F.tid = threadIdx.x; F.lane = F.tid & 63; F.wave = __builtin_amdgcn_readfirstlane(F.tid >> 6);
    F.G = gridDim.x; { const int bx = blockIdx.x; F.vcu = (F.G % 8 == 0) ? (bx % 8) * (F.G / 8) + bx / 8 : bx; }
    F.ws = args.ws; F.ctl = (gu32*)(args.ws + WS_CTL);
    for (int u = F.tid; u < (LDS_BYTES - RING_BYTES) / 4; u += NTHR) ((LAS unsigned*)(F.lds + RING_BYTES))[u] = 0u;
    __syncthreads();
    const int lo = args.ph_lo, hi = args.ph_hi;
    const bool multi = (hi - lo) > 1;
    XcdBarrier bar; bar.bar = (unsigned*)(F.ctl + CW_BAR); bar.x = 0; bar.st = nullptr;
    if (multi) bar = xcd_barrier_post((unsigned*)(F.ctl + CW_BAR), F.MISC + 8);
    unsigned long long pr_acc = 0, pr_t0 = 0;
    PROBE_BEGIN(15);
    if (PHC(15) && IN(0)) {
#if E1_I8
        if (args.p0sub != 2) colmax_wine(F, args);
        if (args.p0sub == 0 && multi) xcd_barrier(bar);
        if (args.p0sub != 1) { convert_dense(F, args); __syncthreads(); p0_rows(F, args); }
#else
        convert_dense(F, args); __syncthreads(); p0_rows(F, args);
#endif
    }
    { const bool fullfill = SEAM_FILL && lo == 0 && hi == N_PHASES && F.G == 256; SEAMF(0, 0, FILL0_LO); }
    PROBE_END(15);
    pair_body<0>(F, args, lo, hi, bar, lds_raw, pr_acc);
    pair_body<1>(F, args, lo, hi, bar, lds_raw, pr_acc);
    if (PROBE_PHASE >= 0 && blockIdx.x == 0 && threadIdx.x == 0) { const unsigned long long t1 = __builtin_amdgcn_s_memrealtime(); while (__builtin_amdgcn_s_memrealtime() - t1 < 4ull * pr_acc) __builtin_amdgcn_s_sleep(8); }
}
#undef IN
#undef SEAM
}
extern "C" void kernel_launch(void* const* d_in, const int* in_sizes, int n_in, void* d_out, int out_size, void* d_ws, size_t ws_size, hipStream_t stream) {
    static int grid = 0;
    if (grid == 0) {
        if (n_in != 26 || out_size != 16384 * 1024 || ws_size < (size_t)896 * 1024 * 1024) { fprintf(stderr, "kernel_launch: unexpected sizes n_in %d out %d ws %zu\n", n_in, out_size, ws_size); grid = -1; return; }
        int dev = 0, cus = 0, per_cu = 0;
        if (hipGetDevice(&dev) != hipSuccess || hipDeviceGetAttribute(&cus, hipDeviceAttributeMultiprocessorCount, dev) != hipSuccess) { grid = -1; return; }
        if (hipFuncSetAttribute((const void*)fk::fwd, hipFuncAttributeMaxDynamicSharedMemorySize, fk::LDS_BYTES) != hipSuccess) { fprintf(stderr, "kernel_launch: hipFuncSetAttribute failed\n"); grid = -1; return; }
        if (hipOccupancyMaxActiveBlocksPerMultiprocessor(&per_cu, (const void*)fk::fwd, fk::NTHR, fk::LDS_BYTES) != hipSuccess || per_cu < 1) fprintf(stderr, "kernel_launch: occupancy query says %d\n", per_cu);
        (void)hipGetLastError();
        grid = cus;
    }
    if (grid < 0) return;
    (void)hipMemsetAsync((char*)d_ws + fk::WS_CTL, 0, fk::CTL_ZERO_BYTES, stream);
    fk::Args a{};
    for (int i = 0; i < 26; ++i) a.in[i] = (const float*)d_in[i];
    a.out = (float*)d_out; a.ws = (unsigned char*)d_ws; a.ph_lo = 0; a.ph_hi = fk::N_PHASES;
    hipLaunchKernelGGL(fk::fwd, dim3(grid), dim3(fk::NTHR), fk::LDS_BYTES, stream, a);
#ifdef PROF_PHASES
    { const int plist[] = {PROF_PHASES};
      for (int r = 0; r < PROF_REP; ++r) for (int ph : plist) { a.ph_lo = ph; a.ph_hi = ph + 1; hipLaunchKernelGGL(fk::fwd, dim3(grid), dim3(fk::NTHR), fk::LDS_BYTES, stream, a); } }
#endif
}
```

```cpp
#include <hip/hip_runtime.h>
#include <cstdio>
#include <cstdint>
#include <hip/hip_bf16.h>
#include <cmath>
#ifndef BUILD_MODE
#define BUILD_MODE 0
#endif
#define GAS __attribute__((address_space(1)))
#define LAS __attribute__((address_space(3)))
typedef unsigned short bf16_t;
typedef short bf16x8 __attribute__((ext_vector_type(8)));
typedef short s16x4 __attribute__((ext_vector_type(4)));
typedef float f32x4 __attribute__((ext_vector_type(4)));
typedef float f32x2 __attribute__((ext_vector_type(2)));
typedef float f32x16 __attribute__((ext_vector_type(16)));
typedef unsigned u32x4 __attribute__((ext_vector_type(4)));
typedef unsigned u32x2 __attribute__((ext_vector_type(2)));
typedef int i32x8 __attribute__((ext_vector_type(8)));
typedef int i32x4 __attribute__((ext_vector_type(4)));
typedef GAS unsigned gu32;
#define RLX_AGENT __ATOMIC_RELAXED, __HIP_MEMORY_SCOPE_AGENT
#define LDS_WAIT() asm volatile("s_waitcnt lgkmcnt(0)" ::: "memory")
#define VM_WAIT() asm volatile("s_waitcnt vmcnt(0)" ::: "memory")
__device__ __forceinline__ unsigned cvt_pk_bf16(float lo, float hi) { unsigned r; asm volatile("v_cvt_pk_bf16_f32 %0, %1, %2" : "=v"(r) : "v"(lo), "v"(hi)); return r; }
__device__ __forceinline__ float bf2f(bf16_t v) { return __uint_as_float(((unsigned)v) << 16); }
__device__ __forceinline__ float bflo(unsigned w) { return __uint_as_float(w << 16); }
__device__ __forceinline__ float bfhi(unsigned w) { return __uint_as_float(w & 0xffff0000u); }
#ifndef WT_STORES
#define WT_STORES 0
#endif
__device__ __forceinline__ void st16(void* p, const u32x4& v, bool wt) { if (WT_STORES && wt) asm volatile("global_store_dwordx4 %0, %1, off sc1\n\ts_nop 1" :: "v"(p), "v"(v) : "memory"); else *(u32x4*)p = v; }
__device__ __forceinline__ void st8(void* p, const u32x2& v, bool wt) { if (WT_STORES && wt) asm volatile("global_store_dwordx2 %0, %1, off sc1\n\ts_nop 1" :: "v"(p), "v"(v) : "memory"); else *(u32x2*)p = v; }
template <int CTRL> __device__ __forceinline__ float dpp_f(float v) { return __int_as_float(__builtin_amdgcn_update_dpp(0, __float_as_int(v), CTRL, 0xF, 0xF, true)); }
__device__ __forceinline__ float wave_sum(float v) {
    v += dpp_f<0xB1>(v); v += dpp_f<0x4E>(v); v += dpp_f<0x141>(v); v += dpp_f<0x140>(v);
    { const unsigned u = __float_as_uint(v); const auto p = __builtin_amdgcn_permlane16_swap(u, u, false, false); const unsigned a = p[0], b = p[1]; v = __uint_as_float(a) + __uint_as_float(b); }
    { const unsigned u = __float_as_uint(v); const auto p = __builtin_amdgcn_permlane32_swap(u, u, false, false); const unsigned a = p[0], b = p[1]; v = __uint_as_float(a) + __uint_as_float(b); }
    return v;
}
__device__ __forceinline__ float sum_rows4(float v) {
    { const unsigned u = __float_as_uint(v); const auto p = __builtin_amdgcn_permlane16_swap(u, u, false, false); const unsigned a = p[0], b = p[1]; v = __uint_as_float(a) + __uint_as_float(b); }
    { const unsigned u = __float_as_uint(v); const auto p = __builtin_amdgcn_permlane32_swap(u, u, false, false); const unsigned a = p[0], b = p[1]; v = __uint_as_float(a) + __uint_as_float(b); }
    return v;
}
__device__ __forceinline__ float wave_max(float v) {
    v = fmaxf(v, dpp_f<0xB1>(v)); v = fmaxf(v, dpp_f<0x4E>(v)); v = fmaxf(v, dpp_f<0x141>(v)); v = fmaxf(v, dpp_f<0x140>(v));
    { const unsigned u = __float_as_uint(v); const auto p = __builtin_amdgcn_permlane16_swap(u, u, false, false); const unsigned a = p[0], b = p[1]; v = fmaxf(__uint_as_float(a), __uint_as_float(b)); }
    { const unsigned u = __float_as_uint(v); const auto p = __builtin_amdgcn_permlane32_swap(u, u, false, false); const unsigned a = p[0], b = p[1]; v = fmaxf(__uint_as_float(a), __uint_as_float(b)); }
    return v;
}
__device__ __forceinline__ float fast_exp(float x) { return __builtin_amdgcn_exp2f(x * 1.4426950408889634f); }
__device__ __forceinline__ float fast_sigm(float x) { return __builtin_amdgcn_rcpf(1.f + __builtin_amdgcn_exp2f(-x * 1.4426950408889634f)); }
__device__ __forceinline__ float fast_silu(float x) { return x * fast_sigm(x); }

#define XB_TMO      128
#define XB_XCNT(j)  (256  + 64 * (j))
#define XB_XSUB(j)  (1280 + 64 * (j))
#define XB_XGEN(j)  (2304 + 64 * (j))
#define XB_TOP      3328
#define XB_TOPGEN   3392
#define XCD_BAR_WORDS 3456
#define XB_SPIN_CAP (1u << 18)

__device__ __forceinline__ unsigned xb_ld(unsigned* p)              { return __hip_atomic_load(p, __ATOMIC_RELAXED, __HIP_MEMORY_SCOPE_AGENT); }
__device__ __forceinline__ unsigned xb_add(unsigned* p, unsigned v) { return __hip_atomic_fetch_add(p, v, __ATOMIC_RELAXED, __HIP_MEMORY_SCOPE_AGENT); }
__device__ __forceinline__ unsigned xb_xcc_id() { return (unsigned)__builtin_amdgcn_s_getreg((3 << 11) | 20) & 0xFu; }
#define XB_SPIN(cond, bar) do { unsigned _sp = 0; while (cond) { __builtin_amdgcn_s_sleep(1); \
    if ((++_sp & 255u) == 0u) { if (xb_ld(&(bar)[XB_TMO])) break; if (_sp > XB_SPIN_CAP) { atomicAdd(&(bar)[XB_TMO], 1u); break; } } } } while (0)

struct XcdBarrier {
    unsigned* bar; unsigned x;
    volatile LAS unsigned* st;
};
__device__ __forceinline__ XcdBarrier xcd_barrier_post(unsigned* bar, volatile LAS unsigned* st) {
    XcdBarrier b; b.bar = bar; b.x = xb_xcc_id(); b.st = st;
    if (threadIdx.x == 0) (void)xb_add(&bar[XB_XCNT(b.x)], 1u);
    return b;
}
__device__ __forceinline__ void xcd_barrier_complete(unsigned* bar, unsigned x, unsigned& nloc, unsigned& nx) {
    const unsigned G = gridDim.x * gridDim.y * gridDim.z;
    unsigned sum, cnt, mine, sp = 0u;
    for (;;) {
        sum = 0u; cnt = 0u; mine = 0u;
#pragma unroll
        for (unsigned j = 0; j < 16; ++j) { const unsigned c = xb_ld(&bar[XB_XCNT(j)]); sum += c; cnt += (c > 0u) ? 1u : 0u; mine = (j == x) ? c : mine; }
        if (sum == G) break;
        __builtin_amdgcn_s_sleep(1);
        if ((++sp & 255u) == 0u) { if (xb_ld(&bar[XB_TMO])) break; if (sp > XB_SPIN_CAP) { atomicAdd(&bar[XB_TMO], 1u); break; } }
    }
    nloc = mine > 0u ? mine : 1u; nx = cnt > 0u ? cnt : 1u;
}
__device__ __forceinline__ void xcd_barrier(const XcdBarrier& b) {
    asm volatile("s_waitcnt vmcnt(0)" ::: "memory");
    __syncthreads();
    if (threadIdx.x == 0) {
        unsigned* bar = b.bar;
        __builtin_amdgcn_s_waitcnt(0);
        unsigned nloc = b.st[0], nx = b.st[1];
        if (nloc == 0u) { xcd_barrier_complete(bar, b.x, nloc, nx); b.st[0] = nloc; b.st[1] = nx; }
        const unsigned old = xb_add(&bar[XB_XSUB(b.x)], 1u);
        const unsigned gen = old / nloc;
        if (old + 1u == (gen + 1u) * nloc) {
            __builtin_amdgcn_fence(__ATOMIC_RELEASE, "agent");
            asm volatile("s_waitcnt vmcnt(0)" ::: "memory");
            const unsigned og = xb_add(&bar[XB_TOP], 1u);
            const unsigned tg = og / nx;
            if (og + 1u == (tg + 1u) * nx) xb_add(&bar[XB_TOPGEN], 1u);
            else XB_SPIN(xb_ld(&bar[XB_TOPGEN]) == tg, bar);
            __builtin_amdgcn_fence(__ATOMIC_ACQUIRE, "agent");
            xb_add(&bar[XB_XGEN(b.x)], 1u);
            asm volatile("s_waitcnt vmcnt(0)" ::: "memory");
        } else {
            XB_SPIN(xb_ld(&bar[XB_XGEN(b.x)]) == gen, bar);
            __builtin_amdgcn_fence(__ATOMIC_ACQUIRE, "agent");
            asm volatile("s_waitcnt vmcnt(0)" ::: "memory");
        }
    }
    __syncthreads();
}

__device__ __forceinline__ void split_arrive(unsigned* ctr) {
    asm volatile("s_waitcnt vmcnt(0)" ::: "memory");
    __syncthreads();
    if (threadIdx.x == 0) { __builtin_amdgcn_fence(__ATOMIC_RELEASE, "agent"); asm volatile("s_waitcnt vmcnt(0)" ::: "memory"); (void)xb_add(ctr, 1u); }
}
__device__ __forceinline__ void split_wait(unsigned* ctr, unsigned* bar) {
    if (threadIdx.x == 0) { const unsigned G = gridDim.x * gridDim.y * gridDim.z; XB_SPIN(xb_ld(ctr) < G, bar);
        __builtin_amdgcn_fence(__ATOMIC_ACQUIRE, "agent"); asm volatile("s_waitcnt vmcnt(0)" ::: "memory"); }
    __syncthreads();
}

namespace pg8 {
constexpr int BM = 256, BK = 64, HALF = 128, HTB = HALF * BK * 2  , STAGE_BYTES = 8 * HTB, NXCD = 8, WGM = 8;
__host__ __device__ __forceinline__ int lds_byte(int r, int c) { const int st = (r >> 4) * 2 + (c >> 5), rr = r & 15, cc = c & 31, ob = rr * 64 + cc * 2; return st * 1024 + (ob ^ (((ob >> 9) & 1) << 5)); }
__host__ __device__ __forceinline__ void stage_rc(int b, int& R, int& C) { const int st = b / 1024, sb = b % 1024, swz = sb ^ (((sb >> 9) & 1) << 5); R = (st >> 1) * 16 + swz / 64; C = (st & 1) * 32 + (swz % 64) / 2; }
__host__ __device__ __forceinline__ int perm32(int rho) { const int n = rho >> 4, i = rho & 15; return 8 * (i >> 2) + 4 * n + (i & 3); }

struct Unit { int pm, pn; };
__device__ __forceinline__ bool static_unit(int i, int G, int c, int nM, int nN, Unit& u) {
    const int nwg = nM * nN; const long L = (long)i * G + c; if (L >= nwg) return false;
    int wgid = (int)L; { const int q = nwg / NXCD, r = nwg % NXCD, xcd = wgid % NXCD, off = wgid / NXCD; wgid = (xcd < r ? xcd * (q + 1) : r * (q + 1) + (xcd - r) * q) + off; }
    const int nig = WGM * nN, gid = wgid / nig, fm = gid * WGM, gsz = (nM - fm) < WGM ? (nM - fm) : WGM;
    u.pm = fm + ((wgid % nig) % gsz); u.pn = (wgid % nig) / gsz; return true;
}
struct DenseSched {
    static constexpr bool GATHER = false;
    const char* A; const char* Bt; int nM, nN, G, c; size_t tstep;
    __device__ __forceinline__ void init(const void* A_, const void* Bt_, int M, int N, int K, int G_, int c_, int es = 2) { A = (const char*)A_; Bt = (const char*)Bt_; nM = M / BM; nN = N / BM; G = G_; c = c_; tstep = (size_t)BM * K * es; }
    __device__ __forceinline__ bool next(int i, Unit& u) const { return static_unit(i, G, c, nM, nN, u); }
    __device__ __forceinline__ const char* a_base(const Unit& u) const { return A + (size_t)u.pm * tstep; }
    __device__ __forceinline__ const char* b_base(const Unit& u) const { return Bt + (size_t)u.pn * tstep; }
    __device__ __forceinline__ void rows(const Unit&, const int (&)[2], int, unsigned (&)[2][2]) const {}
};
template <bool GATH> struct MoeSched {
    static constexpr bool GATHER = GATH;
    const char* A; const char* Bt; int nM, nN, G, c; size_t tstepA, tstepB, estride; int K2;
    int ncol; size_t ksoff;
    const LAS int* tab;
    const int* TL;
    const LAS unsigned* rowtab;
    __device__ __forceinline__ int expert(int pm) const { int e = 0;
#pragma unroll
        for (int k = 1; k < 8; ++k) e += (pm >= tab[k]) ? 1 : 0; return e; }
    __device__ __forceinline__ bool next(int i, Unit& u) const { return static_unit(i, G, c, nM, nN, u); }
    __device__ __forceinline__ const char* a_base(const Unit& u) const { return GATH ? A : A + (size_t)u.pm * tstepA + (size_t)(u.pn / ncol) * ksoff; }
    __device__ __forceinline__ const char* b_base(const Unit& u) const { return Bt + (size_t)__builtin_amdgcn_readfirstlane(expert(u.pm)) * estride + (size_t)(u.pn % ncol) * tstepB + (size_t)(u.pn / ncol) * ksoff; }
    __device__ __forceinline__ void rows(const Unit&, const int (&R)[2], int ord, unsigned (&v)[2][2]) const {
        if constexpr (GATH) {
#pragma unroll
            for (int h = 0; h < 2; ++h)
#pragma unroll
                for (int i = 0; i < 2; ++i) v[h][i] = rowtab[ord * 256 + h * 128 + R[i]];
        }
    }
    __device__ __forceinline__ void fill_rows(LAS unsigned* tabw) const {
        if constexpr (GATH) { Unit u;
            for (int i = 0; next(i, u); ++i) { if (threadIdx.x < 256) { const int e = expert(u.pm); const int pe = tab[e], ce = tab[16 + e]; int pos = (u.pm - pe) * 256 + (int)threadIdx.x; pos = pos < ce ? pos : ce - 1;
                    tabw[i * 256 + threadIdx.x] = (unsigned)TL[e * 16384 + pos] * (unsigned)K2; } }
            __syncthreads(); }
    }
};

constexpr float RMS_EPS = 1e-6f;
struct SumSq { const float* f; const unsigned long long* q; };
__device__ __forceinline__ float ss_value(const SumSq& s, int row) { if (s.q) { const unsigned long long v = s.q[row]; return (float)(unsigned)(v >> 32) + (float)(unsigned)v * (1.0f / 4294967296.0f); } return s.f[row]; }
__device__ __forceinline__ float inv_rms(const SumSq& s, int row) { return (s.f || s.q) ? 1.0f / sqrtf(ss_value(s, row) * (1.0f / 1024.0f) + RMS_EPS) : 1.0f; }
struct SsRaw { float f; unsigned long long q; };
__device__ __forceinline__ SsRaw ss_load(const SumSq& s, int row) { SsRaw r; r.f = 0.f; r.q = 0ull; if (s.q) r.q = s.q[row]; else if (s.f) r.f = s.f[row]; return r; }
__device__ __forceinline__ float ss_fin(const SumSq& s, const SsRaw& r) { if (s.q) return (float)(unsigned)(r.q >> 32) + (float)(unsigned)r.q * (1.0f / 4294967296.0f); return r.f; }
__device__ __forceinline__ float inv_rms_fin(const SumSq& s, const SsRaw& r) { return (s.f || s.q) ? 1.0f / sqrtf(ss_fin(s, r) * (1.0f / 1024.0f) + RMS_EPS) : 1.0f; }
constexpr int RS_TAB_OFF = 149504, CS_TAB_OFF = 151552;
struct RsRaw2 { SsRaw a, b; };

template <int MODE> struct EpiProj {
    static constexpr bool PERM = true, AFTER_DRAIN = false, ROWSCALE = (MODE != 3), COLSCALE = false;
    __device__ __forceinline__ RsRaw2 rs_load(int row) const { RsRaw2 r; r.a = ss_load(ss, row); r.b = r.a; return r; }
    __device__ __forceinline__ float rs_finish(const RsRaw2& r) const { return inv_rms_fin(ss, r.a); }
    SumSq ss; bf16_t* p0; int ld0; float qscale; bf16_t* p1;
    __device__ __forceinline__ void operator()(const f32x4 (&acc)[2][2][4][2], const Unit& u, int wr, int wc, int fr, int fq, const LAS float* rs = nullptr, bool wt = false) const {
        bf16_t* base; int ldc, colt; float scl = 1.f;
        if constexpr (MODE == 0) { const int t = u.pn >> 1; base = p0 + (size_t)t * (8u << 20); ldc = 512; colt = (u.pn & 1) * BM; scl = (t == 2) ? qscale : 1.f; }
        else if constexpr (MODE == 1) { if (u.pn < 4) { base = p0 + (size_t)(u.pn >> 1) * (8u << 20); ldc = 512; colt = (u.pn & 1) * BM; }
                                        else { const int q = u.pn - 4; base = p0 + (size_t)(16u << 20) + (size_t)(q >> 2) * (16u << 20); ldc = 1024; colt = (q & 3) * BM; } }
        else if constexpr (MODE == 3) { base = (u.pn >> 2) ? p1 : p0; ldc = ld0; colt = (u.pn & 3) * BM; }
        else { base = p0; ldc = ld0; colt = u.pn * BM; }
        const int row0 = u.pm * BM + wr * 64 + fr, col0 = colt + wc * 32 + 8 * fq;
#pragma unroll
        for (int ai = 0; ai < 2; ++ai)
#pragma unroll
            for (int m = 0; m < 4; ++m) { const int row = row0 + ai * HALF + m * 16; const float s = (rs ? rs[wr * 64 + fr + ai * HALF + m * 16] : inv_rms(ss, row)) * scl; bf16_t* rowp = base + (size_t)row * ldc + col0;
#pragma unroll
                for (int bj = 0; bj < 2; ++bj) { const f32x4 v0 = acc[ai][bj][m][0] * s, v1 = acc[ai][bj][m][1] * s;
                    u32x4 w; w.x = cvt_pk_bf16(v0[0], v0[1]); w.y = cvt_pk_bf16(v0[2], v0[3]); w.z = cvt_pk_bf16(v1[0], v1[1]); w.w = cvt_pk_bf16(v1[2], v1[3]);
                    st16(rowp + bj * HALF, w, wt); } }
    }
};
__device__ __forceinline__ unsigned q4_i8(float a, float b, float c, float d, float qs) {
    unsigned w = 0;
    w = __builtin_amdgcn_cvt_pk_u8_f32(__builtin_rintf(fmaf(a, qs, 128.f)), 0, w); w = __builtin_amdgcn_cvt_pk_u8_f32(__builtin_rintf(fmaf(b, qs, 128.f)), 1, w);
    w = __builtin_amdgcn_cvt_pk_u8_f32(__builtin_rintf(fmaf(c, qs, 128.f)), 2, w); w = __builtin_amdgcn_cvt_pk_u8_f32(__builtin_rintf(fmaf(d, qs, 128.f)), 3, w);
    return w ^ 0x80808080u; }
#ifndef I8_CLIP_V
#define I8_CLIP_V 6.0f
#endif
constexpr float I8_CLIP = I8_CLIP_V;
__device__ __forceinline__ float i8_act_step(const SumSq& ssin, int row) { return I8_CLIP * sqrtf(ss_value(ssin, row) * (1.0f / 1024.0f) + RMS_EPS) * (1.0f / 127.0f); }
template <int MODE> struct EpiProjI8 {
    static constexpr bool PERM = true, AFTER_DRAIN = false, ROWSCALE = true, COLSCALE = true;
    __device__ __forceinline__ float cs_load(const Unit& u, int c) const { return wmax[u.pn * BM + c]; }
    __device__ __forceinline__ RsRaw2 rs_load(int row) const { RsRaw2 r; r.a = ss_load(ss, row); if (stepv) { r.b.f = stepv[row]; r.b.q = 0ull; } else r.b = ss_load(ssin, row); return r; }
    __device__ __forceinline__ float rs_finish(const RsRaw2& r) const { return inv_rms_fin(ss, r.a) * (stepv ? r.b.f : I8_CLIP * sqrtf(ss_fin(ssin, r.b) * (1.0f / 1024.0f) + RMS_EPS) * (1.0f / 127.0f)); }
    SumSq ss; SumSq ssin; const float* wmax; bf16_t* p0; int ld0; float qscale; const float* stepv;
    __device__ __forceinline__ void operator()(const f32x4 (&acc)[2][2][4][2], const Unit& u, int wr, int wc, int fr, int fq, const LAS float* rs = nullptr, const LAS float* cs = nullptr, bool wt = false) const {
        bf16_t* base; int ldc, colt; float scl = 1.f;
        if constexpr (MODE == 0) { const int t = u.pn >> 1; base = p0 + (size_t)t * (8u << 20); ldc = 512; colt = (u.pn & 1) * BM; scl = (t == 2) ? qscale : 1.f; }
        else if constexpr (MODE == 1) { if (u.pn < 4) { base = p0 + (size_t)(u.pn >> 1) * (8u << 20); ldc = 512; colt = (u.pn & 1) * BM; }
                                        else { const int q = u.pn - 4; base = p0 + (size_t)(16u << 20) + (size_t)(q >> 2) * (16u << 20); ldc = 1024; colt = (q & 3) * BM; } }
        else { base = p0; ldc = ld0; colt = u.pn * BM; }
        const int row0 = u.pm * BM + wr * 64 + fr, col0 = colt + wc * 32 + 8 * fq;
        const float* wp = wmax + u.pn * BM + wc * 32 + 8 * fq;
#pragma unroll
        for (int ai = 0; ai < 2; ++ai)
#pragma unroll
            for (int m = 0; m < 4; ++m) { const int row = row0 + ai * HALF + m * 16; const float s = (rs ? rs[wr * 64 + fr + ai * HALF + m * 16] : inv_rms(ss, row) * (stepv ? stepv[row] : i8_act_step(ssin, row))) * scl * (1.0f / 127.0f); bf16_t* rowp = base + (size_t)row * ldc + col0;
#pragma unroll
                for (int bj = 0; bj < 2; ++bj) { const i32x4 i0 = __builtin_bit_cast(i32x4, acc[ai][bj][m][0]), i1 = __builtin_bit_cast(i32x4, acc[ai][bj][m][1]);
                    f32x4 w0, w1; if (cs) { const LAS float* cp = cs + wc * 32 + 8 * fq + bj * HALF; w0 = *(const LAS f32x4*)cp; w1 = *(const LAS f32x4*)(cp + 4); } else { w0 = *(const f32x4*)(wp + bj * HALF); w1 = *(const f32x4*)(wp + bj * HALF + 4); }
                    const f32x2 v0 = (f32x2){(float)i0[0], (float)i0[1]} * ((f32x2){w0[0], w0[1]} * s), v1 = (f32x2){(float)i0[2], (float)i0[3]} * ((f32x2){w0[2], w0[3]} * s);
                    const f32x2 v2 = (f32x2){(float)i1[0], (float)i1[1]} * ((f32x2){w1[0], w1[1]} * s), v3 = (f32x2){(float)i1[2], (float)i1[3]} * ((f32x2){w1[2], w1[3]} * s);
                    u32x4 w; w.x = cvt_pk_bf16(v0.x, v0.y); w.y = cvt_pk_bf16(v1.x, v1.y); w.z = cvt_pk_bf16(v2.x, v2.y); w.w = cvt_pk_bf16(v3.x, v3.y);
                    st16(rowp + bj * HALF, w, wt); } }
    }
};
struct EpiGluI8 {
    static constexpr bool PERM = true, AFTER_DRAIN = false, ROWSCALE = true, COLSCALE = true;
    __device__ __forceinline__ float cs_load(const Unit& u, int c) const { return sw[u.pn * BM + c]; }
    __device__ __forceinline__ RsRaw2 rs_load(int row) const { RsRaw2 r; r.a = ss_load(ss, row); r.b = ss_load(ssin, row); return r; }
    __device__ __forceinline__ float rs_finish(const RsRaw2& r) const { return inv_rms_fin(ss, r.a) * (I8_CLIP * sqrtf(ss_fin(ssin, r.b) * (1.0f / 1024.0f) + RMS_EPS) * (1.0f / 127.0f)); }
    SumSq ss; SumSq ssin; const float* sw; bf16_t* O; int ldc;
    __device__ __forceinline__ void operator()(const f32x4 (&acc)[2][2][4][2], const Unit& u, int wr, int wc, int fr, int fq, const LAS float* rs = nullptr, const LAS float* cs = nullptr, bool wt = false) const {
        const int row0 = u.pm * BM + wr * 64 + fr, col0 = u.pn * HALF + wc * 32 + 8 * fq;
        const float* swp = sw + u.pn * BM + wc * 32 + 8 * fq;
        f32x2 nw1[4], c13[4];
#pragma unroll
        for (int n = 0; n < 2; ++n) { f32x4 w1, w3; if (cs) { const LAS float* cp = cs + wc * 32 + 8 * fq; w1 = *(const LAS f32x4*)(cp + 4 * n); w3 = *(const LAS f32x4*)(cp + HALF + 4 * n); } else { w1 = *(const f32x4*)(swp + 4 * n); w3 = *(const f32x4*)(swp + HALF + 4 * n); }
#pragma unroll
            for (int h = 0; h < 2; ++h) { const f32x2 a = (f32x2){w1[2 * h], w1[2 * h + 1]}, b = (f32x2){w3[2 * h], w3[2 * h + 1]}; nw1[2 * n + h] = a * (-1.4426950408889634f); c13[2 * n + h] = a * b; } }
#pragma unroll
        for (int ai = 0; ai < 2; ++ai)
#pragma unroll
            for (int m = 0; m < 4; ++m) { const int row = row0 + ai * HALF + m * 16; const float s = (rs ? rs[wr * 64 + fr + ai * HALF + m * 16] : inv_rms(ss, row) * i8_act_step(ssin, row)) * (1.0f / 127.0f);
                const float s2 = s * s; f32x2 o[4];
#pragma unroll
                for (int n = 0; n < 2; ++n) { const i32x4 ia = __builtin_bit_cast(i32x4, acc[ai][0][m][n]), ib = __builtin_bit_cast(i32x4, acc[ai][1][m][n]);
#pragma unroll
                    for (int h = 0; h < 2; ++h) { const f32x2 af = (f32x2){(float)ia[2 * h], (float)ia[2 * h + 1]}, bf = (f32x2){(float)ib[2 * h], (float)ib[2 * h + 1]};
                        const f32x2 t = (af * nw1[2 * n + h]) * s; f32x2 d = (f32x2){__builtin_amdgcn_exp2f(t.x), __builtin_amdgcn_exp2f(t.y)} + 1.0f;
                        const f32x2 r = (f32x2){__builtin_amdgcn_rcpf(d.x), __builtin_amdgcn_rcpf(d.y)};
                        o[2 * n + h] = (((af * bf) * c13[2 * n + h]) * r) * s2; } }
                u32x4 w; w.x = cvt_pk_bf16(o[0].x, o[0].y); w.y = cvt_pk_bf16(o[1].x, o[1].y); w.z = cvt_pk_bf16(o[2].x, o[2].y); w.w = cvt_pk_bf16(o[3].x, o[3].y); st16(O + (size_t)row * ldc + col0, w, wt); }
    }
};
__device__ __forceinline__ unsigned pk4_fp8(float a, float b, float c, float d) { int w = __builtin_amdgcn_cvt_pk_fp8_f32(a, b, 0, false); w = __builtin_amdgcn_cvt_pk_fp8_f32(c, d, w, true); return (unsigned)w; }
template <bool F8> struct EpiGluT {
    static constexpr bool PERM = true, AFTER_DRAIN = false, ROWSCALE = false, COLSCALE = false;
    SumSq ss; void* O; int ldc;
    __device__ __forceinline__ void operator()(const f32x4 (&acc)[2][2][4][2], const Unit& u, int wr, int wc, int fr, int fq, const LAS float* rs = nullptr, bool wt = false) const {
        const int row0 = u.pm * BM + wr * 64 + fr, col0 = u.pn * HALF + wc * 32 + 8 * fq;
#pragma unroll
        for (int ai = 0; ai < 2; ++ai)
#pragma unroll
            for (int m = 0; m < 4; ++m) { const int row = row0 + ai * HALF + m * 16; const float s = inv_rms(ss, row); const float nls = -1.4426950408889634f * s, s2 = s * s;
                float o[8];
#pragma unroll
                for (int n = 0; n < 2; ++n)
#pragma unroll
                    for (int h = 0; h < 2; ++h) { const f32x2 af = (f32x2){acc[ai][0][m][n][2 * h], acc[ai][0][m][n][2 * h + 1]}, bf = (f32x2){acc[ai][1][m][n][2 * h], acc[ai][1][m][n][2 * h + 1]};
                        const f32x2 t = af * nls; f32x2 d = (f32x2){__builtin_amdgcn_exp2f(t.x), __builtin_amdgcn_exp2f(t.y)} + 1.0f;
                        const f32x2 r = (f32x2){__builtin_amdgcn_rcpf(d.x), __builtin_amdgcn_rcpf(d.y)}; const f32x2 ov = ((af * bf) * r) * s2; o[n * 4 + 2 * h] = ov.x; o[n * 4 + 2 * h + 1] = ov.y; }
                if constexpr (F8) { u32x2 w; w.x = pk4_fp8(o[0], o[1], o[2], o[3]); w.y = pk4_fp8(o[4], o[5], o[6], o[7]); st8((unsigned char*)O + (size_t)row * ldc + col0, w, wt); }
                else { u32x4 w; w.x = cvt_pk_bf16(o[0], o[1]); w.y = cvt_pk_bf16(o[2], o[3]); w.z = cvt_pk_bf16(o[4], o[5]); w.w = cvt_pk_bf16(o[6], o[7]); st16((bf16_t*)O + (size_t)row * ldc + col0, w, wt); } }
    }
};
typedef EpiGluT<false> EpiGlu;
template <bool BF16_RES> struct EpiResT {
    static constexpr bool PERM = false, AFTER_DRAIN = false, ROWSCALE = false, COLSCALE = false;
    const float* basef; const bf16_t* baseb; float* out; bf16_t* outb; unsigned long long* ss; unsigned char* outq; SumSq ssin;
    __device__ __forceinline__ void operator()(const f32x4 (&acc)[2][2][4][2], const Unit& u, int wr, int wc, int fr, int fq, const LAS float* rs = nullptr, bool wt = false) const {
        const int row0 = u.pm * BM + wr * 64 + fr, col0 = u.pn * BM + wc * 32 + 4 * fq;
        const bool fbase = !BF16_RES || basef != nullptr;
#pragma unroll
        for (int ai = 0; ai < 2; ++ai)
#pragma unroll
          for (int mh = 0; mh < 2; ++mh) {
            f32x4 res[2][2][2];
#pragma unroll
            for (int mm = 0; mm < 2; ++mm)
#pragma unroll
                for (int bj = 0; bj < 2; ++bj)
#pragma unroll
                    for (int n = 0; n < 2; ++n) { const size_t o2 = (size_t)(row0 + ai * HALF + (2 * mh + mm) * 16) * 1024 + col0 + bj * HALF + n * 16;
                        if (fbase) res[mm][bj][n] = *(const f32x4*)(basef + o2);
                        else { const u32x2 w = *(const u32x2*)(baseb + o2); res[mm][bj][n] = (f32x4){bflo(w.x), bfhi(w.x), bflo(w.y), bfhi(w.y)}; } }
#pragma unroll
            for (int mm = 0; mm < 2; ++mm) { const int m = 2 * mh + mm; const int row = row0 + ai * HALF + m * 16; const size_t off = (size_t)row * 1024 + col0; float rs = 0.f; const bool qi8 = ssin.f || ssin.q; const float qs = (outq && qi8) ? 1.0f / i8_act_step(ssin, row) : 0.f;
#pragma unroll
                for (int bj = 0; bj < 2; ++bj)
#pragma unroll
                    for (int n = 0; n < 2; ++n) { const size_t o2 = off + bj * HALF + n * 16; const f32x4 r = res[mm][bj][n] + acc[ai][bj][m][n];
                        if (!BF16_RES) *(f32x4*)(out + o2) = r;
                        rs += (r[0] * r[0] + r[1] * r[1]) + (r[2] * r[2] + r[3] * r[3]);
                        if (outb) { u32x2 w; w.x = cvt_pk_bf16(r[0], r[1]); w.y = cvt_pk_bf16(r[2], r[3]); *(u32x2*)(outb + o2) = w; }
                        if (outq) *(unsigned*)(outq + o2) = qi8 ? q4_i8(r[0], r[1], r[2], r[3], qs) : pk4_fp8(r[0], r[1], r[2], r[3]); }
                if (ss) { rs = sum_rows4(rs); if (fq == 0) { const unsigned hi_ = (unsigned)rs; const unsigned lo_ = (unsigned)((rs - (float)hi_) * 4294967296.0f);
                        __hip_atomic_fetch_add(ss + row, ((unsigned long long)hi_ << 32) | lo_, __ATOMIC_RELAXED, __HIP_MEMORY_SCOPE_AGENT); } } }
            asm volatile("" ::: "memory"); }
    }
};

template <bool FBASE> struct EpiResB {
    static constexpr bool PERM = true, AFTER_DRAIN = false, ROWSCALE = true, COLSCALE = false;
    __device__ __forceinline__ RsRaw2 rs_load(int row) const { RsRaw2 r; r.a = ss_load(ssin, row); r.b = r.a; return r; }
    __device__ __forceinline__ float rs_finish(const RsRaw2& r) const { return (ssin.f || ssin.q) ? 1.0f / (I8_CLIP * sqrtf(ss_fin(ssin, r.a) * (1.0f / 1024.0f) + RMS_EPS) * (1.0f / 127.0f)) : 0.f; }
    const float* basef; const bf16_t* baseb; float* out; bf16_t* outb; unsigned long long* ss; unsigned char* outq; SumSq ssin;
    struct Raw { u32x4 b; f32x4 f0, f1; };
    __device__ __forceinline__ void load_batch(Raw (&R)[2][2], int rowb, int col0) const {
#pragma unroll
        for (int mm = 0; mm < 2; ++mm)
#pragma unroll
            for (int bj = 0; bj < 2; ++bj) { const size_t o2 = (size_t)(rowb + mm * 16) * 1024 + col0 + bj * HALF;
                if constexpr (FBASE) { R[mm][bj].f0 = __builtin_nontemporal_load((const f32x4*)(basef + o2)); R[mm][bj].f1 = __builtin_nontemporal_load((const f32x4*)(basef + o2 + 4)); }     else R[mm][bj].b = *(const u32x4*)(baseb + o2); }
    }
    __device__ __forceinline__ void operator()(const f32x4 (&acc)[2][2][4][2], const Unit& u, int wr, int wc, int fr, int fq, const LAS float* rst = nullptr, bool wt = false) const {
        const int row0 = u.pm * BM + wr * 64 + fr, col0 = u.pn * BM + wc * 32 + 8 * fq;
        const bool qi8 = ssin.f || ssin.q;
        Raw R[2][2][2];
        load_batch(R[0], row0, col0);
#pragma unroll
        for (int s = 0; s < 4; ++s) { const int ai = s >> 1, mh = s & 1; const int rowb = row0 + ai * HALF + mh * 32;
            if (s < 3) load_batch(R[(s + 1) & 1], row0 + ((s + 1) >> 1) * HALF + ((s + 1) & 1) * 32, col0);
#pragma unroll
            for (int mm = 0; mm < 2; ++mm) { const int m = 2 * mh + mm; const int row = rowb + mm * 16; float rs = 0.f; const float qs = (outq && qi8) ? (rst ? rst[wr * 64 + fr + ai * HALF + m * 16] : 1.0f / i8_act_step(ssin, row)) : 0.f;
#pragma unroll
                for (int bj = 0; bj < 2; ++bj) { const Raw& q = R[s & 1][mm][bj]; f32x4 b0, b1;
                    if constexpr (FBASE) { b0 = q.f0; b1 = q.f1; } else { b0 = (f32x4){bflo(q.b.x), bfhi(q.b.x), bflo(q.b.y), bfhi(q.b.y)}; b1 = (f32x4){bflo(q.b.z), bfhi(q.b.z), bflo(q.b.w), bfhi(q.b.w)}; }
                    const f32x4 r0 = b0 + acc[ai][bj][m][0], r1 = b1 + acc[ai][bj][m][1]; const size_t o2 = (size_t)row * 1024 + col0 + bj * HALF;
                    rs += ((r0[0] * r0[0] + r0[1] * r0[1]) + (r0[2] * r0[2] + r0[3] * r0[3])) + ((r1[0] * r1[0] + r1[1] * r1[1]) + (r1[2] * r1[2] + r1[3] * r1[3]));
                    if (outb) { u32x4 w; w.x = cvt_pk_bf16(r0[0], r0[1]); w.y = cvt_pk_bf16(r0[2], r0[3]); w.z = cvt_pk_bf16(r1[0], r1[1]); w.w = cvt_pk_bf16(r1[2], r1[3]); st16(outb + o2, w, wt); }
                    if (outq) { u32x2 w; w.x = qi8 ? q4_i8(r0[0], r0[1], r0[2], r0[3], qs) : pk4_fp8(r0[0], r0[1], r0[2], r0[3]); w.y = qi8 ? q4_i8(r1[0], r1[1], r1[2], r1[3], qs) : pk4_fp8(r1[0], r1[1], r1[2], r1[3]); st8(outq + o2, w, wt); } }
                if (ss) { rs = sum_rows4(rs); if (fq == 0) { const unsigned hi_ = (unsigned)rs; const unsigned lo_ = (unsigned)((rs - (float)hi_) * 4294967296.0f);
                        __hip_atomic_fetch_add(ss + row, ((unsigned long long)hi_ << 32) | lo_, __ATOMIC_RELAXED, __HIP_MEMORY_SCOPE_AGENT); } } }
            asm volatile("" ::: "memory"); }
    }
};


template <class Epi, class Sched, bool ALIGN_EPI, bool SP2, int ES = 2, bool I8 = false>
__device__ __forceinline__ void gemm_phase(LAS unsigned char* lds, const int K, const int LD, const Sched& S, const Epi& E, const int wscale = 0x7f7f7f7f) {
    int tid_ = threadIdx.x; asm volatile("" : "+v"(tid_));
    const int tid = tid_, wid = __builtin_amdgcn_readfirstlane(tid >> 6), lane = tid & 63, wr = wid >> 2, wc = wid & 3, fr = lane & 15, fq = lane >> 4;
    const int nt = K * ES / (BK * 2);
    constexpr bool GATH = Sched::GATHER;
    const size_t kstep = (size_t)(BK * 2);
    const size_t hstep = (size_t)HALF * LD * ES;
    unsigned voffB[2]; unsigned vA[2][2], vAn[2][2]; int RA[2]; unsigned CA2[2];
#pragma unroll
    for (int i = 0; i < 2; ++i) { int R, C; stage_rc(tid * 16 + i * 8192, R, C); const int Rb = Epi::PERM ? ((R & ~31) + perm32(R & 31)) : R;
        RA[i] = R; CA2[i] = (unsigned)C * 2u; voffB[i] = (unsigned)(Rb * LD * ES + C * 2);
        vA[0][i] = (unsigned)(R * LD * ES + C * 2); vA[1][i] = vA[0][i] + (unsigned)hstep; vAn[0][i] = vA[0][i]; vAn[1][i] = vA[1][i]; }
    const unsigned ldsw = (unsigned)wid * 1024u;
    int aoffk[2], boffk[2];
#pragma unroll
    for (int k = 0; k < 2; ++k) { aoffk[k] = lds_byte(wr * 64 + fr, 32 * k + 8 * fq); boffk[k] = lds_byte(wc * 32 + fr, 32 * k + 8 * fq); }
#define PG8_SA(b, h) (((b) * 2 + (h)) * HTB)
#define PG8_SB(b, h) ((4 + (b) * 2 + (h)) * HTB)
#define PG8_STAGE2(bufoff, gbase, o0, o1) do { \
        __builtin_amdgcn_global_load_lds((const unsigned*)((const char*)(gbase) + (o0)), (LAS unsigned*)(lds + (bufoff) + ldsw), 16, 0, 0); \
        __builtin_amdgcn_global_load_lds((const unsigned*)((const char*)(gbase) + (o1)), (LAS unsigned*)(lds + (bufoff) + ldsw + 8192), 16, 0, 0); } while (0)
#define PG8_STAGEB(bufoff, gbase) PG8_STAGE2(bufoff, gbase, voffB[0], voffB[1])
#define PG8_STAGEA(bufoff, gbase, h) PG8_STAGE2(bufoff, gbase, vA[h][0], vA[h][1])
#define PG8_STAGEAX(bufoff, gbase, h, nx) PG8_STAGE2(bufoff, gbase, ((nx) ? vAn[h][0] : vA[h][0]), ((nx) ? vAn[h][1] : vA[h][1]))
#define PG8_LDA(dst, b, h) do { _Pragma("unroll") for (int m = 0; m < 4; ++m) { const i32x4 l_ = *(const LAS i32x4*)(lds + PG8_SA(b, h) + aoffk[0] + m * 2048), h_ = *(const LAS i32x4*)(lds + PG8_SA(b, h) + aoffk[1] + m * 2048); \
        if constexpr (ES == 1 && !I8) dst##8[m] = __builtin_shufflevector(l_, h_, 0, 1, 2, 3, 4, 5, 6, 7); else { dst##4[m][0] = l_; dst##4[m][1] = h_; } } } while (0)
#define PG8_LDB(dst, b, h) do { _Pragma("unroll") for (int n = 0; n < 2; ++n) { const i32x4 l_ = *(const LAS i32x4*)(lds + PG8_SB(b, h) + boffk[0] + n * 2048), h_ = *(const LAS i32x4*)(lds + PG8_SB(b, h) + boffk[1] + n * 2048); \
        if constexpr (ES == 1 && !I8) dst##8[n] = __builtin_shufflevector(l_, h_, 0, 1, 2, 3, 4, 5, 6, 7); else { dst##4[n][0] = l_; dst##4[n][1] = h_; } } } while (0)
#define PG8_MMA(ai, bj, At, Bt) do { __builtin_amdgcn_s_setprio(1); _Pragma("unroll") for (int m = 0; m < 4; ++m) _Pragma("unroll") for (int n = 0; n < 2; ++n) { \
        if constexpr (ES == 2) { _Pragma("unroll") for (int k = 0; k < 2; ++k) \
            acc[ai][bj][m][n] = __builtin_amdgcn_mfma_f32_16x16x32_bf16(__builtin_bit_cast(bf16x8, Bt##4[n][k]), __builtin_bit_cast(bf16x8, At##4[m][k]), acc[ai][bj][m][n], 0, 0, 0); } \
        else if constexpr (I8) { i32x4 c_ = __builtin_bit_cast(i32x4, acc[ai][bj][m][n]); \
            _Pragma("unroll") for (int k = 0; k < 2; ++k) c_ = __builtin_amdgcn_mfma_i32_16x16x64_i8(Bt##4[n][k], At##4[m][k], c_, 0, 0, 0); \
            acc[ai][bj][m][n] = __builtin_bit_cast(f32x4, c_); } \
        else { asm volatile("v_mfma_scale_f32_16x16x128_f8f6f4 %0, %1, %2, %0, %3, %4 op_sel_hi:[0,0,0]" : "+v"(acc[ai][bj][m][n]) : "v"(Bt##8[n]), "v"(At##8[m]), "v"(wsc_), "v"(one_)); } } \
        __builtin_amdgcn_s_setprio(0); } while (0)
#define PG8_WAIT_V(n) asm volatile("s_waitcnt vmcnt(" #n ")" ::: "memory")
#define PG8_WAIT_L(n) asm volatile("s_waitcnt lgkmcnt(" #n ")" ::: "memory")
#define PG8_BAR __builtin_amdgcn_s_barrier()
#define PG8_SCHED __builtin_amdgcn_sched_barrier(0)
    Unit cur, nxt; int ui = 0;
    if (!S.next(0, cur)) return;
    f32x4 acc[2][2][4][2];
#pragma unroll
    for (int a = 0; a < 2; ++a)
#pragma unroll
        for (int b = 0; b < 2; ++b)
#pragma unroll
            for (int m = 0; m < 4; ++m)
#pragma unroll
                for (int n = 0; n < 2; ++n) { acc[a][b][m][n] = (f32x4){0.f, 0.f, 0.f, 0.f}; if constexpr (ES == 1) asm volatile("" : "+v"(acc[a][b][m][n])); }
    int wsc_ = wscale, one_ = 0x7f7f7f7f; asm volatile("" : "+v"(wsc_), "+v"(one_));
    i32x4 At4[4][2], B04[2][2], B14[2][2];
    i32x8 At8[4], B08[2], B18[2];
    const char* cA = S.a_base(cur); const char* cB = S.b_base(cur);
    constexpr bool RS = Epi::ROWSCALE && !GATH;
    LAS float* rstab = (LAS float*)(lds + RS_TAB_OFF); RsRaw2 rsraw; rsraw.a.f = 0.f; rsraw.a.q = 0ull; rsraw.b = rsraw.a;
    constexpr bool CS = Epi::COLSCALE && !GATH;
    LAS float* cstab = (LAS float*)(lds + CS_TAB_OFF); float csraw = 0.f;
    if constexpr (CS) { if (tid >= 256) cstab[tid - 256] = E.cs_load(cur, tid - 256); }
    if constexpr (RS) { if (tid < 256) rstab[tid] = E.rs_finish(E.rs_load(cur.pm * BM + tid)); }
    if constexpr (GATH) { S.rows(cur, RA, 0, vA);
#pragma unroll
        for (int h = 0; h < 2; ++h)
#pragma unroll
            for (int i = 0; i < 2; ++i) vA[h][i] += CA2[i]; }
    if constexpr (SP2) {
        PG8_STAGEB(PG8_SB(0, 0), cB); PG8_STAGEB(PG8_SB(0, 1), cB + hstep); PG8_STAGEA(PG8_SA(0, 0), cA, 0); PG8_STAGEA(PG8_SA(0, 1), cA, 1);
        if (wr == 1) PG8_BAR;
        PG8_WAIT_V(2); PG8_BAR;
        PG8_STAGEB(PG8_SB(1, 0), cB + kstep); PG8_STAGEA(PG8_SA(1, 0), cA + kstep, 0); PG8_STAGEB(PG8_SB(1, 1), cB + hstep + kstep);
        PG8_WAIT_V(6); PG8_BAR;
    } else {
        PG8_STAGEB(PG8_SB(0, 0), cB); PG8_STAGEA(PG8_SA(0, 0), cA, 0); PG8_STAGEB(PG8_SB(0, 1), cB + hstep); PG8_STAGEA(PG8_SA(0, 1), cA, 1);
        if (wr == 1) PG8_BAR;
        PG8_WAIT_V(4); PG8_BAR;
        PG8_STAGEB(PG8_SB(1, 0), cB + kstep); PG8_STAGEA(PG8_SA(1, 0), cA + kstep, 0); PG8_STAGEB(PG8_SB(1, 1), cB + hstep + kstep);
        PG8_WAIT_V(6); PG8_BAR;
    }
    for (;;) {
        const bool has_next = S.next(ui + 1, nxt);
        const char* nA = has_next ? S.a_base(nxt) : cA; const char* nB = has_next ? S.b_base(nxt) : cB;
        if constexpr (GATH) { if (has_next) { S.rows(nxt, RA, ui + 1, vAn);
#pragma unroll
                for (int h = 0; h < 2; ++h)
#pragma unroll
                    for (int i = 0; i < 2; ++i) vAn[h][i] += CA2[i]; } else {
#pragma unroll
                for (int h = 0; h < 2; ++h)
#pragma unroll
                    for (int i = 0; i < 2; ++i) vAn[h][i] = vA[h][i]; } }
        for (int t = 0; t < nt; t += 2) {
            const bool last = (t == nt - 2);
            const char* a1 = cA + (size_t)(t + 1) * kstep;
            const char* a2 = last ? nA : cA + (size_t)(t + 2) * kstep; const char* b2 = last ? nB : cB + (size_t)(t + 2) * kstep;
            const char* a3 = a2 + kstep; const char* b3 = b2 + kstep;
            const bool nx = GATH && last;
            if constexpr (SP2) {
            PG8_LDB(B0, 0, 0); PG8_LDB(B1, 0, 1); PG8_SCHED; PG8_LDA(At, 0, 0); PG8_STAGEA(PG8_SA(1, 1), a1, 1);
            PG8_WAIT_V(8); PG8_WAIT_L(0); PG8_BAR; PG8_MMA(0, 0, At, B0); PG8_MMA(0, 1, At, B1); PG8_BAR; PG8_SCHED;
            PG8_LDA(At, 0, 1); PG8_STAGEB(PG8_SB(0, 0), b2); PG8_STAGEB(PG8_SB(0, 1), b2 + hstep); PG8_STAGEAX(PG8_SA(0, 0), a2, 0, nx);
            PG8_WAIT_V(8); PG8_WAIT_L(0); PG8_BAR; PG8_MMA(1, 0, At, B0); PG8_MMA(1, 1, At, B1); PG8_BAR; PG8_SCHED;
            PG8_LDB(B0, 1, 0); PG8_LDB(B1, 1, 1); PG8_SCHED; PG8_LDA(At, 1, 0); PG8_STAGEAX(PG8_SA(0, 1), a2, 1, nx);
            PG8_WAIT_V(8); PG8_WAIT_L(0); PG8_BAR; PG8_MMA(0, 0, At, B0); PG8_MMA(0, 1, At, B1); PG8_BAR; PG8_SCHED;
            PG8_LDA(At, 1, 1); PG8_STAGEB(PG8_SB(1, 0), b3); PG8_STAGEB(PG8_SB(1, 1), b3 + hstep); PG8_STAGEAX(PG8_SA(1, 0), a3, 0, nx);
            PG8_WAIT_V(8); PG8_WAIT_L(0); PG8_BAR; PG8_MMA(1, 0, At, B0); PG8_MMA(1, 1, At, B1); PG8_BAR; PG8_SCHED;
            } else {
            PG8_LDB(B0, 0, 0); PG8_SCHED; PG8_LDA(At, 0, 0); PG8_STAGEA(PG8_SA(1, 1), a1, 1);
            PG8_WAIT_L(8); PG8_BAR; PG8_WAIT_L(0); PG8_MMA(0, 0, At, B0); PG8_BAR; PG8_SCHED;
            PG8_LDB(B1, 0, 1); PG8_STAGEB(PG8_SB(0, 0), b2);
            PG8_BAR; PG8_WAIT_L(0); PG8_MMA(0, 1, At, B1); PG8_BAR;
            PG8_LDA(At, 0, 1); PG8_STAGEAX(PG8_SA(0, 0), a2, 0, nx);
            PG8_BAR; PG8_WAIT_L(0); PG8_MMA(1, 0, At, B0); PG8_BAR; PG8_SCHED;
            PG8_STAGEB(PG8_SB(0, 1), b2 + hstep);
            PG8_WAIT_V(6); PG8_BAR; PG8_MMA(1, 1, At, B1); PG8_BAR;
            PG8_LDB(B0, 1, 0); PG8_SCHED; PG8_LDA(At, 1, 0); PG8_STAGEAX(PG8_SA(0, 1), a2, 1, nx);
            PG8_WAIT_L(8); PG8_BAR; PG8_WAIT_L(0); PG8_MMA(0, 0, At, B0); PG8_BAR; PG8_SCHED;
            PG8_LDB(B1, 1, 1); PG8_STAGEB(PG8_SB(1, 0), b3);
            PG8_BAR; PG8_WAIT_L(0); PG8_MMA(0, 1, At, B1); PG8_BAR;
            PG8_LDA(At, 1, 1); PG8_STAGEAX(PG8_SA(1, 0), a3, 0, nx);
            PG8_BAR; PG8_WAIT_L(0); PG8_MMA(1, 0, At, B0); PG8_BAR; PG8_SCHED;
            PG8_STAGEB(PG8_SB(1, 1), b3 + hstep);
            PG8_WAIT_V(6); PG8_BAR; PG8_MMA(1, 1, At, B1); PG8_BAR;
            }
        }
        if constexpr (ALIGN_EPI) { if (wr == 0) PG8_BAR; }
        if constexpr (ES == 1 && !I8) asm volatile("s_nop 15\n\ts_nop 15" ::: "memory");
        if constexpr (RS) { if (has_next && tid < 256) rsraw = E.rs_load(nxt.pm * BM + tid); }
        if constexpr (CS) { if (has_next && tid >= 256) csraw = E.cs_load(nxt, tid - 256); }
        const bool wt = !has_next;
        if constexpr (CS) E(acc, cur, wr, wc, fr, fq, rstab + (ui & 1) * 256, cstab + (ui & 1) * 256, wt); else if constexpr (RS) E(acc, cur, wr, wc, fr, fq, rstab + (ui & 1) * 256, wt); else E(acc, cur, wr, wc, fr, fq, nullptr, wt);
        if (!has_next) break;
        if constexpr (RS) { if (tid < 256) rstab[((ui + 1) & 1) * 256 + tid] = E.rs_finish(rsraw); }
        if constexpr (CS) { if (tid >= 256) cstab[((ui + 1) & 1) * 256 + tid - 256] = csraw; }
#pragma unroll
        for (int a = 0; a < 2; ++a)
#pragma unroll
            for (int b = 0; b < 2; ++b)
#pragma unroll
                for (int m = 0; m < 4; ++m)
#pragma unroll
                    for (int n = 0; n < 2; ++n) { acc[a][b][m][n] = (f32x4){0.f, 0.f, 0.f, 0.f}; if constexpr (ES == 1) asm volatile("" : "+v"(acc[a][b][m][n])); }
        cur = nxt; cA = nA; cB = nB; ++ui;
        if constexpr (GATH) {
#pragma unroll
            for (int h = 0; h < 2; ++h)
#pragma unroll
                for (int i = 0; i < 2; ++i) vA[h][i] = vAn[h][i]; }
        if constexpr (ALIGN_EPI) { if (wr == 1) PG8_BAR; }
    }
    PG8_WAIT_V(0);
    if constexpr (!ALIGN_EPI) { if (wr == 0) PG8_BAR; }
    PG8_BAR;
#undef PG8_SA
#undef PG8_SB
#undef PG8_STAGE2
#undef PG8_STAGEA
#undef PG8_STAGEAX
#undef PG8_STAGEB
#undef PG8_LDA
#undef PG8_LDB
#undef PG8_MMA
#undef PG8_WAIT_V
#undef PG8_WAIT_L
#undef PG8_BAR
#undef PG8_SCHED
}
}
#ifndef BF16_RESID
#define BF16_RESID 1
#endif
#ifndef FFN_DN_FP8
#define FFN_DN_FP8 0
#endif
#ifndef IN_O_I8
#define IN_O_I8 2
#endif
#ifndef FFN_UP_I8
#define FFN_UP_I8 1
#endif
#ifndef FFN_UP_FP8
#define FFN_UP_FP8 0
#endif
namespace fk {
constexpr int NWAVES = 8, NTHR = 512;
constexpr int T = 16384, D = 1024, SEQ = 4096, NBATCH = 4;
constexpr int EIN = 2568, OIN = 3088, DFF = 2816, DFE = 3584, NE = 8;
constexpr float EPS = 1e-6f;
constexpr float LOG2E = 1.4426950408889634f;
constexpr float C2 = 0.125f * LOG2E;
constexpr float GLA_QS = 0.08838834764831845f;

constexpr size_t MiB = 1u << 20;
constexpr size_t WS_CTL = 0, CTL_ZERO_BYTES = 2 * MiB;
constexpr int CW_TMO = 0, CW_CODE = 1;
constexpr int CW_BAR = 4096;
constexpr int CW_SPLIT = 8448;
constexpr int CW_CNT = 12288;
constexpr size_t CTL_WMAXE = 1664 * 1024;
constexpr size_t CTL_WMAXO = 1600 * 1024;
constexpr size_t CTL_WMAX = 1536 * 1024;
constexpr size_t CTL_SS = 1 * MiB;
constexpr size_t WS_HB8E = 538 * MiB;
constexpr size_t WS_H = 66 * MiB, WS_HB = 130 * MiB, WS_HB8 = 394 * MiB, WS_HB8O = 492 * MiB;
constexpr size_t WS_WINE = 162 * MiB, WS_WOUTE = 172 * MiB, WS_W13F = 176 * MiB, WS_W2F = 198 * MiB, WS_WINO = 209 * MiB, WS_WOUTO = 221 * MiB, WS_SMALL = 225 * MiB;
constexpr size_t SM_WLR = 0, SM_GAT = 128 * 1024, SM_GXT = 256 * 1024, SM_SSA = 384 * 1024;
constexpr size_t SM_KMAX = 600 * 1024;
constexpr size_t SM_STEPE = 448 * 1024;
constexpr size_t SM_STEPO = 640 * 1024;
constexpr size_t SM_SSF = 512 * 1024;
constexpr size_t W13E_PAIR = 56 * MiB;
constexpr size_t WS_W13E = 226 * MiB, WS_W2E = 338 * MiB;
constexpr size_t WS_ACT = 394 * MiB;
constexpr size_t WS_XR = 394 * MiB, WS_YR = 410 * MiB, WS_Q = 426 * MiB, WS_K = 442 * MiB, WS_V = 458 * MiB, WS_YLG = 474 * MiB, WS_PG = 490 * MiB, WS_Y = 506 * MiB, WS_HF = 538 * MiB, WS_ESM = 626 * MiB;
constexpr size_t ES_FLOG = 0, ES_CP = 512 * 1024, ES_AGG = 1024 * 1024;
constexpr size_t WS_GQ = 394 * MiB, WS_GK = 410 * MiB, WS_GV = 426 * MiB, WS_GG = 458 * MiB, WS_LR = 490 * MiB, WS_DEC = 491 * MiB, WS_KVT = 492 * MiB, WS_SNT = 556 * MiB;
constexpr size_t WS_OG = 652 * MiB, WS_XN = 684 * MiB, WS_RT = 716 * MiB, WS_YM = 718 * MiB, WS_HM = 394 * MiB, WS_YM1 = 632 * MiB;
constexpr size_t RT_TS = 0, RT_TW = 128 * 1024, RT_TL = 256 * 1024;
constexpr size_t WS_END = 840 * MiB;
static_assert(WS_YM + (size_t)34816 * 1024 * 2 <= WS_END && WS_HM + (size_t)34816 * 3584 * 2 <= WS_OG, "ws map");

constexpr int LDS_BYTES = 153600;
constexpr int RING_BYTES = 131072, MISC_OFF = 147456; static_assert(pg8::RS_TAB_OFF == MISC_OFF + 2048 && pg8::CS_TAB_OFF == pg8::RS_TAB_OFF + 2048 && pg8::CS_TAB_OFF + 2048 == LDS_BYTES, "row-scale table");

#ifndef PROBE_PHASE
#define PROBE_PHASE -1
#endif
#ifndef NT_LOADS
#define NT_LOADS 1
#endif
#ifndef P0_SPLIT
#define P0_SPLIT 1
#endif
#ifndef P0_STREAM
#define P0_STREAM (!FFN_DN_FP8)
#endif
#ifndef CQ_LOCAL
#define CQ_LOCAL 1
#endif
#ifndef E1_I8
#define E1_I8 1
#endif
struct Args { const float* in[26]; float* out; unsigned char* ws; int ph_lo, ph_hi, p0sub, pad; };

struct Frame {
    LAS unsigned char* lds; volatile LAS unsigned* MISC; gu32* ctl; unsigned char* ws;
    int tid, lane, wave, vcu, G;
};

constexpr float W13_MUL = 64.f, W2_MUL = 256.f; constexpr int W13_SCALE = 0x79797979, W2_SCALE = 0x77777777;
__device__ __forceinline__ unsigned f2bf(float f) { unsigned u = __builtin_bit_cast(unsigned, f); return (u + 0x7fffu + ((u >> 16) & 1u)) >> 16; }
__device__ __forceinline__ unsigned pk2(float lo, float hi) { return f2bf(lo) | (f2bf(hi) << 16); }

struct TrReg { float v[64]; };
template <bool HASG> __device__ __forceinline__ void transpose_load(TrReg& t, const float* W, int ldw, int c0, const float* g, int kb, int nb, int lane) {
    const float* p = W + (size_t)(128 * kb) * ldw + c0 + 32 * nb;
    const int lo = (lane >> 5) * ldw + (lane & 31);
#pragma unroll
    for (int i = 0; i < 64; ++i) { float v = NT_LOADS ? __builtin_nontemporal_load(&(p + (size_t)(2 * i) * ldw)[lo]) : (p + (size_t)(2 * i) * ldw)[lo]; if (HASG) v *= g[128 * kb + 2 * i + (lane >> 5)]; t.v[i] = v; }
}
template <int MODE, bool F8> __device__ __forceinline__ void transpose_store(const TrReg& t, int K, void* WTv, int half, LAS float* scr, int kb, int nb, int lane, float wmul, const unsigned* wmax = nullptr, const float* qsl = nullptr) {
    const int k0 = 128 * kb, n0 = 32 * nb;
#pragma unroll
    for (int i = 0; i < 64; ++i) scr[(2 * i + (lane >> 5)) * 33 + (lane & 31)] = t.v[i];
    LDS_WAIT(); asm volatile("" ::: "memory");
    const int c = lane & 7;
#pragma unroll
    for (int j = 0; j < 4; ++j) { const int n = (lane >> 3) + 8 * j; const LAS float* s = scr + (16 * c) * 33 + n;
        const int col = n0 + n; const int orow = MODE == 0 ? col : (256 * (col >> 7) + 128 * half + (col & 127));
        float v[16];
#pragma unroll
        for (int e = 0; e < 16; ++e) v[e] = s[e * 33] * wmul;
        if (wmax || qsl) { float qs; if (qsl) qs = qsl[j]; else { const float mx = __uint_as_float(wmax[orow]); qs = mx > 0.f ? 127.0f / mx : 0.f; }
            u32x4 o; o.x = pg8::q4_i8(v[0], v[1], v[2], v[3], qs); o.y = pg8::q4_i8(v[4], v[5], v[6], v[7], qs); o.z = pg8::q4_i8(v[8], v[9], v[10], v[11], qs); o.w = pg8::q4_i8(v[12], v[13], v[14], v[15], qs);
            *(GAS u32x4*)((unsigned char*)WTv + (size_t)orow * K + k0 + 16 * c) = o; }
        else if constexpr (F8) { u32x4 o; o.x = pg8::pk4_fp8(v[0], v[1], v[2], v[3]); o.y = pg8::pk4_fp8(v[4], v[5], v[6], v[7]); o.z = pg8::pk4_fp8(v[8], v[9], v[10], v[11]); o.w = pg8::pk4_fp8(v[12], v[13], v[14], v[15]);
            *(GAS u32x4*)((unsigned char*)WTv + (size_t)orow * K + k0 + 16 * c) = o; }
        else { bf16_t* WT = (bf16_t*)WTv; u32x4 o0, o1; o0.x = cvt_pk_bf16(v[0], v[1]); o0.y = cvt_pk_bf16(v[2], v[3]); o0.z = cvt_pk_bf16(v[4], v[5]); o0.w = cvt_pk_bf16(v[6], v[7]);
            o1.x = cvt_pk_bf16(v[8], v[9]); o1.y = cvt_pk_bf16(v[10], v[11]); o1.z = cvt_pk_bf16(v[12], v[13]); o1.w = cvt_pk_bf16(v[14], v[15]);
            *(GAS u32x4*)(WT + (size_t)orow * K + k0 + 16 * c) = o0; *(GAS u32x4*)(WT + (size_t)orow * K + k0 + 16 * c + 8) = o1; } }
    LDS_WAIT(); asm volatile("" ::: "memory");
}
template <int MODE, bool F8 = false> __device__ __forceinline__ void convert_matrix(Frame& F, const float* W, int K, int ldw, int c0, int ncols, const float* g, void* WT, int half, int& itbase, float wmul = 1.f, const unsigned* wmax = nullptr) {
    LAS float* scr = (LAS float*)(F.lds + F.wave * 16896);
    const int gw = F.vcu * NWAVES + F.wave, NGW = F.G * NWAVES; const int nblk = ncols / 32, nit = (K / 128) * nblk;
    int it = (gw - (itbase % NGW) + NGW) % NGW;
    itbase += nit;
    if (it >= nit) return;
    TrReg r0, r1;
    auto LOADI = [&](TrReg& t, int i_) { if (g) transpose_load<true>(t, W, ldw, c0, g, i_ / nblk, i_ % nblk, F.lane); else transpose_load<false>(t, W, ldw, c0, g, i_ / nblk, i_ % nblk, F.lane); };
    LOADI(r0, it);
    for (;;) {
        if (it + NGW < nit) LOADI(r1, it + NGW);
        transpose_store<MODE, F8>(r0, K, WT, half, scr, it / nblk, it % nblk, F.lane, wmul, wmax);
        it += NGW; if (it >= nit) break;
        r0 = r1;
    }
}
template <int MODE> __device__ __forceinline__ void colmax_matrix(Frame& F, const float* W, int K, int ldw, int ncols, const float* g, unsigned* wmax, int half, int& itbase) {
    const int gw = F.vcu * NWAVES + F.wave, NGW = F.G * NWAVES; const int nblk = ncols / 32, nit = (K / 128) * nblk;
    int it = (gw - (itbase % NGW) + NGW) % NGW; itbase += nit;
    for (; it < nit; it += NGW) { TrReg r; transpose_load<true>(r, W, ldw, 0, g, it / nblk, it % nblk, F.lane); float m = 0.f;
#pragma unroll
        for (int i = 0; i < 64; ++i) m = fmaxf(m, fabsf(r.v[i]));
        m = fmaxf(m, __shfl_xor(m, 32));
        if (F.lane < 32) { const int col = 32 * (it % nblk) + F.lane; const int orow = MODE == 0 ? col : (256 * (col >> 7) + 128 * half + (col & 127)); atomicMax(wmax + orow, __float_as_uint(m)); } }
}

struct CqTask { const float* W; const float* g; unsigned char* WT; unsigned* wmax; int ldw, nb, half, mode; };
constexpr int CQ_WINE = 2 * 80, CQ_W13 = 2 * 2 * 88, CQ_WINO = (IN_O_I8 ? 2 * 96 : 0), CQ_TASKS = CQ_WINE + CQ_W13 + CQ_WINO;
__device__ __forceinline__ CqTask cq_decode(const Args& a, unsigned char* ws, int t) {
    CqTask c;
    if (t < CQ_WINE) { const int j = t / 80; c.nb = t % 80; c.W = a.in[4] + (size_t)j * D * EIN; c.ldw = EIN; c.g = a.in[1] + (2 * j) * D; c.WT = ws + WS_WINE + (size_t)j * 2560 * D; c.wmax = (unsigned*)(ws + CTL_WMAXE) + j * 2560; c.half = 0; c.mode = 0; }
    else if (t < CQ_WINE + CQ_W13) { const int q = t - CQ_WINE, j = q / 176, r = q % 176; c.half = r / 88; c.nb = r % 88; c.W = a.in[14 + c.half] + (size_t)j * D * DFF; c.ldw = DFF; c.g = a.in[2] + (2 * j) * D;
        c.WT = ws + WS_W13F + (size_t)j * 2 * DFF * D; c.wmax = (unsigned*)(ws + CTL_WMAX) + j * 2 * DFF; c.mode = 1; }
    else { const int q = t - CQ_WINE - CQ_W13, j = q / 96; c.nb = q % 96; c.W = a.in[17] + (size_t)j * D * OIN; c.ldw = OIN; c.g = a.in[1] + (2 * j + 1) * D; c.WT = ws + WS_WINO + (size_t)j * 3072 * D; c.wmax = (unsigned*)(ws + CTL_WMAXO) + j * 3072; c.half = 0; c.mode = 0; }
    return c;
}
template <int MODE> __device__ __forceinline__ void colquant_block(Frame& F, const Args& a, int t, int tnext, TrReg& r) {
    LAS float* scr = (LAS float*)(F.lds + F.wave * 16896); LAS float* mxs = (LAS float*)(F.lds + 8 * 16896);
    const CqTask c = cq_decode(a, F.ws, t); int lane_ = F.lane; asm volatile("" : "+v"(lane_)); const int lane = lane_; const int kb = F.wave, cc = lane & 7;
    f32x4 gk[4];
#pragma unroll
    for (int q = 0; q < 4; ++q) gk[q] = *(const GAS f32x4*)(c.g + 128 * kb + 16 * cc + 4 * q);
#pragma unroll
    for (int i = 0; i < 64; ++i) scr[(2 * i + (lane >> 5)) * 33 + (lane & 31)] = r.v[i];
    LDS_WAIT(); asm volatile("" ::: "memory");
    if (tnext >= 0) { const CqTask cn = cq_decode(a, F.ws, tnext); transpose_load<false>(r, cn.W, cn.ldw, 0, nullptr, kb, cn.nb, lane); }
    float v[4][16];
#pragma unroll
    for (int j = 0; j < 4; ++j) { const int n = (lane >> 3) + 8 * j; const LAS float* sp = scr + (16 * cc) * 33 + n; float m = 0.f;
#pragma unroll
        for (int e = 0; e < 16; ++e) { const float x = sp[e * 33] * gk[e >> 2][e & 3]; v[j][e] = x; m = fmaxf(m, fabsf(x)); }
        m = fmaxf(m, __shfl_xor(m, 1)); m = fmaxf(m, __shfl_xor(m, 2)); m = fmaxf(m, __shfl_xor(m, 4));
        if (cc == 0) mxs[F.wave * 32 + n] = m; }
    __syncthreads();
#pragma unroll
    for (int j = 0; j < 4; ++j) { const int n = (lane >> 3) + 8 * j; float mx = 0.f;
#pragma unroll
        for (int w = 0; w < 8; ++w) mx = fmaxf(mx, mxs[w * 32 + n]);
        const float qs = mx > 0.f ? 127.0f / mx : 0.f;
        const int col = 32 * c.nb + n; const int orow = MODE == 0 ? col : (256 * (col >> 7) + 128 * c.half + (col & 127));
        if (F.wave == 0 && cc == 0) c.wmax[orow] = __float_as_uint(mx);
        u32x4 o; o.x = pg8::q4_i8(v[j][0], v[j][1], v[j][2], v[j][3], qs); o.y = pg8::q4_i8(v[j][4], v[j][5], v[j][6], v[j][7], qs); o.z = pg8::q4_i8(v[j][8], v[j][9], v[j][10], v[j][11], qs); o.w = pg8::q4_i8(v[j][12], v[j][13], v[j][14], v[j][15], qs);
        *(GAS u32x4*)(c.WT + (size_t)orow * D + 128 * kb + 16 * cc) = o; }
    __syncthreads();
}
__device__ __forceinline__ int cq_order(int q) { return q < CQ_W13 ? CQ_WINE + q : (q < CQ_W13 + CQ_WINE ? q - CQ_W13 : q); }
__device__ __forceinline__ int cq_pair_task(int jp, int q) { return q < 176 ? CQ_WINE + jp * 176 + q : (q < 256 ? jp * 80 + (q - 176) : CQ_WINE + CQ_W13 + jp * 96 + (q - 256)); }
__device__ __forceinline__ void colquant_pair(Frame& F, const Args& a, int jp, int qlo = 0, int qhi = 176 + 80 + (IN_O_I8 ? 96 : 0)) {
    const int NQ = qhi;
    int q = qlo + F.vcu; if (q >= NQ) return;
    TrReg r; { const CqTask c0 = cq_decode(a, F.ws, cq_pair_task(jp, q)); transpose_load<false>(r, c0.W, c0.ldw, 0, nullptr, F.wave, c0.nb, F.lane); }
    for (; q < NQ; q += F.G) { const int qn = q + F.G; const int tn = qn < NQ ? cq_pair_task(jp, qn) : -1;
        if (q < 176) colquant_block<1>(F, a, cq_pair_task(jp, q), tn, r); else colquant_block<0>(F, a, cq_pair_task(jp, q), tn, r); }
}
__device__ __forceinline__ void colquant_all(Frame& F, const Args& a) {
    int q = F.vcu; if (q >= CQ_TASKS) return;
    TrReg r; { const CqTask c0 = cq_decode(a, F.ws, cq_order(q)); transpose_load<false>(r, c0.W, c0.ldw, 0, nullptr, F.wave, c0.nb, F.lane); }
    for (; q < CQ_TASKS; q += F.G) { const int qn = q + F.G; const int tn = qn < CQ_TASKS ? cq_order(qn) : -1;
        if (q < CQ_W13) colquant_block<1>(F, a, cq_order(q), tn, r); else colquant_block<0>(F, a, cq_order(q), tn, r); }
}
__device__ __forceinline__ void quantize_wino(Frame& F, const Args& a, int j) {
    int itb = 0; convert_matrix<0, true>(F, a.in[17] + (size_t)j * D * OIN, D, OIN, 0, 3072, a.in[1] + (2 * j + 1) * D, (unsigned char*)(F.ws + WS_WINO) + (size_t)j * 3072 * D, 0, itb, 1.f, (const unsigned*)(F.ws + CTL_WMAXO) + j * 3072);
}
__device__ __forceinline__ void quantize_w13(Frame& F, const Args& a, int j) {
    int itb = 0; const unsigned* wm = (const unsigned*)(F.ws + CTL_WMAX) + j * 2 * DFF;
    convert_matrix<1, true>(F, a.in[14] + (size_t)j * D * DFF, D, DFF, 0, DFF, a.in[2] + (2 * j) * D, (unsigned char*)(F.ws + WS_W13F) + (size_t)j * 2 * DFF * D, 0, itb, 1.f, wm);
    convert_matrix<1, true>(F, a.in[15] + (size_t)j * D * DFF, D, DFF, 0, DFF, a.in[2] + (2 * j) * D, (unsigned char*)(F.ws + WS_W13F) + (size_t)j * 2 * DFF * D, 1, itb, 1.f, wm);
}
__device__ __forceinline__ void colmax_wine(Frame& F, const Args& a) {
    int itb = 0;
    for (int j = 0; j < 2; ++j) colmax_matrix<0>(F, a.in[4] + (size_t)j * D * EIN, D, EIN, 2560, a.in[1] + (2 * j) * D, (unsigned*)(F.ws + CTL_WMAXE) + j * 2560, 0, itb);
}
constexpr int CB_PER_PAIR = 256 + 704 + 256, CB_ITEMS = 2 * CB_PER_PAIR;
struct CbItem { const float* W; bf16_t* WT; int K, ldw, kb, nb; };
__device__ __forceinline__ CbItem cb_decode(const Args& a, unsigned char* ws, int g) {
    CbItem c; const int j = g / CB_PER_PAIR, r = g % CB_PER_PAIR; c.ldw = D;
    if (r < 256) { c.W = a.in[13] + (size_t)j * D * D; c.WT = (bf16_t*)(ws + WS_WOUTE) + (size_t)j * D * D; c.K = D; c.kb = r / 32; c.nb = r % 32; }
    else if (r < 960) { const int q = r - 256; c.W = a.in[16] + (size_t)j * DFF * D; c.WT = (bf16_t*)(ws + WS_W2F) + (size_t)j * D * DFF; c.K = DFF; c.kb = q / 32; c.nb = q % 32; }
    else { const int q = r - 960; c.W = a.in[21] + (size_t)j * D * D; c.WT = (bf16_t*)(ws + WS_WOUTO) + (size_t)j * D * D; c.K = D; c.kb = q / 32; c.nb = q % 32; }
    return c;
}
__device__ __forceinline__ void convert_bf16_pair(Frame& F, const Args& a, int jp, int lo = 0, int hi = CB_PER_PAIR) {
    LAS float* scr = (LAS float*)(F.lds + F.wave * 16896);
    const int nw = F.G * NWAVES;
    for (int li = lo + nw - 1 - (F.vcu * NWAVES + F.wave); li < hi; li += nw) { const CbItem c = cb_decode(a, F.ws, jp * CB_PER_PAIR + li); TrReg r;
        transpose_load<false>(r, c.W, c.ldw, 0, nullptr, c.kb, c.nb, F.lane); transpose_store<0, false>(r, c.K, c.WT, 0, scr, c.kb, c.nb, F.lane, 1.f); }
}
__device__ __forceinline__ void convert_bf16_stream(Frame& F, const Args& a) {
    LAS float* scr = (LAS float*)(F.lds + F.wave * 16896);
    const int nw = F.G * NWAVES; int g = nw - 1 - (F.vcu * NWAVES + F.wave); if (g >= CB_ITEMS) return;
    TrReg r0, r1; CbItem c0 = cb_decode(a, F.ws, g), c1 = c0;
    transpose_load<false>(r0, c0.W, c0.ldw, 0, nullptr, c0.kb, c0.nb, F.lane);
    for (;;) {
        const bool more = g + nw < CB_ITEMS;
        if (more) { c1 = cb_decode(a, F.ws, g + nw); transpose_load<false>(r1, c1.W, c1.ldw, 0, nullptr, c1.kb, c1.nb, F.lane); }
        transpose_store<0, false>(r0, c0.K, c0.WT, 0, scr, c0.kb, c0.nb, F.lane, 1.f);
        if (!more) break;
        g += nw; r0 = r1; c0 = c1;
    }
}
__device__ __forceinline__ void convert_dense(Frame& F, const Args& a) {
    int itb = 0;
#if P0_STREAM && P0_SPLIT == 2
    convert_bf16_pair(F, a, 0, 960, CB_PER_PAIR);
#elif P0_STREAM && P0_SPLIT
    convert_bf16_pair(F, a, 0);
#elif P0_STREAM
    convert_bf16_stream(F, a);
#endif
#if CQ_LOCAL
    if (PROBE_PHASE == 19 && blockIdx.x == 0 && threadIdx.x == 0) *(volatile unsigned long long*)(F.ws + WS_CTL + 2040 * 1024) = __builtin_amdgcn_s_memrealtime();
    if (P0_SPLIT == 2) colquant_pair(F, a, 0, 176); else if (P0_SPLIT) colquant_pair(F, a, 0); else colquant_all(F, a);
    if (PROBE_PHASE == 19 && blockIdx.x == 0 && threadIdx.x == 0) *(volatile unsigned long long*)(F.ws + WS_CTL + 2040 * 1024 + 8) = __builtin_amdgcn_s_memrealtime();
#endif
    for (int j = 0; j < 2; ++j) {
#if E1_I8 && CQ_LOCAL
#elif E1_I8
        convert_matrix<0, true>(F, a.in[4] + (size_t)j * D * EIN, D, EIN, 0, 2560, a.in[1] + (2 * j) * D, (unsigned char*)(F.ws + WS_WINE) + (size_t)j * 2560 * D, 0, itb, 1.f, (const unsigned*)(F.ws + CTL_WMAXE) + j * 2560);
#else
        convert_matrix<0>(F, a.in[4] + (size_t)j * D * EIN, D, EIN, 0, 2560, a.in[1] + (2 * j) * D, (bf16_t*)(F.ws + WS_WINE) + (size_t)j * 2560 * D, 0, itb);
#endif
#if !P0_STREAM
        convert_matrix<0>(F, a.in[13] + (size_t)j * D * D, D, D, 0, D, nullptr, (bf16_t*)(F.ws + WS_WOUTE) + (size_t)j * D * D, 0, itb);
#endif
#if FFN_UP_I8 && CQ_LOCAL
#elif FFN_UP_I8
        colmax_matrix<1>(F, a.in[14] + (size_t)j * D * DFF, D, DFF, DFF, a.in[2] + (2 * j) * D, (unsigned*)(F.ws + CTL_WMAX) + j * 2 * DFF, 0, itb);
        colmax_matrix<1>(F, a.in[15] + (size_t)j * D * DFF, D, DFF, DFF, a.in[2] + (2 * j) * D, (unsigned*)(F.ws + CTL_WMAX) + j * 2 * DFF, 1, itb);
#elif FFN_UP_FP8
        convert_matrix<1, true>(F, a.in[14] + (size_t)j * D * DFF, D, DFF, 0, DFF, a.in[2] + (2 * j) * D, (unsigned char*)(F.ws + WS_W13F) + (size_t)j * 2 * DFF * D, 0, itb, W13_MUL);
        convert_matrix<1, true>(F, a.in[15] + (size_t)j * D * DFF, D, DFF, 0, DFF, a.in[2] + (2 * j) * D, (unsigned char*)(F.ws + WS_W13F) + (size_t)j * 2 * DFF * D, 1, itb, W13_MUL);
#else
        convert_matrix<1>(F, a.in[14] + (size_t)j * D * DFF, D, DFF, 0, DFF, a.in[2] + (2 * j) * D, (bf16_t*)(F.ws + WS_W13F) + (size_t)j * 2 * DFF * D, 0, itb);
        convert_matrix<1>(F, a.in[15] + (size_t)j * D * DFF, D, DFF, 0, DFF, a.in[2] + (2 * j) * D, (bf16_t*)(F.ws + WS_W13F) + (size_t)j * 2 * DFF * D, 1, itb);
#endif
#if FFN_DN_FP8
        convert_matrix<0, true>(F, a.in[16] + (size_t)j * DFF * D, DFF, D, 0, D, nullptr, (unsigned char*)(F.ws + WS_W2F) + (size_t)j * D * DFF, 0, itb, W2_MUL);
#else
#if !P0_STREAM
        convert_matrix<0>(F, a.in[16] + (size_t)j * DFF * D, DFF, D, 0, D, nullptr, (bf16_t*)(F.ws + WS_W2F) + (size_t)j * D * DFF, 0, itb);
#endif
#endif
#if IN_O_I8 && CQ_LOCAL
#elif IN_O_I8
        colmax_matrix<0>(F, a.in[17] + (size_t)j * D * OIN, D, OIN, 3072, a.in[1] + (2 * j + 1) * D, (unsigned*)(F.ws + CTL_WMAXO) + j * 3072, 0, itb);
#else
        convert_matrix<0>(F, a.in[17] + (size_t)j * D * OIN, D, OIN, 0, 3072, a.in[1] + (2 * j + 1) * D, (bf16_t*)(F.ws + WS_WINO) + (size_t)j * 3072 * D, 0, itb);
#endif
#if !P0_STREAM
        convert_matrix<0>(F, a.in[21] + (size_t)j * D * D, D, D, 0, D, nullptr, (bf16_t*)(F.ws + WS_WOUTO) + (size_t)j * D * D, 0, itb);
#endif
    }
    const int gt = (F.vcu * NTHR + F.tid), NT_ = F.G * NTHR;
    for (int idx = gt; idx < 2 * 16 * 1024; idx += NT_) { const int j = idx >> 14, c = (idx >> 10) & 15, k = idx & 1023;
        ((bf16_t*)(F.ws + WS_SMALL + SM_WLR))[idx] = (bf16_t)f2bf(a.in[17][(size_t)j * D * OIN + (size_t)k * OIN + 3072 + c] * a.in[1][(2 * j + 1) * D + k]); }
    for (int idx = gt; idx < 2 * 8 * 64 * 64; idx += NT_) { const int jn = idx >> 12, jj = (idx >> 6) & 63, i = idx & 63;
        ((bf16_t*)(F.ws + WS_SMALL + SM_GAT))[idx] = (bf16_t)f2bf(a.in[7][(size_t)jn * 4096 + i * 64 + jj]);
        ((bf16_t*)(F.ws + WS_SMALL + SM_GXT))[idx] = (bf16_t)f2bf(a.in[9][(size_t)jn * 4096 + i * 64 + jj]); }
}
constexpr int CV_PER_MAT = 896, CV_W13 = NE * 2 * CV_PER_MAT  , CV_ITEMS = NE * 3 * CV_PER_MAT;
struct CvItem { const float* W; unsigned char* WT; int K, ldw, kb, nb, half, mode; float mul; };
__device__ __forceinline__ CvItem cv_decode(const Args& a, unsigned char* ws, int j, int g) {
    CvItem c;
    if (g < CV_W13) { const int e = g / (2 * CV_PER_MAT), r = g % (2 * CV_PER_MAT), mat = r / CV_PER_MAT, it = r % CV_PER_MAT; const size_t eo = (size_t)j * NE + e;
        c.W = a.in[23 + mat] + eo * D * DFE; c.WT = ws + WS_W13E + (size_t)j * W13E_PAIR + (size_t)e * 2 * DFE * D; c.K = D; c.ldw = DFE; c.kb = it / 112; c.nb = it % 112; c.half = mat; c.mode = 1; c.mul = W13_MUL; }
    else { const int q = g - CV_W13, e = q / CV_PER_MAT, it = q % CV_PER_MAT; const size_t eo = (size_t)j * NE + e;
        c.W = a.in[25] + eo * DFE * D; c.WT = ws + WS_W2E + (size_t)e * D * DFE; c.K = DFE; c.ldw = D; c.kb = it / 32; c.nb = it % 32; c.half = 0; c.mode = 0; c.mul = W2_MUL; }
    return c;
}
__device__ __forceinline__ void convert_experts_range(Frame& F, const Args& a, int j, int lo, int hi, int wk, int nw) {
    LAS float* scr = (LAS float*)(F.lds + F.wave * 16896);
    int g = lo + wk; if (g >= hi) return;
    TrReg r0, r1; CvItem c0 = cv_decode(a, F.ws, j, g), c1 = c0;
    transpose_load<false>(r0, c0.W, c0.ldw, 0, nullptr, c0.kb, c0.nb, F.lane);
    for (;;) {
        const bool more = g + nw < hi;
        if (more) { c1 = cv_decode(a, F.ws, j, g + nw); transpose_load<false>(r1, c1.W, c1.ldw, 0, nullptr, c1.kb, c1.nb, F.lane); }
        if (c0.mode == 1) transpose_store<1, true>(r0, c0.K, c0.WT, c0.half, scr, c0.kb, c0.nb, F.lane, c0.mul); else transpose_store<0, true>(r0, c0.K, c0.WT, c0.half, scr, c0.kb, c0.nb, F.lane, c0.mul);
        if (!more) break;
        g += nw; r0 = r1; c0 = c1;
    }
}
#ifndef CV_T1_V
#define CV_T1_V (E1_I8 ? 3072 : (FFN_UP_I8 ? 5120 : 4096))
#endif
#ifndef CV_O4B_V
#define CV_O4B_V 4096
#endif
#ifndef CV_O4B1_V
#define CV_O4B1_V 0
#endif
constexpr int CV_O4B1 = CV_O4B1_V;
constexpr int CV_O4B = CV_O4B_V;
constexpr int CV_T1 = CV_T1_V, CV_T2 = FFN_UP_I8 ? 3072 : 4096, CV_PRE = 6144;
__device__ __forceinline__ int tail_first(int nwg) { const int rounds = (nwg + 255) >> 8; const int full = nwg - (rounds - 1) * 256; return full; }

struct RowV { f32x4 v[4]; };
__device__ __forceinline__ void row_load(RowV& r, const float* p, int lane) { const GAS f32x4* x = (const GAS f32x4*)p + lane;
#pragma unroll
    for (int j = 0; j < 4; ++j) r.v[j] = NT_LOADS ? __builtin_nontemporal_load(x + 64 * j) : x[64 * j]; }
__device__ __forceinline__ void row_load_bf16(RowV& r, const bf16_t* p, int lane) { const GAS u32x2* x = (const GAS u32x2*)p + lane;
#pragma unroll
    for (int j = 0; j < 4; ++j) { const u32x2 w = x[64 * j]; r.v[j] = (f32x4){bflo(w.x), bfhi(w.x), bflo(w.y), bfhi(w.y)}; } }
__device__ __forceinline__ float row_sumsq(const RowV& r) { float s = 0.f;
#pragma unroll
    for (int j = 0; j < 4; ++j) s += (r.v[j].x * r.v[j].x + r.v[j].y * r.v[j].y) + (r.v[j].z * r.v[j].z + r.v[j].w * r.v[j].w);
    return wave_sum(s); }
__device__ __forceinline__ void row_store_f32(const RowV& r, float* p, int lane) { GAS f32x4* x = (GAS f32x4*)p + lane;
#pragma unroll
    for (int j = 0; j < 4; ++j) { if (NT_LOADS) __builtin_nontemporal_store(r.v[j], x + 64 * j); else x[64 * j] = r.v[j]; } }
__device__ __forceinline__ void row_store_bf16(const RowV& r, bf16_t* p, int lane) { GAS u32x2* x = (GAS u32x2*)p + lane;
#pragma unroll
    for (int j = 0; j < 4; ++j) { u32x2 w; w.x = cvt_pk_bf16(r.v[j].x, r.v[j].y); w.y = cvt_pk_bf16(r.v[j].z, r.v[j].w); x[64 * j] = w; } }
__device__ __forceinline__ void row_store_fp8(const RowV& r, unsigned char* p, int lane) { GAS unsigned* x = (GAS unsigned*)p + lane;
#pragma unroll
    for (int j = 0; j < 4; ++j) x[64 * j] = pg8::pk4_fp8(r.v[j].x, r.v[j].y, r.v[j].z, r.v[j].w); }
__device__ __forceinline__ float row_store_i8max(const RowV& r, unsigned char* p, int lane) { float mx = 0.f;
#pragma unroll
    for (int j = 0; j < 4; ++j) mx = fmaxf(fmaxf(mx, fmaxf(fabsf(r.v[j].x), fabsf(r.v[j].y))), fmaxf(fabsf(r.v[j].z), fabsf(r.v[j].w)));
    mx = wave_max(mx);
    const float qs = mx > 0.f ? 127.0f / mx : 0.f; GAS unsigned* x = (GAS unsigned*)p + lane;
#pragma unroll
    for (int j = 0; j < 4; ++j) x[64 * j] = pg8::q4_i8(r.v[j].x, r.v[j].y, r.v[j].z, r.v[j].w, qs);
    return mx * (1.0f / 127.0f); }
template <int NC> __device__ __forceinline__ void row_dots(const RowV& r, const LAS float* Wl, int lane, float (&out)[NC]) {
#pragma unroll
    for (int c = 0; c < NC; ++c) { float s = 0.f;
#pragma unroll
        for (int j = 0; j < 4; ++j) { const f32x4 w = *(const LAS f32x4*)(Wl + c * 1024 + 4 * lane + 256 * j); s += (r.v[j].x * w.x + r.v[j].y * w.y) + (r.v[j].z * w.z + r.v[j].w * w.w); }
        out[c] = wave_sum(s); }
}
template <int NC, int NR> __device__ __forceinline__ void row_dots_n(const RowV (&r)[NR], const LAS float* Wl, int lane, float (&out)[NR][NC]) {
#pragma unroll
    for (int c = 0; c < NC; ++c) { f32x4 w[4];
#pragma unroll
        for (int j = 0; j < 4; ++j) w[j] = *(const LAS f32x4*)(Wl + c * 1024 + 4 * lane + 256 * j);
#pragma unroll
        for (int u = 0; u < NR; ++u) { float s = 0.f;
#pragma unroll
            for (int j = 0; j < 4; ++j) s += (r[u].v[j].x * w[j].x + r[u].v[j].y * w[j].y) + (r[u].v[j].z * w[j].z + r[u].v[j].w * w[j].w);
            out[u][c] = wave_sum(s); } }
}
__device__ __forceinline__ void stage_table8(Frame& F, LAS float* Wl, const float* W, int ldw, int c0, const float* g) {
    float wv[16], gv[16];
#pragma unroll
    for (int i = 0; i < 16; ++i) { const int idx = F.tid + NTHR * i, k = idx >> 3, c = idx & 7; wv[i] = W[(size_t)k * ldw + c0 + c]; gv[i] = g ? g[k] : 1.f; }
#pragma unroll
    for (int i = 0; i < 16; ++i) { const int idx = F.tid + NTHR * i, k = idx >> 3, c = idx & 7; Wl[c * 1024 + k] = wv[i] * gv[i]; }
    __syncthreads();
}
__device__ __forceinline__ void p0_rows(Frame& F, const Args& a) {
    LAS float* Wl = (LAS float*)(F.lds);
    float* ssa = (float*)(F.ws + WS_SMALL + SM_SSA); bf16_t* hb = (bf16_t*)(F.ws + WS_HB); float* flog = (float*)(F.ws + WS_ESM + ES_FLOG);
    const int gw = F.vcu * NWAVES + F.wave, NGW = F.G * NWAVES;
    stage_table8(F, Wl, a.in[4], EIN, 2560, a.in[1]);
    for (int m0 = gw; m0 < T; m0 += 4 * NGW) {
        RowV rr[4];
#pragma unroll
        for (int u = 0; u < 4; ++u) { const int m = m0 + u * NGW; if (m < T) row_load(rr[u], a.in[0] + (size_t)m * D, F.lane); }
        float dta[4][8]; row_dots_n<8, 4>(rr, Wl, F.lane, dta);
#pragma unroll
        for (int u = 0; u < 4; ++u) { const int m = m0 + u * NGW; if (m < T) { const RowV& r = rr[u];
            const float ss = row_sumsq(r); const float inv = 1.0f / sqrtf(ss * (1.f / D) + EPS);
            if (!E1_I8 || BUILD_MODE != 0 || a.pad != 0) row_store_bf16(r, hb + (size_t)m * D, F.lane);
#if E1_I8
            { const float st = row_store_i8max(r, (unsigned char*)(F.ws + WS_HB8E) + (size_t)m * D, F.lane); if (F.lane == 0) ((float*)(F.ws + WS_SMALL + SM_STEPE))[m] = st; }
#endif
            float dts[8];
#pragma unroll
            for (int c = 0; c < 8; ++c) dts[c] = dta[u][c];
            if (F.lane == 0) ssa[m] = ss;
            if (F.lane < 8) { float v = dts[0];
#pragma unroll
                for (int c = 1; c < 8; ++c) v = (F.lane == c) ? dts[c] : v;
                flog[m * 8 + F.lane] = v * inv; } } }
    }
    __syncthreads();
}
}
#ifndef ATTN_EXIT
#define ATTN_EXIT 1
#endif
namespace attn_body {
using bf16=__hip_bfloat16;
constexpr int BATCH=4,NHEAD=8,SEQ=4096,D=64,DM=NHEAD*D,ODM=1024,OCOL=512;
constexpr int NW=8,QBLK=32,QB=QBLK*NW,KVBLK=64,NQB=SEQ/QB;
constexpr int ATTN_PITCH=DM, ATTN_UNIT_ROWS=QB;
__device__ __forceinline__ int crow(int r,int hi){return (r&3)+8*(r>>2)+4*hi;}
#define SBAR() __builtin_amdgcn_sched_barrier(0)
__device__ __forceinline__ void cmask(f32x16&p0,f32x16&p1,int jb,int qrel,int hi){
  const float NEG=-INFINITY; int kb=64*jb+4*hi;
  #pragma unroll
  for(int r=0;r<16;++r){int kv=kb+(r&3)+8*(r>>2); if(kv>qrel)p0[r]=NEG; if(kv+32>qrel)p1[r]=NEG;}
}

constexpr int NSLOT=3, SLOTB=8192;
constexpr int LDS_K=0, LDS_V=NSLOT*SLOTB, LDS_WS=2*NSLOT*SLOTB, LDS_OST=LDS_WS+NW*64*4, LDS_CB=LDS_OST+NW*4096, LDS_STOP=LDS_CB+SEQ*4, LDS_BYTES=LDS_STOP+64;
constexpr float C2=0.125f*1.4426950408889634f;
__device__ __forceinline__ void glds16(const void*gsrc,unsigned lds_dst){unsigned keep;
  asm volatile("s_mov_b32 %0, m0\n\ts_mov_b32 m0, %2\n\ts_nop 0\n\tglobal_load_lds_dwordx4 %1, off\n\ts_mov_b32 m0, %0":"=&s"(keep):"v"(gsrc),"s"(lds_dst):"memory");}
__device__ __forceinline__ float max3f(float a,float b,float c){float r;asm("v_max3_f32 %0, %1, %2, %3":"=v"(r):"v"(a),"v"(b),"v"(c));return r;}
__device__ __forceinline__ float max2f(float a,float b){float r;asm("v_max_f32_e32 %0, %1, %2":"=v"(r):"v"(a),"v"(b));return r;}
__device__ __forceinline__ float fadd_s(float a,float b){float r;asm("v_add_f32_e32 %0, %1, %2":"=v"(r):"v"(a),"v"(b));return r;}
__device__ __forceinline__ float fsub_s(float a,float b){float r;asm("v_sub_f32_e32 %0, %1, %2":"=v"(r):"v"(a),"v"(b));return r;}
typedef float f32x2_t __attribute__((ext_vector_type(2))); typedef __bf16 bf16x2_t __attribute__((ext_vector_type(2)));
__device__ __forceinline__ unsigned cvtpk_s(float lo,float hi){f32x2_t v={lo,hi};bf16x2_t b=__builtin_convertvector(v,bf16x2_t);return __builtin_bit_cast(unsigned,b);}
#define WAIT_BAR(N) asm volatile("s_waitcnt vmcnt(" #N ") lgkmcnt(0)\n\ts_barrier":::"memory")

__device__ __forceinline__ void qkt(f32x16&p0,f32x16&p1,const char*Kslot,const bf16x8*qr,const f32x16&negm,int r32,int hi){
  const char*kb=Kslot+hi*1024+r32*16;
  #pragma unroll
  for(int d0=0;d0<4;++d0){
    const bf16x8 b0=*reinterpret_cast<const bf16x8*>(kb+d0*2048);
    const bf16x8 b1=*reinterpret_cast<const bf16x8*>(kb+d0*2048+512);
    if(d0==0){p0=__builtin_amdgcn_mfma_f32_32x32x16_bf16(b0,qr[0],negm,0,0,0);p1=__builtin_amdgcn_mfma_f32_32x32x16_bf16(b1,qr[0],negm,0,0,0);}
    else{p0=__builtin_amdgcn_mfma_f32_32x32x16_bf16(b0,qr[d0],p0,0,0,0);p1=__builtin_amdgcn_mfma_f32_32x32x16_bf16(b1,qr[d0],p1,0,0,0);}}
}
typedef __attribute__((address_space(3))) const char* lds_cptr;
typedef short v4i16_t __attribute__((ext_vector_type(4)));
__device__ __forceinline__ void kload8(bf16x8*kf,lds_cptr kp){
  kf[0]=*(const __attribute__((address_space(3))) bf16x8*)(kp);      kf[1]=*(const __attribute__((address_space(3))) bf16x8*)(kp+512);
  kf[2]=*(const __attribute__((address_space(3))) bf16x8*)(kp+2048); kf[3]=*(const __attribute__((address_space(3))) bf16x8*)(kp+2560);
  kf[4]=*(const __attribute__((address_space(3))) bf16x8*)(kp+4096); kf[5]=*(const __attribute__((address_space(3))) bf16x8*)(kp+4608);
  kf[6]=*(const __attribute__((address_space(3))) bf16x8*)(kp+6144); kf[7]=*(const __attribute__((address_space(3))) bf16x8*)(kp+6656);
}
__device__ __forceinline__ void kload2(bf16x8*kf,lds_cptr kp,int j){ kf[2*j]=*(const __attribute__((address_space(3))) bf16x8*)(kp+j*2048); kf[2*j+1]=*(const __attribute__((address_space(3))) bf16x8*)(kp+j*2048+512); }
__device__ __forceinline__ s16x4 vtr(lds_cptr p){ return __builtin_bit_cast(s16x4,__builtin_amdgcn_ds_read_tr16_b64_v4i16((__attribute__((address_space(3))) v4i16_t*)p)); }
__device__ __forceinline__ float rowmax(const f32x16&p0,const f32x16&p1){
  float a=max3f(p0[0],p0[1],p1[0]),b=max3f(p0[2],p0[3],p1[1]);a=max3f(a,p1[2],p1[3]);
  #pragma unroll
  for(int r=4;r<16;r+=4){a=max3f(a,p0[r],p0[r+1]);b=max3f(b,p0[r+2],p0[r+3]);a=max3f(a,p1[r],p1[r+1]);b=max3f(b,p1[r+2],p1[r+3]);}
  const float m=max2f(a,b);
  auto rr=__builtin_amdgcn_permlane32_swap(__float_as_uint(m),__float_as_uint(m),false,false);
  return max2f(__uint_as_float(rr[0]),__uint_as_float(rr[1]));
}
__device__ __forceinline__ void pv(f32x16*o,int vb,bf16x8 pa0,bf16x8 pa1,bf16x8 pa2,bf16x8 pa3){
  #pragma unroll
  for(int d0=0;d0<2;++d0){s16x4 lo[4],hi[4];
    #pragma unroll
    for(int ks=0;ks<4;++ks){
      asm volatile("ds_read_b64_tr_b16 %0,%1 offset:%c2":"=&v"(lo[ks]):"v"(vb),"i"(d0*4096+ks*1024):"memory");
      asm volatile("ds_read_b64_tr_b16 %0,%1 offset:%c2":"=&v"(hi[ks]):"v"(vb),"i"(d0*4096+ks*1024+512):"memory");}
    asm volatile("s_waitcnt lgkmcnt(0)":::"memory");SBAR();
    #define PK(k) (bf16x8){lo[k][0],lo[k][1],lo[k][2],lo[k][3],hi[k][0],hi[k][1],hi[k][2],hi[k][3]}
    o[d0]=__builtin_amdgcn_mfma_f32_32x32x16_bf16(pa0,PK(0),o[d0],0,0,0);
    o[d0]=__builtin_amdgcn_mfma_f32_32x32x16_bf16(pa1,PK(1),o[d0],0,0,0);
    o[d0]=__builtin_amdgcn_mfma_f32_32x32x16_bf16(pa2,PK(2),o[d0],0,0,0);
    o[d0]=__builtin_amdgcn_mfma_f32_32x32x16_bf16(pa3,PK(3),o[d0],0,0,0);
    #undef PK
  }
}

#ifndef ATTN_STORE16
#define ATTN_STORE16(p,v) (*(u32x4*)(p)=(v))
#endif
template<int THRL> __device__ __forceinline__ void attn_unit(int b,int h,int qb,const bf16*Q,const bf16*__restrict__ K,const bf16*__restrict__ V,bf16*O,const float*CPbh,const float*segt,const float kmax,char*shm){
  int tid_=threadIdx.x; asm volatile("":"+v"(tid_));
  const int tid=tid_,lane=tid&63,r32=lane&31,hi=lane>>5; const int wid=__builtin_amdgcn_readfirstlane(tid>>6);
  const long rowbase=(long)b*SEQ; const int q0=qb*QB;
  const bf16*Qw=Q+(rowbase+q0+wid*QBLK)*DM+h*D;
  const bf16*Kh=K+rowbase*DM+h*D,*Vh=V+rowbase*DM+h*D;
  const unsigned lds0=(unsigned)(uintptr_t)shm;
  float*wsf=(float*)(shm+LDS_WS)+wid*64;
  const bf16*ksrc=Kh+(long)lane*DM+wid*8;
  const bf16*vsrc=Vh+(long)(16*(wid&3)+(lane>>2))*DM+(wid>>2)*32+(lane&3)*8;
  const unsigned kdst=lds0+LDS_K+wid*1024, vdst=lds0+LDS_V+wid*1024;
  #define PT(x) (NT-1-(x))
  #define DMA_K(t,slot) glds16(ksrc+(long)PT(t)*KVBLK*DM,(unsigned)__builtin_amdgcn_readfirstlane(kdst+(slot)))
  #define DMA_V(t,slot) glds16(vsrc+(long)PT(t)*KVBLK*DM,(unsigned)__builtin_amdgcn_readfirstlane(vdst+(slot)))
  const int vb0=(int)(lds0+LDS_V)+((lane>>4)&1)*32+(lane&3)*8+(4*hi+((lane&15)>>2))*64;
  const char*Kbase=shm+LDS_K; bf16x8 kf[8];
  const lds_cptr shm3=(lds_cptr)shm; const lds_cptr kp0=shm3+LDS_K+hi*1024+r32*16; const lds_cptr vp0=shm3+LDS_V+((lane>>4)&1)*32+(lane&3)*8+(4*hi+((lane&15)>>2))*64;
  const int NT=(q0+QB)/KVBLK;
  DMA_K(0,0);DMA_V(0,0);DMA_K(1,SLOTB);
  bf16x8 qr[4];
  #pragma unroll
  for(int d0=0;d0<4;++d0)qr[d0]=*reinterpret_cast<const bf16x8*>(&Qw[(long)r32*DM+d0*16+hi*8]);
  { __attribute__((address_space(3))) f32x4* dst=(__attribute__((address_space(3))) f32x4*)((__attribute__((address_space(3))) char*)shm+LDS_CB); const f32x4* src=(const f32x4*)CPbh; const int n4=(q0+QB)/4;
    float sg[8]; _Pragma("unroll") for(int q_=0;q_<8;++q_) sg[q_]=segt[q_];
    float ofa=0.f,ofb=0.f; { const int sa_=tid>>7; float run_=0.f; _Pragma("unroll") for(int q_=0;q_<8;++q_){ if(q_==sa_)ofa=run_; if(q_==sa_+4)ofb=run_; run_+=sg[q_]; } }
    if(tid<n4){ f32x4 v=src[tid]; v=v+ofa; dst[tid]=v; } if(tid+NW*64<n4){ f32x4 v=src[tid+NW*64]; v=v+ofb; dst[tid+NW*64]=v; } }
  const __attribute__((address_space(3))) float* cbl=(const __attribute__((address_space(3))) float*)((lds_cptr)shm+LDS_CB)+4*hi;
  #define BIAS(P0,P1,t) do{ const __attribute__((address_space(3))) float* cbp_=cbl+64*PT(t); _Pragma("unroll") for(int g_=0;g_<4;++g_){ const f32x4 b0_=*(const __attribute__((address_space(3))) f32x4*)(cbp_+8*g_), b1_=*(const __attribute__((address_space(3))) f32x4*)(cbp_+8*g_+32); \
      _Pragma("unroll") for(int q_=0;q_<4;++q_){ P0[4*g_+q_]-=b0_[q_]; P1[4*g_+q_]-=b1_[q_]; } } }while(0)
  float mhat=0.f,l_reg=0.f;f32x16 o[2];o[0]=f32x16{};o[1]=f32x16{};
  const int qrel=wid*QBLK+r32;
  #define CMASK(P0,P1,t) do{int jb_=3-(t); if(jb_>=0)cmask(P0,P1,jb_,qrel,hi);}while(0)
  bool resc=false;
  #define START(P0,P1) do{ const float rm=rowmax(P0,P1); resc=false; \
    { const float dl=(rm==-INFINITY)?0.f:rm; mhat=fadd_s(mhat,dl);     \
      _Pragma("unroll") for(int r=0;r<16;++r){P0[r]=fsub_s(P0[r],dl);P1[r]=fsub_s(P1[r],dl);} \
      } \
    _Pragma("unroll") for(int r=0;r<16;++r)P0[r]=__builtin_amdgcn_exp2f(P0[r]); }while(0)
  #define RESC() do{ if(resc){ asm volatile("s_waitcnt lgkmcnt(0)":::"memory"); \
      _Pragma("unroll") for(int d_=0;d_<2;++d_) _Pragma("unroll") for(int r=0;r<16;++r)o[d_][r]*=wsf[crow(r,hi)]; } }while(0)
  f32x16 pA0,pA1,pB0,pB1;
  int sl_prev=0,sl_cur=0,sl_next=SLOTB;
  #define ROT() do{sl_prev=sl_cur;sl_cur=sl_next;sl_next=(sl_next==(NSLOT-1)*SLOTB)?0:sl_next+SLOTB;}while(0)
  DMA_K(2,2*SLOTB);
  WAIT_BAR(3);
  { f32x16 z0_=f32x16{}; asm volatile("":"+v"(z0_)); qkt(pA0,pA1,Kbase,qr,z0_,r32,hi); }asm volatile("s_nop 15\n\ts_nop 7":"+v"(pA0),"+v"(pA1));BIAS(pA0,pA1,0);CMASK(pA0,pA1,0);
  START(pA0,pA1);
  _Pragma("unroll") for(int r=0;r<16;++r)pA1[r]=__builtin_amdgcn_exp2f(pA1[r]);
  { const float nmh_=-mhat; _Pragma("unroll") for(int g_=0;g_<4;++g_){ const f32x4 b0_=*(const __attribute__((address_space(3))) f32x4*)(cbl+64*PT(1)+8*g_), b1_=*(const __attribute__((address_space(3))) f32x4*)(cbl+64*PT(1)+8*g_+32);
      _Pragma("unroll") for(int q_=0;q_<4;++q_){ pB0[4*g_+q_]=nmh_-b0_[q_]; pB1[4*g_+q_]=nmh_-b1_[q_]; } } }
  WAIT_BAR(0);
  DMA_K(3,0);DMA_V(1,SLOTB);
  ROT();
  kload8(kf,kp0+sl_cur);
  WAIT_BAR(2);
  s16x4 vlo[8],vhi[8]; u32x4 pw0,pw1,pw2,pw3;
  #define PKW(P,B) cvtpk_s(P[B],P[B+1])
  #define PAF(k) __builtin_bit_cast(bf16x8,pw##k)
  #define VFR(i) (bf16x8){vlo[i][0],vlo[i][1],vlo[i][2],vlo[i][3],vhi[i][0],vhi[i][1],vhi[i][2],vhi[i][3]}
  #define PIN(x) asm volatile("":"+v"(x))
  #define MX3(a,b,c) __builtin_fmaxf(__builtin_fmaxf((a),(b)),(c))
  #define GAPA(MF,A0,A1,A2,A3,W0,W1,PW) do{ MF; sacc+=A0; sacc+=A1; sacc+=A2; sacc+=A3; PIN(sacc); W0; W1; PIN(PW); SBAR(); }while(0)
  #define EX(v) __builtin_amdgcn_exp2f(v)
  #define INI(GI,P,g,p,t) do{ if(GI){ const f32x4 b_=*(const __attribute__((address_space(3))) f32x4*)(cbl+64*PT((t)+1)+8*(g)+32*(p)); P[4*(g)]=nmh_-b_[0]; P[4*(g)+1]=nmh_-b_[1]; P[4*(g)+2]=nmh_-b_[2]; P[4*(g)+3]=nmh_-b_[3]; PIN(P); } }while(0)
  #define GAPB(MF,X,B,INIT) do{ MF; X[B]=EX(X[B]); X[B+1]=EX(X[B+1]); X[B+2]=EX(X[B+2]); X[B+3]=EX(X[B+3]); PIN(X); INIT; SBAR(); }while(0)
  #define VRD(i) do{ vlo[i]=vtr(vp_+(((i)>>2)*4096+((i)&3)*1024)); vhi[i]=vtr(vp_+(((i)>>2)*4096+((i)&3)*1024+512)); }while(0)
  #define KRD(G,j) do{ if(G){ kload2(kf,kp0+sl_next,j); SBAR(); } }while(0)
  #define STEP(C0,C1,P0,P1,t,GK,GV,GL) do{ SBAR(); \
    const lds_cptr vp_=vp0+sl_prev; \
    VRD(0); SBAR(); float sacc=(P0[0]+P0[1]); \
    GAPA(C0=__builtin_amdgcn_mfma_f32_32x32x16_bf16(kf[0],qr[0],C0,0,0,0), P0[2],P0[3],P0[4],P0[5],     pw0[0]=PKW(P0,0), pw0[1]=PKW(P0,2), pw0); \
    VRD(4); SBAR(); GAPA(C1=__builtin_amdgcn_mfma_f32_32x32x16_bf16(kf[1],qr[0],C1,0,0,0), P0[6],P0[7],P0[8],P0[9],     pw0[2]=PKW(P0,4), pw0[3]=PKW(P0,6), pw0); \
    VRD(1); SBAR(); GAPA(C0=__builtin_amdgcn_mfma_f32_32x32x16_bf16(kf[2],qr[1],C0,0,0,0),   P0[10],P0[11],P0[12],P0[13], pw1[0]=PKW(P0,8), pw1[1]=PKW(P0,10), pw1); \
    VRD(5); SBAR(); GAPA(C1=__builtin_amdgcn_mfma_f32_32x32x16_bf16(kf[3],qr[1],C1,0,0,0),   P0[14],P0[15],P1[0],P1[1],   pw1[2]=PKW(P0,12),pw1[3]=PKW(P0,14), pw1); \
    VRD(2); SBAR(); GAPA(C0=__builtin_amdgcn_mfma_f32_32x32x16_bf16(kf[4],qr[2],C0,0,0,0),   P1[2],P1[3],P1[4],P1[5],     pw2[0]=PKW(P1,0), pw2[1]=PKW(P1,2), pw2); \
    VRD(6); SBAR(); GAPA(C1=__builtin_amdgcn_mfma_f32_32x32x16_bf16(kf[5],qr[2],C1,0,0,0),   P1[6],P1[7],P1[8],P1[9],     pw2[2]=PKW(P1,4), pw2[3]=PKW(P1,6), pw2); \
    VRD(3); SBAR(); GAPA(C0=__builtin_amdgcn_mfma_f32_32x32x16_bf16(kf[6],qr[3],C0,0,0,0),   P1[10],P1[11],P1[12],P1[13], pw3[0]=PKW(P1,8), pw3[1]=PKW(P1,10), pw3); \
    VRD(7); SBAR(); GAPA(C1=__builtin_amdgcn_mfma_f32_32x32x16_bf16(kf[7],qr[3],C1,0,0,0),   P1[14],P1[15],0.f,0.f,       pw3[2]=PKW(P1,12),pw3[3]=PKW(P1,14), pw3); \
    l_reg+=sacc; \
    if(GK){DMA_K((t)+3,sl_cur);} if(GV){DMA_V((t)+1,sl_next);} \
    CMASK(C0,C1,t); \
    { float a=MX3(C0[0],C0[1],C1[0]),b=MX3(C0[2],C0[3],C1[1]); a=MX3(a,C1[2],C1[3]); \
      _Pragma("unroll") for(int r=4;r<16;r+=4){a=MX3(a,C0[r],C0[r+1]);b=MX3(b,C0[r+2],C0[r+3]);a=MX3(a,C1[r],C1[r+1]);b=MX3(b,C1[r+2],C1[r+3]);} \
      float rm=__builtin_fmaxf(a,b); { auto rr=__builtin_amdgcn_permlane32_swap(__float_as_uint(rm),__float_as_uint(rm),false,false); rm=__builtin_fmaxf(__uint_as_float(rr[0]),__uint_as_float(rr[1])); } \
      resc=false; \
      if(__builtin_expect(__any(rm>(float)THRL),0)){ const float dl=__builtin_fmaxf(rm,0.f); mhat+=dl; \
        _Pragma("unroll") for(int r=0;r<16;++r){C0[r]-=dl;C1[r]-=dl;} \
        const float f=__builtin_amdgcn_exp2f(-dl); l_reg*=f; if(hi==0)wsf[r32]=f; resc=true; } } \
    const float nmh_=-mhat; SBAR(); \
    GAPB(o[0]=__builtin_amdgcn_mfma_f32_32x32x16_bf16(PAF(0),VFR(0),o[0],0,0,0), C0,0, INI(GL,P0,0,0,t)); \
    GAPB(o[1]=__builtin_amdgcn_mfma_f32_32x32x16_bf16(PAF(0),VFR(4),o[1],0,0,0), C0,4, INI(GL,P0,1,0,t)); \
    KRD(GL,0); GAPB(o[0]=__builtin_amdgcn_mfma_f32_32x32x16_bf16(PAF(1),VFR(1),o[0],0,0,0), C0,8, INI(GL,P0,2,0,t)); \
    KRD(GL,1); GAPB(o[1]=__builtin_amdgcn_mfma_f32_32x32x16_bf16(PAF(1),VFR(5),o[1],0,0,0), C0,12, INI(GL,P0,3,0,t)); \
    KRD(GL,2); GAPB(o[0]=__builtin_amdgcn_mfma_f32_32x32x16_bf16(PAF(2),VFR(2),o[0],0,0,0), C1,0, INI(GL,P1,0,1,t)); \
    KRD(GL,3); GAPB(o[1]=__builtin_amdgcn_mfma_f32_32x32x16_bf16(PAF(2),VFR(6),o[1],0,0,0), C1,4, INI(GL,P1,1,1,t)); \
    GAPB(o[0]=__builtin_amdgcn_mfma_f32_32x32x16_bf16(PAF(3),VFR(3),o[0],0,0,0), C1,8, INI(GL,P1,2,1,t)); \
    GAPB(o[1]=__builtin_amdgcn_mfma_f32_32x32x16_bf16(PAF(3),VFR(7),o[1],0,0,0), C1,12, INI(GL,P1,3,1,t)); \
    }while(0)
  float qnk;
  { float s2=0.f;
    _Pragma("unroll") for(int d0=0;d0<4;++d0){ _Pragma("unroll") for(int e=0;e<8;++e){ const float v=__uint_as_float(((unsigned)(unsigned short)qr[d0][e])<<16); s2+=v*v; } }
    auto rr=__builtin_amdgcn_permlane32_swap(__float_as_uint(s2),__float_as_uint(s2),false,false); s2=__uint_as_float(rr[0])+__uint_as_float(rr[1]);
    qnk=sqrtf(s2)*kmax; }
  const __attribute__((address_space(3))) float* cb0=(const __attribute__((address_space(3))) float*)((lds_cptr)shm+LDS_CB);
  __attribute__((address_space(3))) unsigned* stopf=(__attribute__((address_space(3))) unsigned*)((__attribute__((address_space(3))) char*)shm+LDS_STOP);
  #define ENDW(tt) do{ if((tt)+3<NT){WAIT_BAR(2);} else if((tt)+2<NT){WAIT_BAR(1);} else {WAIT_BAR(0);} }while(0)
  #define DRAIN(P0,P1,slot) do{ float sacc=P0[0]+P0[1]; _Pragma("unroll") for(int r=2;r<16;++r)sacc+=P0[r]; _Pragma("unroll") for(int r=0;r<16;++r)sacc+=P1[r]; l_reg+=sacc; \
    pw0=(u32x4){PKW(P0,0),PKW(P0,2),PKW(P0,4),PKW(P0,6)};pw1=(u32x4){PKW(P0,8),PKW(P0,10),PKW(P0,12),PKW(P0,14)};pw2=(u32x4){PKW(P1,0),PKW(P1,2),PKW(P1,4),PKW(P1,6)};pw3=(u32x4){PKW(P1,8),PKW(P1,10),PKW(P1,12),PKW(P1,14)}; \
    SBAR(); pv(o,vb0+(slot),PAF(0),PAF(1),PAF(2),PAF(3)); }while(0)
  int t=1; bool stopped=false;
  for(;t+1<NT;t+=2){
    STEP(pB0,pB1,pA0,pA1,t,(t+3<NT),(t+1<NT),(t+1<NT));       ENDW(t);   RESC(); ROT();
    STEP(pA0,pA1,pB0,pB1,t+1,(t+4<NT),(t+2<NT),(t+2<NT));
    { bool ok=(t+2<NT) && ATTN_EXIT; if(ok){ const float cl=cb0[64*PT(t+2)+63]; ok=__all((qnk-cl-mhat)<-160.f); } if(lane==0)stopf[wid]=ok?1u:0u; }
    ENDW(t+1); RESC(); ROT();
    { const u32x4 f0=*(const __attribute__((address_space(3))) u32x4*)stopf, f1=*(const __attribute__((address_space(3))) u32x4*)(stopf+4);
      if((f0.x&f0.y&f0.z&f0.w&f1.x&f1.y&f1.z&f1.w)!=0u){ stopped=true; break; } }
  }
  if(!stopped){ STEP(pB0,pB1,pA0,pA1,NT-1,false,false,false); RESC(); DRAIN(pB0,pB1,sl_cur); }
  else { asm volatile("s_waitcnt vmcnt(0)":::"memory"); DRAIN(pA0,pA1,sl_prev); }
  #undef DRAIN
  #undef PKW
  #undef PAF
  #undef VFR
  #undef PIN
  #undef MX3
  #undef GAPA
  #undef GAPB
  #undef INI
  #undef EX
  #undef VRD
  #undef KRD
  #undef STEP
  #undef ENDW
  {auto rr=__builtin_amdgcn_permlane32_swap(__float_as_uint(l_reg),__float_as_uint(l_reg),false,false);l_reg=__uint_as_float(rr[0])+__uint_as_float(rr[1]);}
  if(hi==0)wsf[32+r32]=l_reg;asm volatile("s_waitcnt lgkmcnt(0)":::"memory");
  float rli[16];
  #pragma unroll
  for(int r=0;r<16;++r)rli[r]=__builtin_amdgcn_rcpf(wsf[32+crow(r,hi)]);
  bf16*Ow=O+(rowbase+q0+wid*QBLK)*ODM+OCOL+h*D;
  { bf16*stg=(bf16*)(shm+LDS_OST)+wid*2048;
    #pragma unroll
    for(int r=0;r<16;++r){const int orow=crow(r,hi);
      #pragma unroll
      for(int d0=0;d0<2;++d0)stg[orow*64+d0*32+r32]=__float2bfloat16(o[d0][r]*rli[r]);}
    asm volatile("s_waitcnt lgkmcnt(0)":::"memory");
    #pragma unroll
    for(int i=0;i<4;++i){const int row=i*8+(lane>>3),ch=lane&7; const u32x4 v=*(const u32x4*)(stg+row*64+ch*8); ATTN_STORE16(Ow+(long)row*ODM+ch*8,v);} }
  asm volatile("s_waitcnt lgkmcnt(0)\n\ts_barrier":::"memory");
  #undef BIAS
  #undef PT
  #undef DMA_K
  #undef DMA_V
  #undef CMASK
  #undef START
  #undef RESC
  #undef ROT
}
constexpr int ATTN_LDS_BYTES=LDS_BYTES;
#undef SBAR
#undef WAIT_BAR
}
namespace fk {
__device__ __forceinline__ float gelu_tanh_fast(float x) {
    const float z = 0.7978845608028654f * (x + 0.044715f * x * x * x);
    const float e = __builtin_amdgcn_exp2f(2.f * LOG2E * z);
    const float th = 1.f - 2.f * __builtin_amdgcn_rcpf(1.f + e);
    return 0.5f * x * (1.f + th);
}
__device__ __forceinline__ bf16_t bf1(float v) { return (bf16_t)cvt_pk_bf16(v, 0.f); }
__device__ __forceinline__ f32x16 zero16v() { f32x16 z = f32x16{}; asm volatile("" : "+v"(z)); return z; }
__device__ __forceinline__ int crow32f(int r, int hi) { return (r & 3) + 8 * (r >> 2) + 4 * hi; }
__device__ __forceinline__ float logsigm_acc(float z) {
    const float e = __builtin_amdgcn_exp2f(-fabsf(z) * LOG2E); return fminf(z, 0.f) - 0.6931471805599453f * __builtin_amdgcn_logf(1.f + e); }

constexpr int LW_STRIDE = 13312, LW_XRT = 0, LW_XCI = 4480, LW_YRT = 9088, LW_OUT = 0;
static_assert(8 * LW_STRIDE <= RING_BYTES && LW_YRT + 4096 <= LW_STRIDE, "lru wave lds");
__device__ __forceinline__ void lru_wave_task(Frame& F, const Args& a, int j, int task) {
    int lane0_ = F.lane; asm volatile("" : "+v"(lane0_));
    const int lane = lane0_, r31 = lane & 31, hi = lane >> 5;
    LAS unsigned char* L = F.lds + F.wave * LW_STRIDE;
    const int c = task >> 5, bn = task & 31, b = bn >> 3, n = bn & 7;
    const bf16_t* XR = (const bf16_t*)(F.ws + WS_XR); const bf16_t* YR = (const bf16_t*)(F.ws + WS_YR);
    bf16_t* YLG = (bf16_t*)(F.ws + WS_YLG); bf16_t* PGo = (bf16_t*)(F.ws + WS_PG); float* AGG = (float*)(F.ws + WS_ESM + ES_AGG);
    const bf16_t* GAT = (const bf16_t*)(F.ws + WS_SMALL + SM_GAT) + (size_t)(j * 8 + n) * 4096; const bf16_t* GXT = (const bf16_t*)(F.ws + WS_SMALL + SM_GXT) + (size_t)(j * 8 + n) * 4096;
    float cb[2], w0[2], w1[2], w2[2], w3[2], gab[2], gxb[2], sp[2];
#pragma unroll
    for (int nbk = 0; nbk < 2; ++nbk) { const int gch = n * 64 + 32 * nbk + r31; const float* cw = a.in[5] + j * 2048;
        cb[nbk] = a.in[6][j * 512 + gch]; w0[nbk] = cw[gch]; w1[nbk] = cw[512 + gch]; w2[nbk] = cw[1024 + gch]; w3[nbk] = cw[1536 + gch];
        gab[nbk] = a.in[8][j * 512 + gch]; gxb[nbk] = a.in[10][j * 512 + gch];
        const float lam = a.in[11][j * 512 + gch]; sp[nbk] = 0.6931471805599453f * __builtin_amdgcn_logf(1.f + __builtin_amdgcn_exp2f(-lam * LOG2E));
    }
    float Pc[2] = {1.f, 1.f}, yc[2] = {0.f, 0.f};
    for (int hb = 0; hb < 2; ++hb) {
        int row0 = b * SEQ + c * 64 + hb * 32;
        asm volatile("" : "+s"(row0));
#pragma unroll
        for (int i = 0; i < 5; ++i) { const int q = lane + 64 * i; if (q < 280) { const int r = q >> 3, c8 = q & 7; u32x4 v = (u32x4){0u, 0u, 0u, 0u};
                if (c > 0 || hb > 0 || r >= 3) v = __builtin_nontemporal_load((const GAS u32x4*)(XR + (size_t)(row0 - 3 + r) * 512 + n * 64 + c8 * 8));
                *(LAS u32x4*)(L + LW_XRT + q * 16) = v; } }
#pragma unroll
        for (int i = 0; i < 4; ++i) { const int q = lane + 64 * i, r = q >> 3, c8 = q & 7; *(LAS u32x4*)(L + LW_YRT + q * 16) = __builtin_nontemporal_load((const GAS u32x4*)(YR + (size_t)(row0 + r) * 512 + n * 64 + c8 * 8)); }
        float xc[2][16];
        const LAS bf16_t* xt = (const LAS bf16_t*)(L + LW_XRT); LAS bf16_t* xi = (LAS bf16_t*)(L + LW_XCI);
#pragma unroll
        for (int nbk = 0; nbk < 2; ++nbk) { const int ch = 32 * nbk + r31;
#pragma unroll
            for (int g4 = 0; g4 < 4; ++g4) { const int t0 = 8 * g4 + 4 * hi; float xv[7];
#pragma unroll
                for (int q = 0; q < 7; ++q) xv[q] = bf2f(xt[(t0 + q) * 64 + ch]);
#pragma unroll
                for (int q = 0; q < 4; ++q) { const float v = cb[nbk] + w0[nbk] * xv[q] + w1[nbk] * xv[q + 1] + w2[nbk] * xv[q + 2] + w3[nbk] * xv[q + 3]; xc[nbk][4 * g4 + q] = v; xi[(t0 + q) * 72 + ch] = bf1(v); } } }
        f32x16 ra[2], rx[2];
#pragma unroll
        for (int nbk = 0; nbk < 2; ++nbk) { ra[nbk] = zero16v(); rx[nbk] = zero16v(); }
        { bf16x8 ba[2][4], bx[2][4];
#pragma unroll
          for (int nbk = 0; nbk < 2; ++nbk)
#pragma unroll
              for (int s = 0; s < 4; ++s) { const size_t bo = (size_t)(32 * nbk + r31) * 64 + 16 * s + 8 * hi; ba[nbk][s] = *(const GAS bf16x8*)(GAT + bo); bx[nbk][s] = *(const GAS bf16x8*)(GXT + bo); }
#pragma unroll
          for (int s = 0; s < 4; ++s) { const bf16x8 af = *(const LAS bf16x8*)(L + LW_XCI + (r31 * 72 + 16 * s + 8 * hi) * 2);
#pragma unroll
              for (int nbk = 0; nbk < 2; ++nbk) { ra[nbk] = __builtin_amdgcn_mfma_f32_32x32x16_bf16(af, ba[nbk][s], ra[nbk], 0, 0, 0); rx[nbk] = __builtin_amdgcn_mfma_f32_32x32x16_bf16(af, bx[nbk][s], rx[nbk], 0, 0, 0); } } }
#pragma unroll
        for (int nbk = 0; nbk < 2; ++nbk)
#pragma unroll
            for (int r = 0; r < 16; r += 2) {
                const float nga = -LOG2E * gab[nbk], ngx = -LOG2E * gxb[nbk], c8 = -8.0f * sp[nbk];
                const f32x2 a2 = (f32x2){ra[nbk][r], ra[nbk][r + 1]}, u2 = (f32x2){rx[nbk][r], rx[nbk][r + 1]}, xc2 = (f32x2){xc[nbk][r], xc[nbk][r + 1]};
                const f32x2 ta = a2 * (-LOG2E) + nga, tx = u2 * (-LOG2E) + ngx;
                const f32x2 da = (f32x2){__builtin_amdgcn_exp2f(ta.x), __builtin_amdgcn_exp2f(ta.y)} + 1.0f, dx = (f32x2){__builtin_amdgcn_exp2f(tx.x), __builtin_amdgcn_exp2f(tx.y)} + 1.0f;
                const f32x2 rg = (f32x2){__builtin_amdgcn_rcpf(da.x), __builtin_amdgcn_rcpf(da.y)}, ig = (f32x2){__builtin_amdgcn_rcpf(dx.x), __builtin_amdgcn_rcpf(dx.y)};
                const f32x2 la = rg * c8; const f32x2 tl = la * LOG2E; const f32x2 av = (f32x2){__builtin_amdgcn_exp2f(tl.x), __builtin_amdgcn_exp2f(tl.y)};
                const f32x2 x2 = la * 2.0f; const f32x2 ps = -x2 * ((x2 * (1.f / 6.f) + 0.5f) * x2 + 1.0f), pb = 1.0f - av * av;
                const f32x2 om = (f32x2){x2.x > -0.02f ? ps.x : pb.x, x2.y > -0.02f ? ps.y : pb.y};
                const f32x2 uo = (f32x2){__builtin_amdgcn_sqrtf(om.x), __builtin_amdgcn_sqrtf(om.y)} * (ig * xc2);
                ra[nbk][r] = av.x; ra[nbk][r + 1] = av.y; rx[nbk][r] = uo.x; rx[nbk][r + 1] = uo.y; }
#pragma unroll
        for (int nbk = 0; nbk < 2; ++nbk) {
#pragma unroll
            for (int g4 = 0; g4 < 4; ++g4) {
#pragma unroll
                for (int q = 1; q < 4; ++q) { const int r = 4 * g4 + q; rx[nbk][r] = ra[nbk][r] * rx[nbk][r - 1] + rx[nbk][r]; ra[nbk][r] = ra[nbk][r] * ra[nbk][r - 1]; }
                const float P4 = ra[nbk][4 * g4 + 3], y4 = rx[nbk][4 * g4 + 3];
                float Pin = Pc[nbk], yin = yc[nbk];
                { const float yo = P4 * yin + y4, Po = P4 * Pin;
                  const auto sy = __builtin_amdgcn_permlane32_swap(__float_as_uint(yo), __float_as_uint(yo), false, false); const auto sP = __builtin_amdgcn_permlane32_swap(__float_as_uint(Po), __float_as_uint(Po), false, false);
                  const float y_lo = __uint_as_float(sy[0]), P_lo = __uint_as_float(sP[0]);
                  if (hi) { Pin = P_lo; yin = y_lo; }
                  const float y1 = P4 * yin + y4, P1 = P4 * Pin;
                  const auto ty = __builtin_amdgcn_permlane32_swap(__float_as_uint(y1), __float_as_uint(y1), false, false); const auto tP = __builtin_amdgcn_permlane32_swap(__float_as_uint(P1), __float_as_uint(P1), false, false);
                  yc[nbk] = __uint_as_float(ty[1]); Pc[nbk] = __uint_as_float(tP[1]); }
#pragma unroll
                for (int q = 0; q < 4; ++q) { const int r = 4 * g4 + q; rx[nbk][r] = ra[nbk][r] * yin + rx[nbk][r]; ra[nbk][r] = ra[nbk][r] * Pin; }
            }
        }
        { const LAS bf16_t* yt = (const LAS bf16_t*)(L + LW_YRT); LAS bf16_t* o0 = (LAS bf16_t*)(L + LW_OUT); LAS bf16_t* o1 = (LAS bf16_t*)(L + LW_OUT + 4096);
#pragma unroll
          for (int nbk = 0; nbk < 2; ++nbk) { const int ch = 32 * nbk + r31;
#pragma unroll
              for (int r = 0; r < 16; r += 2) { const int t0 = crow32f(r, hi), t1 = crow32f(r + 1, hi);
                  const f32x2 x = (f32x2){bf2f(yt[t0 * 64 + ch]), bf2f(yt[t1 * 64 + ch])};
                  const f32x2 tz = (x * ((x * x) * 0.044715f + 1.0f)) * (2.f * LOG2E * 0.7978845608028654f);
                  const f32x2 d = (f32x2){__builtin_amdgcn_exp2f(tz.x), __builtin_amdgcn_exp2f(tz.y)} + 1.0f;
                  const f32x2 rc = (f32x2){__builtin_amdgcn_rcpf(d.x), __builtin_amdgcn_rcpf(d.y)};
                  const f32x2 g = x - rc * x;
                  const f32x2 y0 = (f32x2){rx[nbk][r], rx[nbk][r + 1]} * g, y1 = (f32x2){ra[nbk][r], ra[nbk][r + 1]} * g;
                  o0[t0 * 64 + ch] = bf1(y0.x); o0[t1 * 64 + ch] = bf1(y0.y); o1[t0 * 64 + ch] = bf1(y1.x); o1[t1 * 64 + ch] = bf1(y1.y); } }
#pragma unroll
          for (int i = 0; i < 4; ++i) { const int q = lane + 64 * i, r = q >> 3, c8 = q & 7; const size_t go = (size_t)(row0 + r) * 512 + n * 64 + c8 * 8;
              *(GAS u32x4*)(YLG + go) = *(const LAS u32x4*)(L + LW_OUT + q * 16); *(GAS u32x4*)(PGo + go) = *(const LAS u32x4*)(L + LW_OUT + 4096 + q * 16); }
          asm volatile("s_waitcnt lgkmcnt(0)" ::: "memory"); }
    }
    if (hi == 0) {
#pragma unroll
        for (int nbk = 0; nbk < 2; ++nbk) { float* ag = AGG + ((size_t)(b * 64 + c) * 512 + n * 64 + 32 * nbk + r31) * 2; *(GAS f32x2*)ag = (f32x2){Pc[nbk], yc[nbk]}; } }
}

__device__ __forceinline__ void fox_cumsum(Frame& F, const Args& a, int j, int item) {
    const int bh = item >> 3, seg = item & 7, b = bh >> 3, h = bh & 7; const float fb = a.in[12][j * 8 + h];
    const float* flog = (const float*)(F.ws + WS_ESM + ES_FLOG); float* CP = (float*)(F.ws + WS_ESM + ES_CP) + (size_t)bh * SEQ;
    const bf16_t* Kb = (const bf16_t*)(F.ws + WS_K);
    LAS float* wt = (LAS float*)(F.lds);
    const int t = seg * 512 + F.tid;
    const float run = logsigm_acc(flog[(size_t)(b * SEQ + t) * 8 + h] + fb);
    float kmx = 0.f;
    { const GAS u32x4* kr = (const GAS u32x4*)(Kb + (size_t)(b * SEQ + t) * 512 + h * 64);
#pragma unroll
      for (int q = 0; q < 8; ++q) { const u32x4 w = kr[q]; kmx += bflo(w.x) * bflo(w.x) + bfhi(w.x) * bfhi(w.x) + bflo(w.y) * bflo(w.y) + bfhi(w.y) * bfhi(w.y) + bflo(w.z) * bflo(w.z) + bfhi(w.z) * bfhi(w.z) + bflo(w.w) * bflo(w.w) + bfhi(w.w) * bfhi(w.w); } }
    float inc = run;
#pragma unroll
    for (int o = 1; o < 64; o <<= 1) { const float u = __shfl_up(inc, o); if (F.lane >= o) inc += u; }
#pragma unroll
    for (int o = 32; o; o >>= 1) kmx = fmaxf(kmx, __shfl_xor(kmx, o));
    if (F.lane == 63) { wt[F.wave] = inc; wt[8 + F.wave] = kmx; }
    __syncthreads();
    float base = 0.f;
    for (int w = 0; w < F.wave; ++w) base += wt[w];
    CP[t] = (base + inc) * LOG2E;
    if (F.tid == 0) { float m = 0.f, tot = 0.f; for (int w = 0; w < 8; ++w) { m = fmaxf(m, wt[8 + w]); tot += wt[w]; }
        ((float*)(F.ws + WS_SMALL + SM_KMAX))[bh * 8 + seg] = m; ((float*)(F.ws + WS_SMALL + SM_KMAX))[256 + bh * 8 + seg] = tot * LOG2E; }
    __syncthreads();
}

__device__ __forceinline__ void lru_fixup(Frame& F, int b, int c) {
    const float* AGG = (const float*)(F.ws + WS_ESM + ES_AGG);
    const bf16_t* YLG = (const bf16_t*)(F.ws + WS_YLG); const bf16_t* PGi = (const bf16_t*)(F.ws + WS_PG); bf16_t* Y = (bf16_t*)(F.ws + WS_Y);
    LAS float* HIN = (LAS float*)(F.lds);
    { const int ch = F.tid; float hh = 0.f;
      for (int cc = 0; cc < c; ++cc) { const f32x2 g = *(const GAS f32x2*)(AGG + ((size_t)(b * 64 + cc) * 512 + ch) * 2); hh = g.x * hh + g.y; }
      HIN[ch] = hh; }
    __syncthreads();
    const int rbase = b * SEQ + c * 64;
#pragma unroll 2
    for (int i = 0; i < 8; ++i) { const int q = F.tid + NTHR * i, r = q >> 6, c8 = q & 63; const size_t off = (size_t)(rbase + r) * 512 + c8 * 8;
        const u32x4 yl = __builtin_nontemporal_load((const GAS u32x4*)(YLG + off)), pg = __builtin_nontemporal_load((const GAS u32x4*)(PGi + off));
        const f32x4 h0 = *(const LAS f32x4*)(HIN + c8 * 8), h1 = *(const LAS f32x4*)(HIN + c8 * 8 + 4);
        u32x4 o;
        o.x = cvt_pk_bf16(bflo(yl.x) + bflo(pg.x) * h0.x, bfhi(yl.x) + bfhi(pg.x) * h0.y);
        o.y = cvt_pk_bf16(bflo(yl.y) + bflo(pg.y) * h0.z, bfhi(yl.y) + bfhi(pg.y) * h0.w);
        o.z = cvt_pk_bf16(bflo(yl.z) + bflo(pg.z) * h1.x, bfhi(yl.z) + bfhi(pg.z) * h1.y);
        o.w = cvt_pk_bf16(bflo(yl.w) + bflo(pg.w) * h1.z, bfhi(yl.w) + bfhi(pg.w) * h1.w);
        *(GAS u32x4*)(Y + (size_t)(rbase + r) * 1024 + c8 * 8) = o; }
    __syncthreads();
}
}
namespace fk {
__device__ __forceinline__ float fast_logsigm(float z) {
    const float az = fabsf(z); const float e = __builtin_amdgcn_exp2f(-az * LOG2E);
    return fminf(z, 0.f) - 0.6931471805599453f * __builtin_amdgcn_logf(1.f + e);
}
__device__ __forceinline__ s16x4 tr16(const LAS void* p) { typedef short v4i16_t __attribute__((ext_vector_type(4))); return __builtin_bit_cast(s16x4, __builtin_amdgcn_ds_read_tr16_b64_v4i16((LAS v4i16_t*)p)); }
#define MFMA32(a, b, c) __builtin_amdgcn_mfma_f32_32x32x16_bf16(a, b, c, 0, 0, 0)
__device__ __forceinline__ f32x16 zero16() { f32x16 z = f32x16{}; asm volatile("" : "+v"(z)); return z; }
__device__ __forceinline__ int crow32(int r, int hi) { return (r & 3) + 8 * (r >> 2) + 4 * hi; }

__device__ __forceinline__ void skinny_lr(Frame& F, int j, int rb, const pg8::SumSq ss) {
    const bf16_t* hb = (const bf16_t*)(F.ws + WS_HB); const bf16_t* Wt = (const bf16_t*)(F.ws + WS_SMALL + SM_WLR) + (size_t)j * 16 * 1024; float* LR = (float*)(F.ws + WS_LR);
    const int lane = F.lane, w = F.wave, fr = lane & 15, fq = lane >> 4, mb = w & 3, kh = w >> 2;
    const bf16_t* ap = hb + (size_t)(rb * 64 + mb * 16 + fr) * D + kh * 512 + 8 * fq; const bf16_t* bp = Wt + (size_t)fr * D + kh * 512 + 8 * fq;
    f32x4 acc = (f32x4){0.f, 0.f, 0.f, 0.f};
#pragma unroll 8
    for (int s = 0; s < 16; ++s) { const bf16x8 av = *(const GAS bf16x8*)(ap + 32 * s), bv = *(const GAS bf16x8*)(bp + 32 * s); acc = __builtin_amdgcn_mfma_f32_16x16x32_bf16(av, bv, acc, 0, 0, 0); }
    LAS float* red = (LAS float*)(F.lds);
#pragma unroll
    for (int r = 0; r < 4; ++r) red[w * 256 + (4 * fq + r) * 16 + fr] = acc[r];
    __syncthreads();
#pragma unroll
    for (int i = 0; i < 2; ++i) { const int o = F.tid + NTHR * i, row = o >> 4, col = o & 15, m = row >> 4, rr = row & 15;
        const float v = red[m * 256 + rr * 16 + col] + red[(4 + m) * 256 + rr * 16 + col]; const int grow = rb * 64 + row;
        LR[(size_t)grow * 16 + col] = v * pg8::inv_rms(ss, grow); }
    __syncthreads();
}

constexpr int GA_KST = 0;
constexpr int GA_VT = 18432;
constexpr int GA_LR = GA_VT + 36864;
constexpr int GA_QT = GA_LR + 4096;
constexpr int GA_QS = GA_QT + 2048;
constexpr int GA_KS = GA_QS + 17408;
constexpr int GA_OUT = GA_VT;
static_assert(GA_KS + 17408 <= RING_BYTES && GA_OUT + 69632 <= GA_KS + 17408, "gla prep lds");
struct GlaPrepRegs { u32x4 v[4], q[2], k[2]; f32x4 lr; float gw[16]; float gb; int gh; };
__device__ __forceinline__ void gla_prep_load(Frame& F, int item, GlaPrepRegs& R) {
    const int tid = F.tid; const int bh = item >> 6, n = item & 63, b = bh >> 2, h = bh & 3; const int r0 = b * SEQ + n * 64;
    const bf16_t* GQ = (const bf16_t*)(F.ws + WS_GQ); const bf16_t* GK = (const bf16_t*)(F.ws + WS_GK); const bf16_t* GV = (const bf16_t*)(F.ws + WS_GV); const float* LR = (const float*)(F.ws + WS_LR);
#pragma unroll
    for (int i = 0; i < 4; ++i) { const int q = tid + NTHR * i, t = q >> 5, c8 = q & 31; R.v[i] = *(const GAS u32x4*)(GV + (size_t)(r0 + t) * 1024 + h * 256 + c8 * 8); }
#pragma unroll
    for (int i = 0; i < 2; ++i) { const int q = tid + NTHR * i, t = q >> 4, c8 = q & 15; const size_t go = (size_t)(r0 + t) * 512 + h * 128 + c8 * 8; R.q[i] = __builtin_nontemporal_load((const GAS u32x4*)(GQ + go)); R.k[i] = __builtin_nontemporal_load((const GAS u32x4*)(GK + go)); }
    R.lr = *(const GAS f32x4*)(LR + (size_t)r0 * 16 + (tid & 255) * 4);
}
__device__ __forceinline__ void gla_prep(Frame& F, const Args& a, int j, int item, int next_item, GlaPrepRegs& R) {
    const int tid = F.tid, lane = F.lane, w = F.wave; LAS unsigned char* L = F.lds;
    const int bh = item >> 6, n = item & 63, b = bh >> 2, h = bh & 3; const int r0 = b * SEQ + n * 64;
    bf16_t* GQ = (bf16_t*)(F.ws + WS_GQ); bf16_t* GK = (bf16_t*)(F.ws + WS_GK);
    float* DEC = (float*)(F.ws + WS_DEC); bf16_t* KVT = (bf16_t*)(F.ws + WS_KVT) + (size_t)item * 32768;
    if (R.gh != h) { const int gd_ = h * 128 + (tid & 127);
#pragma unroll
        for (int r = 0; r < 16; ++r) R.gw[r] = a.in[18][(size_t)j * 8192 + r * 512 + gd_];
        R.gb = a.in[19][j * 512 + gd_]; R.gh = h; }
#pragma unroll
    for (int i = 0; i < 4; ++i) { const int q = tid + NTHR * i, t = q >> 5, c8 = q & 31; *(LAS u32x4*)(L + GA_VT + t * 576 + c8 * 16) = R.v[i]; }
#pragma unroll
    for (int i = 0; i < 2; ++i) { const int q = tid + NTHR * i, t = q >> 4, c8 = q & 15; *(LAS u32x4*)(L + GA_QS + t * 272 + c8 * 16) = R.q[i]; *(LAS u32x4*)(L + GA_KS + t * 272 + c8 * 16) = R.k[i]; }
    if (tid < 256) *(LAS f32x4*)(L + GA_LR + tid * 16) = R.lr;
    __syncthreads();
    if (next_item >= 0) gla_prep_load(F, next_item, R);
    const int d = tid & 127, tq = tid >> 7, gd = h * 128 + d;
    float gw[16];
#pragma unroll
    for (int r = 0; r < 16; ++r) gw[r] = R.gw[r];
    const float gb = R.gb; (void)gd;
    float bl[16]; float run = 0.f;
#pragma unroll
    for (int i = 0; i < 16; ++i) { const int t = 16 * tq + i; const LAS f32x4* lp = (const LAS f32x4*)(L + GA_LR + t * 64); float z = gb;
#pragma unroll
        for (int r4 = 0; r4 < 4; ++r4) { const f32x4 x = lp[r4]; z = fmaf(x.x, gw[4 * r4], z); z = fmaf(x.y, gw[4 * r4 + 1], z); z = fmaf(x.z, gw[4 * r4 + 2], z); z = fmaf(x.w, gw[4 * r4 + 3], z); }
        run += fast_logsigm(z) * (1.f / 16.f); bl[i] = run; }
    LAS float* QT = (LAS float*)(L + GA_QT);
    QT[tq * 128 + d] = run;
    __syncthreads();
    float offs = 0.f, blast = 0.f;
#pragma unroll
    for (int q = 0; q < 4; ++q) { const float v = QT[q * 128 + d]; blast += v; if (q < tq) offs += v; }
    if (tq == 0) DEC[(size_t)item * 128 + d] = fast_exp(blast);
    { LAS bf16_t* qs = (LAS bf16_t*)(L + GA_QS); LAS bf16_t* ks_ = (LAS bf16_t*)(L + GA_KS);
      unsigned ks[8];
#pragma unroll
      for (int i = 0; i < 16; i += 2) {
          float kst[2];
#pragma unroll
          for (int u = 0; u < 2; ++u) { const int t = 16 * tq + i + u; const float bb = bl[i + u] + offs;
              const float qv = bf2f(qs[t * 136 + d]), kv = bf2f(ks_[t * 136 + d]); const float eb = fast_exp(bb);
              qs[t * 136 + d] = (bf16_t)f2bf(qv * GLA_QS * eb); ks_[t * 136 + d] = (bf16_t)f2bf(kv * __builtin_amdgcn_rcpf(eb)); kst[u] = kv * fast_exp(blast - bb); }
          ks[i >> 1] = cvt_pk_bf16(kst[0], kst[1]); }
      *(LAS u32x4*)(L + GA_KST + d * 144 + tq * 32) = (u32x4){ks[0], ks[1], ks[2], ks[3]};
      *(LAS u32x4*)(L + GA_KST + d * 144 + tq * 32 + 16) = (u32x4){ks[4], ks[5], ks[6], ks[7]}; }
    __syncthreads();
#pragma unroll
    for (int i = 0; i < 2; ++i) { const int q = tid + NTHR * i, t = q >> 4, c8 = q & 15; const size_t go = (size_t)(r0 + t) * 512 + h * 128 + c8 * 8;
        *(GAS u32x4*)(GQ + go) = *(const LAS u32x4*)(L + GA_QS + t * 272 + c8 * 16); *(GAS u32x4*)(GK + go) = *(const LAS u32x4*)(L + GA_KS + t * 272 + c8 * 16); }
    const int r = lane & 31, hh = lane >> 5, g = lane >> 4, i16 = lane & 15;
    f32x16 acc[4];
#pragma unroll
    for (int nb = 0; nb < 4; ++nb) acc[nb] = zero16();
#pragma unroll
    for (int s = 0; s < 4; ++s) {
        const LAS unsigned char* vp = L + GA_VT + (16 * s + 8 * (g >> 1) + (i16 >> 2)) * 576 + (32 * w + 16 * (g & 1) + 4 * (i16 & 3)) * 2;
        const s16x4 lo = tr16(vp), hi4 = tr16(vp + 4 * 576);
        const bf16x8 af = (bf16x8){lo[0], lo[1], lo[2], lo[3], hi4[0], hi4[1], hi4[2], hi4[3]};
#pragma unroll
        for (int nb = 0; nb < 4; ++nb) { const bf16x8 bf = *(const LAS bf16x8*)(L + GA_KST + (32 * nb + r) * 144 + (16 * s + 8 * hh) * 2); acc[nb] = MFMA32(bf, af, acc[nb]); }
    }
    __syncthreads();
    asm volatile("s_nop 15\n\ts_nop 7" : "+v"(acc[0]), "+v"(acc[1]), "+v"(acc[2]), "+v"(acc[3]));
#pragma unroll
    for (int nb = 0; nb < 4; ++nb)
#pragma unroll
        for (int q = 0; q < 4; ++q) { u32x2 o; o.x = cvt_pk_bf16(acc[nb][4 * q], acc[nb][4 * q + 1]); o.y = cvt_pk_bf16(acc[nb][4 * q + 2], acc[nb][4 * q + 3]);
            *(LAS u32x2*)(L + GA_OUT + (32 * w + r) * 272 + (32 * nb + 8 * q + 4 * hh) * 2) = o; }
    __syncthreads();
#pragma unroll
    for (int i = 0; i < 8; ++i) { const int q = tid + NTHR * i, dv = q >> 4, c8 = q & 15; *(GAS u32x4*)(KVT + (size_t)dv * 128 + c8 * 8) = *(const LAS u32x4*)(L + GA_OUT + dv * 272 + c8 * 16); }
    __syncthreads();
}

__device__ __forceinline__ void gla_state(Frame& F, int gtid) {
    const int bh = gtid >> 13, rem = gtid & 8191; const size_t eo = (size_t)(rem >> 5) * 128 + (rem & 31) * 4; const int dk0 = (rem & 31) * 4;
    const bf16_t* KVT = (const bf16_t*)(F.ws + WS_KVT) + (size_t)bh * 64 * 32768 + eo; bf16_t* SNT = (bf16_t*)(F.ws + WS_SNT) + (size_t)bh * 64 * 32768 + eo;
    const float* DEC = (const float*)(F.ws + WS_DEC) + (size_t)bh * 64 * 128 + dk0;
    f32x4 s = (f32x4){0.f, 0.f, 0.f, 0.f};
    for (int n0 = 0; n0 < 64; n0 += 8) {
        u32x2 kv[8]; f32x4 dc[8];
#pragma unroll
        for (int u = 0; u < 8; ++u) { kv[u] = __builtin_nontemporal_load((const GAS u32x2*)(KVT + (size_t)(n0 + u) * 32768));     dc[u] = *(const GAS f32x4*)(DEC + (size_t)(n0 + u) * 128); }
#pragma unroll
        for (int u = 0; u < 8; ++u) { u32x2 o; o.x = cvt_pk_bf16(s.x, s.y); o.y = cvt_pk_bf16(s.z, s.w); *(GAS u32x2*)(SNT + (size_t)(n0 + u) * 32768) = o;
            s.x = dc[u].x * s.x + bflo(kv[u].x); s.y = dc[u].y * s.y + bfhi(kv[u].x); s.z = dc[u].z * s.z + bflo(kv[u].y); s.w = dc[u].w * s.w + bfhi(kv[u].y); }
    }
}

constexpr int GC_QD = 0;
constexpr int GC_KI = 17408;
constexpr int GC_VT = 34816;
constexpr int GC_XT = GC_VT + 36864;
constexpr int GC_GT = GC_XT + 9216;
constexpr int GC_SQ = GC_GT + 33792;
constexpr int GC_HN = GC_SQ + 2048;
static_assert(GC_HN + 1024 <= RING_BYTES, "gla lds");
struct GlaOutRegs { u32x4 qd[2], ki[2], vt[4], gt[4]; bf16x8 sn[8]; };
__device__ __forceinline__ void gla_out_load(Frame& F, int item, GlaOutRegs& R) {
    const int tid = F.tid, lane = F.lane, w = F.wave; const int bh = item >> 6, n = item & 63, b = bh >> 2, h = bh & 3; const int r0 = b * SEQ + n * 64;
    const bf16_t* GQ = (const bf16_t*)(F.ws + WS_GQ); const bf16_t* GK = (const bf16_t*)(F.ws + WS_GK); const bf16_t* GV = (const bf16_t*)(F.ws + WS_GV); const bf16_t* GG = (const bf16_t*)(F.ws + WS_GG);
    const bf16_t* SNT = (const bf16_t*)(F.ws + WS_SNT) + (size_t)item * 32768;
#pragma unroll
    for (int i = 0; i < 2; ++i) { const int q = tid + NTHR * i, t = q >> 4, c8 = q & 15; const size_t go = (size_t)(r0 + t) * 512 + h * 128 + c8 * 8; R.qd[i] = __builtin_nontemporal_load((const GAS u32x4*)(GQ + go)); R.ki[i] = __builtin_nontemporal_load((const GAS u32x4*)(GK + go)); }
#pragma unroll
    for (int i = 0; i < 4; ++i) { const int q = tid + NTHR * i, t = q >> 5, c8 = q & 31; const size_t go = (size_t)(r0 + t) * 1024 + h * 256 + c8 * 8; R.vt[i] = __builtin_nontemporal_load((const GAS u32x4*)(GV + go)); R.gt[i] = __builtin_nontemporal_load((const GAS u32x4*)(GG + go)); }
    const int r = lane & 31, hh = lane >> 5;
#pragma unroll
    for (int s = 0; s < 8; ++s) R.sn[s] = __builtin_nontemporal_load((const GAS bf16x8*)(SNT + (size_t)(32 * w + r) * 128 + 16 * s + 8 * hh));
}
__device__ __forceinline__ void gla_out(Frame& F, const Args& a, int j, int item, int next_item, GlaOutRegs& R) {
    const int tid = F.tid, lane = F.lane, w = F.wave; LAS unsigned char* L = F.lds;
    const int bh = item >> 6, n = item & 63, b = bh >> 2, h = bh & 3; const int r0 = b * SEQ + n * 64;
    bf16_t* OG = (bf16_t*)(F.ws + WS_OG);
#pragma unroll
    for (int i = 0; i < 2; ++i) { const int q = tid + NTHR * i, t = q >> 4, c8 = q & 15; *(LAS u32x4*)(L + GC_QD + t * 272 + c8 * 16) = R.qd[i]; *(LAS u32x4*)(L + GC_KI + t * 272 + c8 * 16) = R.ki[i]; }
#pragma unroll
    for (int i = 0; i < 4; ++i) { const int q = tid + NTHR * i, t = q >> 5, c8 = q & 31; *(LAS u32x4*)(L + GC_VT + t * 576 + c8 * 16) = R.vt[i]; *(LAS u32x4*)(L + GC_GT + t * 528 + c8 * 16) = R.gt[i]; }
    __syncthreads();
    const int r = lane & 31, hh = lane >> 5, g = lane >> 4, i16 = lane & 15;
    if (w < 4) {
        const int jb = w >> 1, ib = w & 1;
        f32x16 x = zero16();
        if (!(jb == 1 && ib == 0)) {
#pragma unroll
            for (int s = 0; s < 8; ++s) { const bf16x8 af = *(const LAS bf16x8*)(L + GC_KI + (32 * jb + r) * 272 + (16 * s + 8 * hh) * 2), bf = *(const LAS bf16x8*)(L + GC_QD + (32 * ib + r) * 272 + (16 * s + 8 * hh) * 2);
                x = MFMA32(af, bf, x); }
        }
        const int i = 32 * ib + r;
#pragma unroll
        for (int q4 = 0; q4 < 4; ++q4) { float v[4];
#pragma unroll
            for (int q = 0; q < 4; ++q) { const int jj = 32 * jb + 8 * q4 + 4 * hh + q; v[q] = (jj <= i) ? x[4 * q4 + q] : 0.f; }
            u32x2 o; o.x = cvt_pk_bf16(v[0], v[1]); o.y = cvt_pk_bf16(v[2], v[3]);
            *(LAS u32x2*)(L + GC_XT + i * 144 + (32 * jb + 8 * q4 + 4 * hh) * 2) = o; }
    }
    f32x16 acc[2]; acc[0] = zero16(); acc[1] = zero16();
#pragma unroll
    for (int s = 0; s < 8; ++s) {
#pragma unroll
        for (int ib = 0; ib < 2; ++ib) { const bf16x8 bf = *(const LAS bf16x8*)(L + GC_QD + (32 * ib + r) * 272 + (16 * s + 8 * hh) * 2); acc[ib] = MFMA32(R.sn[s], bf, acc[ib]); } }
    if (next_item >= 0) gla_out_load(F, next_item, R);
    __syncthreads();
#pragma unroll
    for (int s = 0; s < 4; ++s) {
        const LAS unsigned char* vp = L + GC_VT + (16 * s + 8 * (g >> 1) + (i16 >> 2)) * 576 + (32 * w + 16 * (g & 1) + 4 * (i16 & 3)) * 2;
        const s16x4 lo = tr16(vp), hi4 = tr16(vp + 4 * 576);
        const bf16x8 af = (bf16x8){lo[0], lo[1], lo[2], lo[3], hi4[0], hi4[1], hi4[2], hi4[3]};
#pragma unroll
        for (int ib = 0; ib < 2; ++ib) { const bf16x8 bf = *(const LAS bf16x8*)(L + GC_XT + (32 * ib + r) * 144 + (16 * s + 8 * hh) * 2); acc[ib] = MFMA32(af, bf, acc[ib]); } }
    LAS float* SQ = (LAS float*)(L + GC_SQ);
#pragma unroll
    for (int ib = 0; ib < 2; ++ib) { float s2 = 0.f;
#pragma unroll
        for (int rr = 0; rr < 16; ++rr) s2 += acc[ib][rr] * acc[ib][rr];
        s2 += __shfl_xor(s2, 32);
        if (hh == 0) SQ[w * 64 + 32 * ib + r] = s2; }
    __syncthreads();
    const LAS float* hn = (const LAS float*)(L + GC_HN);
#pragma unroll
    for (int ib = 0; ib < 2; ++ib) { const int i = 32 * ib + r; float tot = 0.f;
#pragma unroll
        for (int ww = 0; ww < 8; ++ww) tot += SQ[ww * 64 + i];
        const float inv = 1.0f / sqrtf(tot * (1.f / 256.f) + EPS);
#pragma unroll
        for (int q4 = 0; q4 < 4; ++q4) { const int dv = 32 * w + 8 * q4 + 4 * hh; LAS u32x2* gp = (LAS u32x2*)(L + GC_GT + i * 528 + dv * 2);
            const u32x2 gv = *gp; const f32x4 hw = *(const LAS f32x4*)(hn + dv);
            const float o0 = acc[ib][4 * q4 + 0] * inv * hw.x * fast_silu(bflo(gv.x)), o1 = acc[ib][4 * q4 + 1] * inv * hw.y * fast_silu(bfhi(gv.x));
            const float o2 = acc[ib][4 * q4 + 2] * inv * hw.z * fast_silu(bflo(gv.y)), o3 = acc[ib][4 * q4 + 3] * inv * hw.w * fast_silu(bfhi(gv.y));
            u32x2 o; o.x = cvt_pk_bf16(o0, o1); o.y = cvt_pk_bf16(o2, o3); *gp = o; } }
    __syncthreads();
    for (int q = tid; q < 2048; q += NTHR) { const int t = q >> 5, c8 = q & 31; *(GAS u32x4*)(OG + (size_t)(r0 + t) * 1024 + h * 256 + c8 * 8) = *(const LAS u32x4*)(L + GC_GT + t * 528 + c8 * 16); }
    __syncthreads();
}
}
namespace fk {
constexpr int RP_TAB = 0;
#ifndef RP_NR
#define RP_NR 4
#endif
constexpr int RP_SEL = 32768;
__device__ __forceinline__ void router_rows(Frame& F, const Args& a, int j, int rb, const f32x4 (&gk)[4]) {
    const int lane = F.lane, w = F.wave; LAS unsigned char* L = F.lds;
    const float* H = (const float*)(F.ws + WS_H); unsigned char* XN = (unsigned char*)(F.ws + WS_XN);
    LAS int* SEL = (LAS int*)(L + RP_SEL); LAS float* SELW = (LAS float*)(L + RP_SEL + 512);
    for (int r0 = 0; r0 < 8; r0 += RP_NR) {
        RowV rv[RP_NR];
#pragma unroll
        for (int u = 0; u < RP_NR; ++u) { if (BF16_RESID) row_load_bf16(rv[u], (const bf16_t*)(F.ws + WS_HB) + (size_t)(rb * 64 + w * 8 + r0 + u) * D, lane); else row_load(rv[u], H + (size_t)(rb * 64 + w * 8 + r0 + u) * D, lane); }
        float lga[RP_NR][8]; row_dots_n<8, RP_NR>(rv, (const LAS float*)(L + RP_TAB), lane, lga);
#pragma unroll
        for (int u = 0; u < RP_NR; ++u) { const int lrow = w * 8 + r0 + u, m = rb * 64 + lrow; RowV r = rv[u];
            const float ss = row_sumsq(r); const float inv = 1.0f / sqrtf(ss * (1.f / D) + EPS);
            float lg[8];
#pragma unroll
            for (int e = 0; e < 8; ++e) lg[e] = lga[u][e];
#pragma unroll
            for (int e = 0; e < 8; ++e) lg[e] *= inv;
            int i1 = 0; float v1 = lg[0];
#pragma unroll
            for (int e = 1; e < 8; ++e) if (lg[e] > v1) { v1 = lg[e]; i1 = e; }
            int i2 = -1; float v2 = -INFINITY;
#pragma unroll
            for (int e = 0; e < 8; ++e) if (e != i1 && (i2 < 0 || lg[e] > v2)) { v2 = lg[e]; i2 = e; }
            const float w1 = 1.f / (1.f + expf(v2 - v1)), w2 = 1.f - w1;
            if (lane == 0) { SEL[lrow * 2] = i1; SEL[lrow * 2 + 1] = i2; SELW[lrow * 2] = w1; SELW[lrow * 2 + 1] = w2; }
#pragma unroll
            for (int jj = 0; jj < 4; ++jj) r.v[jj] = r.v[jj] * gk[jj] * inv;
            row_store_fp8(r, XN + (size_t)m * D, lane); }
    }
    __syncthreads();
    if (w == 0) {
        unsigned* cnt = (unsigned*)(F.ctl + CW_CNT + 512 * j);
        int* TS = (int*)(F.ws + WS_RT + RT_TS); float* TW = (float*)(F.ws + WS_RT + RT_TW); int* TL = (int*)(F.ws + WS_RT + RT_TL);
        const int e0 = SEL[lane * 2], e1 = SEL[lane * 2 + 1]; const int m = rb * 64 + lane;
        int p0 = 0, p1 = 0; unsigned tot = 0;
        unsigned long long mk0[8], mk1[8];
#pragma unroll
        for (int e = 0; e < 8; ++e) { mk0[e] = __ballot(e0 == e); mk1[e] = __ballot(e1 == e); const unsigned c = (unsigned)(__popcll(mk0[e]) + __popcll(mk1[e])); tot = (lane == e) ? c : tot; }
        unsigned base = 0;
        if (lane < 8 && tot > 0) base = __hip_atomic_fetch_add(cnt + 64 * lane, tot, RLX_AGENT);
        const unsigned long long lt = (1ull << lane) - 1ull;
#pragma unroll
        for (int e = 0; e < 8; ++e) { const int be = (int)__shfl(base, e);
            if (e0 == e) p0 = be + __popcll(mk0[e] & lt);
            if (e1 == e) p1 = be + __popcll(mk0[e]) + __popcll(mk1[e] & lt); }
        TL[e0 * T + p0] = m; TL[e1 * T + p1] = m;
        TS[m * 2] = e0 * T + p0; TS[m * 2 + 1] = e1 * T + p1;
        TW[m * 2] = SELW[lane * 2]; TW[m * 2 + 1] = SELW[lane * 2 + 1];
    }
    __syncthreads();
}
constexpr int ROWTAB_OFF = RING_BYTES + 1024;
static_assert(ROWTAB_OFF + 15 * 1024 <= LDS_BYTES, "row table");
constexpr int MT_OFF = MISC_OFF + 256;
__device__ __forceinline__ void moe_tables(Frame& F, int j) {
    LAS int* tab = (LAS int*)(F.lds + MT_OFF);
    if (F.tid == 0) { const unsigned* cnt = (const unsigned*)(F.ctl + CW_CNT + 512 * j); int run = 0;
        for (int e = 0; e < 8; ++e) { const int c = (int)__hip_atomic_load(cnt + 64 * e, RLX_AGENT); tab[16 + e] = c; tab[e] = run; run += (c + 255) >> 8; }
        tab[8] = run; }
    __syncthreads();
}
__device__ __forceinline__ void combine_rows(Frame& F, const Args& a, int j, bool last) {
    const LAS int* tab = (const LAS int*)(F.lds + MT_OFF);
    float* H = (float*)(F.ws + WS_H); bf16_t* HB = (bf16_t*)(F.ws + WS_HB); float* ssa = (float*)(F.ws + WS_SMALL + SM_SSA); float* flog = (float*)(F.ws + WS_ESM + ES_FLOG);
    const int* TS = (const int*)(F.ws + WS_RT + RT_TS); const float* TW = (const float*)(F.ws + WS_RT + RT_TW); const bf16_t* YM = (const bf16_t*)(F.ws + WS_YM); const bf16_t* YM1 = (const bf16_t*)(F.ws + WS_YM1);
    const LAS float* Wl = (const LAS float*)(F.lds);
    const int gw = F.vcu * NWAVES + F.wave, NGW = F.G * NWAVES, lane = F.lane;
    f32x4 gf[4];
#pragma unroll
    for (int jj = 0; jj < 4; ++jj) gf[jj] = last ? *(const GAS f32x4*)(a.in[3] + 4 * lane + 256 * jj) : (f32x4){0.f, 0.f, 0.f, 0.f};
    for (int m0 = gw; m0 < T; m0 += 2 * NGW) {
        int sl[2][2]; float wv[2][2]; RowV rr[2]; u32x2 ya[2][2][4], yb[2][2][4];
#pragma unroll
        for (int u = 0; u < 2; ++u) { const int m = m0 + u * NGW; if (m < T) { const int s0 = TS[m * 2], s1 = TS[m * 2 + 1]; wv[u][0] = TW[m * 2]; wv[u][1] = TW[m * 2 + 1];
                sl[u][0] = 256 * tab[s0 >> 14] + (s0 & 16383); sl[u][1] = 256 * tab[s1 >> 14] + (s1 & 16383); } }
#pragma unroll
        for (int u = 0; u < 2; ++u) { const int m = m0 + u * NGW; if (m < T) { if (BF16_RESID) row_load_bf16(rr[u], HB + (size_t)m * D, lane); else row_load(rr[u], H + (size_t)m * D, lane);
#pragma unroll
                for (int k = 0; k < 2; ++k) { const GAS u32x2* y0 = (const GAS u32x2*)(YM + (size_t)sl[u][k] * D) + lane; const GAS u32x2* z0 = (const GAS u32x2*)(YM1 + (size_t)sl[u][k] * D) + lane;
#pragma unroll
                    for (int jj = 0; jj < 4; ++jj) { ya[u][k][jj] = __builtin_nontemporal_load(y0 + 64 * jj); yb[u][k][jj] = __builtin_nontemporal_load(z0 + 64 * jj); } } } }
#pragma unroll
        for (int u = 0; u < 2; ++u) { const int m = m0 + u * NGW; if (m < T) { RowV& r = rr[u]; const float w0 = wv[u][0], w1 = wv[u][1];
#pragma unroll
            for (int jj = 0; jj < 4; ++jj) { const u32x2 a0 = ya[u][0][jj], a1 = ya[u][1][jj], b0 = yb[u][0][jj], b1 = yb[u][1][jj];
                r.v[jj].x += w0 * (bflo(a0.x) + bflo(b0.x)) + w1 * (bflo(a1.x) + bflo(b1.x)); r.v[jj].y += w0 * (bfhi(a0.x) + bfhi(b0.x)) + w1 * (bfhi(a1.x) + bfhi(b1.x));
                r.v[jj].z += w0 * (bflo(a0.y) + bflo(b0.y)) + w1 * (bflo(a1.y) + bflo(b1.y)); r.v[jj].w += w0 * (bfhi(a0.y) + bfhi(b0.y)) + w1 * (bfhi(a1.y) + bfhi(b1.y)); } } }
        float dta[2][8];
        if (!last) row_dots_n<8, 2>(rr, Wl, lane, dta);
#pragma unroll
        for (int u = 0; u < 2; ++u) { const int m = m0 + u * NGW; if (m < T) { RowV r = rr[u];
            const float ss = row_sumsq(r); const float inv = 1.0f / sqrtf(ss * (1.f / D) + EPS);
            if (!last) {
                if (!BF16_RESID) row_store_f32(r, H + (size_t)m * D, lane); row_store_bf16(r, HB + (size_t)m * D, lane);
#if E1_I8
                { const float st = row_store_i8max(r, (unsigned char*)(F.ws + WS_HB8E) + (size_t)m * D, lane); if (lane == 0) ((float*)(F.ws + WS_SMALL + SM_STEPE))[m] = st; }
#endif
                if (lane == 0) ssa[m] = ss;
                float dts[8];
#pragma unroll
                for (int c = 0; c < 8; ++c) dts[c] = dta[u][c];
                if (lane < 8) { float v = dts[0];
#pragma unroll
                    for (int c = 1; c < 8; ++c) v = (lane == c) ? dts[c] : v;
                    flog[m * 8 + lane] = v * inv; }
            } else {
#pragma unroll
                for (int jj = 0; jj < 4; ++jj) r.v[jj] = r.v[jj] * gf[jj] * inv;
                row_store_f32(r, a.out + (size_t)m * D, lane);
            } } }
    }
}

#ifndef PHMASK
#define PHMASK 0xffff
#endif
#define PHC(k) (((PHMASK) >> (k)) & 1)
#ifndef PHREP
#define PHREP 0
#endif
#define REPK(k) (((PHREP) >> (k)) & 1)
constexpr int PH_PER_PAIR = 15, N_PHASES = 1 + 2 * PH_PER_PAIR;
#ifndef PROBE_PHASE
#define PROBE_PHASE -1
#endif
#define PROBE_BEGIN(k) do { if (PROBE_PHASE == (k) && blockIdx.x == 0 && threadIdx.x == 0) pr_t0 = __builtin_amdgcn_s_memrealtime(); } while (0)
#define PROBE_END(k) do { if (PROBE_PHASE == (k) && blockIdx.x == 0 && threadIdx.x == 0) pr_acc += __builtin_amdgcn_s_memrealtime() - pr_t0; } while (0)
#define IN(k) (lo <= (k) && (k) < hi)
#ifndef LRU_HALF
#define LRU_HALF 0
#endif
#ifndef SEAM_REP
#define SEAM_REP 1
#endif
#define SEAM(k) do { if (IN(k) && IN((k) + 1)) { for (int sr_ = 0; sr_ < SEAM_REP; ++sr_) xcd_barrier(bar); } } while (0)

#if BF16_RESID && !defined(EPIRES_OLD)
#define EPIRES_T(fb) pg8::EpiResB<(fb)>
#else
#define EPIRES_T(fb) pg8::EpiResT<BF16_RESID != 0>
#endif
__device__ __forceinline__ int o4b_share(int tf) { const int cap = (256 - tf) * NWAVES * 4; return cap < CV_O4B ? cap : CV_O4B; }
template <int J> __device__ __forceinline__ void pair_body(Frame& F, const Args& args, const int lo, const int hi, const XcdBarrier& bar, unsigned char* lds_raw, unsigned long long& pr_acc) {
    unsigned long long pr_t0 = 0;
    constexpr int j = J, pb = 1 + J * PH_PER_PAIR;
    const int cblk = (int)blockIdx.x;
    float* H = (float*)(F.ws + WS_H); bf16_t* HB = (bf16_t*)(F.ws + WS_HB);
    float* SSA = (float*)(F.ws + WS_SMALL + SM_SSA);
    unsigned long long* SSB = (unsigned long long*)(F.ws + CTL_SS) + (size_t)j * T; unsigned long long* SSC = (unsigned long long*)(F.ws + CTL_SS) + (size_t)(2 + j) * T;
    PROBE_BEGIN(0);
    if (PHC(0) && IN(pb + 0)) { auto body_ = [&]() { Frame Fq_ = F; { int t_ = threadIdx.x; asm volatile("" : "+v"(t_)); Fq_.tid = t_; Fq_.lane = t_ & 63; } Frame& F = Fq_;
#if E1_I8
        pg8::DenseSched S; S.init(F.ws + WS_HB8E, (const unsigned char*)(F.ws + WS_WINE) + (size_t)j * 2560 * D, T, 2560, D, F.G, cblk, 1);
        pg8::EpiProjI8<0> E{pg8::SumSq{SSA, nullptr}, pg8::SumSq{nullptr, nullptr}, (const float*)(F.ws + CTL_WMAXE) + j * 2560, (bf16_t*)(F.ws + WS_XR), 512, C2, (const float*)(F.ws + WS_SMALL + SM_STEPE)};
        pg8::gemm_phase<pg8::EpiProjI8<0>, pg8::DenseSched, true, true, 1, true>(F.lds, D, D, S, E);
#else
        pg8::DenseSched S; S.init(HB, (const bf16_t*)(F.ws + WS_WINE) + (size_t)j * 2560 * D, T, 2560, D, F.G, cblk);
        pg8::EpiProj<0> E{pg8::SumSq{SSA, nullptr}, (bf16_t*)(F.ws + WS_XR), 512, C2, nullptr};
        pg8::gemm_phase<pg8::EpiProj<0>, pg8::DenseSched, true, true>(F.lds, D, D, S, E);
#endif
        { pg8::Unit u_; if (!S.next(2, u_) && F.G == 256) convert_experts_range(F, args, j, (j == 1 ? CV_PRE + CV_O4B : 0), (j == 1 ? CV_PRE + CV_O4B : 0) + CV_T1, (cblk - 128) * NWAVES + F.wave, 128 * NWAVES); }
    }; body_(); if (REPK(0)) body_(); }
    SEAM(pb + 0);
    PROBE_END(0);
    PROBE_BEGIN(1);
    if (PHC(1) && IN(pb + 1)) { auto body_ = [&]() { Frame Fq_ = F; { int t_ = threadIdx.x; asm volatile("" : "+v"(t_)); Fq_.tid = t_; Fq_.lane = t_ & 63; } Frame& F = Fq_;
#if P0_SPLIT == 2 && P0_STREAM && CQ_LOCAL
        if (j == 0) { convert_bf16_pair(F, args, 0, 0, 960); colquant_pair(F, args, 0, 0, 176); __syncthreads(); }
#endif
#if IN_O_I8 && !CQ_LOCAL
        quantize_wino(F, args, j);
#endif
#if FFN_UP_I8 && !CQ_LOCAL
        quantize_w13(F, args, j);
        __syncthreads();
#endif
#if IN_O_I8 && !FFN_UP_I8
        __syncthreads();
#endif
#if LRU_HALF
        for (int base = F.vcu * NWAVES; base < 2048; base += F.G * NWAVES) { if (F.wave < 4) {
#pragma unroll 1
            for (int q = 0; q < 2; ++q) lru_wave_task(F, args, j, base + F.wave + 4 * q); } }
#else
        for (int tk = F.vcu * NWAVES + F.wave; tk < 2048; tk += F.G * NWAVES) lru_wave_task(F, args, j, tk);
#endif
        __syncthreads();
        PROBE_BEGIN(22); for (int it = F.vcu; it < 256; it += F.G) fox_cumsum(F, args, j, it); PROBE_END(22);
    }; body_(); if (REPK(1)) body_(); }
    SEAM(pb + 1);
    PROBE_END(1);
    PROBE_BEGIN(2);
    if (PHC(2) && IN(pb + 2)) { auto body_ = [&]() { Frame Fq_ = F; { int t_ = threadIdx.x; asm volatile("" : "+v"(t_)); Fq_.tid = t_; Fq_.lane = t_ & 63; } Frame& F = Fq_;
        for (int p = F.vcu; p < 256; p += F.G) { const int bh = p >> 3, s = p & 7; const float* cp = (const float*)(F.ws + WS_ESM + ES_CP) + (size_t)bh * SEQ; const float* ksg = (const float*)(F.ws + WS_SMALL + SM_KMAX) + bh * 8; float kmax = 0.f;
#pragma unroll
            for (int q = 0; q < 8; ++q) kmax = fmaxf(kmax, ksg[q]);
            kmax = sqrtf(kmax) * 1.002f; const float* segt = ksg + 256;
            attn_body::attn_unit<8>(bh >> 3, bh & 7, s, (const attn_body::bf16*)(F.ws + WS_Q), (const attn_body::bf16*)(F.ws + WS_K), (const attn_body::bf16*)(F.ws + WS_V), (attn_body::bf16*)(F.ws + WS_Y), cp, segt, kmax, (char*)lds_raw);
            attn_body::attn_unit<8>(bh >> 3, bh & 7, 15 - s, (const attn_body::bf16*)(F.ws + WS_Q), (const attn_body::bf16*)(F.ws + WS_K), (const attn_body::bf16*)(F.ws + WS_V), (attn_body::bf16*)(F.ws + WS_Y), cp, segt, kmax, (char*)lds_raw); }
        __syncthreads();
        for (int it = F.vcu; it < 256; it += F.G) lru_fixup(F, it >> 6, it & 63);
    }; body_(); if (REPK(2)) body_(); }
    SEAM(pb + 2);
    PROBE_END(2);
    PROBE_BEGIN(3);
    if (PHC(3) && IN(pb + 3)) { auto body_ = [&]() { Frame Fq_ = F; { int t_ = threadIdx.x; asm volatile("" : "+v"(t_)); Fq_.tid = t_; Fq_.lane = t_ & 63; } Frame& F = Fq_;
        pg8::DenseSched S; S.init((const bf16_t*)(F.ws + WS_Y), (const bf16_t*)(F.ws + WS_WOUTE) + (size_t)j * D * D, T, D, D, F.G, cblk);
        EPIRES_T(j == 0) E{(j == 0) ? args.in[0] : (BF16_RESID ? nullptr : H), HB, H, (FFN_UP_FP8 && !BF16_RESID) ? nullptr : HB, SSB, (FFN_UP_FP8 || FFN_UP_I8) ? (unsigned char*)(F.ws + WS_HB8) : nullptr, pg8::SumSq{FFN_UP_I8 ? SSA : nullptr, nullptr}};
        pg8::gemm_phase<EPIRES_T(j == 0), pg8::DenseSched, false, true>(F.lds, D, D, S, E);
    }; body_(); if (REPK(3)) body_(); }
    SEAM(pb + 3);
    PROBE_END(3);
    PROBE_BEGIN(4);
    if (PHC(4) && IN(pb + 4)) { auto body_ = [&]() { Frame Fq_ = F; { int t_ = threadIdx.x; asm volatile("" : "+v"(t_)); Fq_.tid = t_; Fq_.lane = t_ & 63; } Frame& F = Fq_;
#if FFN_UP_I8
        pg8::DenseSched S; S.init(F.ws + WS_HB8, (const unsigned char*)(F.ws + WS_W13F) + (size_t)j * 2 * DFF * D, T, 2 * DFF, D, F.G, cblk, 1);
        pg8::EpiGluI8 E{pg8::SumSq{nullptr, SSB}, pg8::SumSq{SSA, nullptr}, (const float*)(F.ws + CTL_WMAX) + j * 2 * DFF, (bf16_t*)(F.ws + WS_HF), DFF};
        pg8::gemm_phase<pg8::EpiGluI8, pg8::DenseSched, true, true, 1, true>(F.lds, D, D, S, E);
        { pg8::Unit u_; if (!S.next(5, u_) && F.G == 256) convert_experts_range(F, args, j, (j == 1 ? CV_PRE + CV_O4B : 0) + CV_T1, (j == 1 ? CV_PRE + CV_O4B : 0) + CV_T1 + CV_T2, (cblk - 128) * NWAVES + F.wave, 128 * NWAVES); }
#elif FFN_UP_FP8
        pg8::DenseSched S; S.init(F.ws + WS_HB8, (const unsigned char*)(F.ws + WS_W13F) + (size_t)j * 2 * DFF * D, T, 2 * DFF, D, F.G, cblk, 1);
        pg8::EpiGluT<FFN_DN_FP8 != 0> E{pg8::SumSq{nullptr, SSB}, (void*)(F.ws + WS_HF), DFF};
        pg8::gemm_phase<pg8::EpiGluT<FFN_DN_FP8 != 0>, pg8::DenseSched, true, true, 1>(F.lds, D, D, S, E, W13_SCALE);
        { pg8::Unit u_; if (!S.next(5, u_) && F.G == 256) convert_experts_range(F, args, j, (j == 1 ? CV_PRE + CV_O4B : 0) + CV_T1, (j == 1 ? CV_PRE + CV_O4B : 0) + CV_T1 + CV_T2, (cblk - 128) * NWAVES + F.wave, 128 * NWAVES); }
#else
        pg8::DenseSched S; S.init(HB, (const bf16_t*)(F.ws + WS_W13F) + (size_t)j * 2 * DFF * D, T, 2 * DFF, D, F.G, cblk);
        pg8::EpiGluT<FFN_DN_FP8 != 0> E{pg8::SumSq{nullptr, SSB}, (void*)(F.ws + WS_HF), DFF};
        pg8::gemm_phase<pg8::EpiGluT<FFN_DN_FP8 != 0>, pg8::DenseSched, true, true>(F.lds, D, D, S, E);
        { pg8::Unit u_; if (!S.next(5, u_) && F.G == 256) convert_experts_range(F, args, j, (j == 1 ? CV_PRE + CV_O4B : 0) + CV_T1, (j == 1 ? CV_PRE + CV_O4B : 0) + CV_T1 + CV_T2, (cblk - 128) * NWAVES + F.wave, 128 * NWAVES); }
#endif
    }; body_(); if (REPK(4)) body_(); }
    SEAM(pb + 4);
    PROBE_END(4);
    PROBE_BEGIN(5);
    if (PHC(5) && IN(pb + 5)) { auto body_ = [&]() { Frame Fq_ = F; { int t_ = threadIdx.x; asm volatile("" : "+v"(t_)); Fq_.tid = t_; Fq_.lane = t_ & 63; } Frame& F = Fq_;
#if FFN_DN_FP8
        pg8::DenseSched S; S.init(F.ws + WS_HF, (const unsigned char*)(F.ws + WS_W2F) + (size_t)j * D * DFF, T, D, DFF, F.G, cblk, 1);
        EPIRES_T(false) E{BF16_RESID ? nullptr : H, HB, H, HB, SSC, (IN_O_I8 == 1) ? (unsigned char*)(F.ws + WS_HB8O) : nullptr, pg8::SumSq{nullptr, (IN_O_I8 == 1) ? SSB : nullptr}};
        pg8::gemm_phase<EPIRES_T(false), pg8::DenseSched, false, true, 1>(F.lds, DFF, DFF, S, E, W2_SCALE);
#else
        pg8::DenseSched S; S.init((const bf16_t*)(F.ws + WS_HF), (const bf16_t*)(F.ws + WS_W2F) + (size_t)j * D * DFF, T, D, DFF, F.G, cblk);
        EPIRES_T(false) E{BF16_RESID ? nullptr : H, HB, H, HB, SSC, (IN_O_I8 == 1) ? (unsigned char*)(F.ws + WS_HB8O) : nullptr, pg8::SumSq{nullptr, (IN_O_I8 == 1) ? SSB : nullptr}};
        pg8::gemm_phase<EPIRES_T(false), pg8::DenseSched, false, true>(F.lds, DFF, DFF, S, E);
#endif
    }; body_(); if (REPK(5)) body_(); }
    SEAM(pb + 5);
    PROBE_END(5);
    PROBE_BEGIN(6);
    if (PHC(6) && IN(pb + 6)) { auto body_ = [&]() { Frame Fq_ = F; { int t_ = threadIdx.x; asm volatile("" : "+v"(t_)); Fq_.tid = t_; Fq_.lane = t_ & 63; } Frame& F = Fq_;
#if IN_O_I8 == 2
        {
            const bf16_t* hbq = (const bf16_t*)(F.ws + WS_HB); unsigned char* q8 = (unsigned char*)(F.ws + WS_HB8O); float* stp = (float*)(F.ws + WS_SMALL + SM_STEPO);
            const int gwq = F.vcu * NWAVES + F.wave, NGWQ = F.G * NWAVES;
            for (int m0 = gwq; m0 < T; m0 += 4 * NGWQ) { RowV rq[4];
#pragma unroll
                for (int u = 0; u < 4; ++u) { const int m = m0 + u * NGWQ; if (m < T) row_load_bf16(rq[u], hbq + (size_t)m * D, F.lane); }
#pragma unroll
                for (int u = 0; u < 4; ++u) { const int m = m0 + u * NGWQ; if (m < T) { const float st = row_store_i8max(rq[u], q8 + (size_t)m * D, F.lane); if (F.lane == 0) stp[m] = st; } } }
            split_arrive((unsigned*)(F.ctl + CW_SPLIT + 64 * j));
        }
#endif
        PROBE_BEGIN(23);
        {
            const int wk = F.vcu * NWAVES + F.wave, nw = F.G * NWAVES;
            if (F.G != 256) convert_experts_range(F, args, j, 0, CV_ITEMS, wk, nw);
            else if (j == 0) convert_experts_range(F, args, j, CV_T1 + CV_T2, CV_ITEMS, wk, nw);
            else { int nm0 = 0; { const unsigned* c0 = (const unsigned*)(F.ctl + CW_CNT);
#pragma unroll
                    for (int e = 0; e < 8; ++e) nm0 += ((int)__builtin_amdgcn_readfirstlane(__hip_atomic_load(c0 + 64 * e, RLX_AGENT)) + 255) >> 8; }
                if (tail_first(8 * nm0) >= 256) convert_experts_range(F, args, j, 0, CV_PRE, wk, nw);
                if (CV_O4B > 0) { const int nx = o4b_share(tail_first(28 * nm0)); if (nx < CV_O4B) convert_experts_range(F, args, j, CV_PRE + nx, CV_PRE + CV_O4B, wk, nw); }
                convert_experts_range(F, args, j, CV_PRE + CV_O4B + CV_T1 + CV_T2, CV_ITEMS - CV_O4B1, wk, nw); }
        }
        __syncthreads(); PROBE_END(23);
#if P0_SPLIT && P0_STREAM && CQ_LOCAL
        if (j == 0) { __syncthreads(); convert_bf16_pair(F, args, 1); colquant_pair(F, args, 1); }
#endif
        __syncthreads();
        for (int rb = F.vcu; rb < 256; rb += F.G) skinny_lr(F, j, rb, pg8::SumSq{nullptr, SSC});
#if IN_O_I8 == 2
        split_wait((unsigned*)(F.ctl + CW_SPLIT + 64 * j), (unsigned*)(F.ctl + CW_BAR));
        pg8::DenseSched S; S.init(F.ws + WS_HB8O, (const unsigned char*)(F.ws + WS_WINO) + (size_t)j * 3072 * D, T, 3072, D, F.G, cblk, 1);
        pg8::EpiProjI8<1> E{pg8::SumSq{nullptr, SSC}, pg8::SumSq{nullptr, nullptr}, (const float*)(F.ws + CTL_WMAXO) + j * 3072, (bf16_t*)(F.ws + WS_GQ), 512, 1.f, (const float*)(F.ws + WS_SMALL + SM_STEPO)};
        pg8::gemm_phase<pg8::EpiProjI8<1>, pg8::DenseSched, true, true, 1, true>(F.lds, D, D, S, E);
#elif IN_O_I8
        pg8::DenseSched S; S.init(F.ws + WS_HB8O, (const unsigned char*)(F.ws + WS_WINO) + (size_t)j * 3072 * D, T, 3072, D, F.G, cblk, 1);
        pg8::EpiProjI8<1> E{pg8::SumSq{nullptr, SSC}, pg8::SumSq{nullptr, SSB}, (const float*)(F.ws + CTL_WMAXO) + j * 3072, (bf16_t*)(F.ws + WS_GQ), 512, 1.f};
        pg8::gemm_phase<pg8::EpiProjI8<1>, pg8::DenseSched, true, true, 1, true>(F.lds, D, D, S, E);
#else
        pg8::DenseSched S; S.init(HB, (const bf16_t*)(F.ws + WS_WINO) + (size_t)j * 3072 * D, T, 3072, D, F.G, cblk);
        pg8::EpiProj<1> E{pg8::SumSq{nullptr, SSC}, (bf16_t*)(F.ws + WS_GQ), 512, 1.f, nullptr};
        pg8::gemm_phase<pg8::EpiProj<1>, pg8::DenseSched, true, true>(F.lds, D, D, S, E);
#endif
    }; body_(); if (REPK(6)) body_(); }
    SEAM(pb + 6);
    PROBE_END(6);
    PROBE_BEGIN(7);
    if (PHC(7) && IN(pb + 7)) { auto body_ = [&]() { Frame Fq_ = F; { int t_ = threadIdx.x; asm volatile("" : "+v"(t_)); Fq_.tid = t_; Fq_.lane = t_ & 63; } Frame& F = Fq_;     GlaPrepRegs R; R.gh = -1; if (F.vcu < 1024) gla_prep_load(F, F.vcu, R); for (int it = F.vcu; it < 1024; it += F.G) gla_prep(F, args, j, it, it + F.G < 1024 ? it + F.G : -1, R); }; body_(); if (REPK(7)) body_(); }
    SEAM(pb + 7);
    PROBE_END(7);
    PROBE_BEGIN(8);
    if (PHC(8) && IN(pb + 8)) { auto body_ = [&]() { Frame Fq_ = F; { int t_ = threadIdx.x; asm volatile("" : "+v"(t_)); Fq_.tid = t_; Fq_.lane = t_ & 63; } Frame& F = Fq_;     for (int g = F.vcu * NTHR + F.tid; g < 131072; g += F.G * NTHR) gla_state(F, g); }; body_(); if (REPK(8)) body_(); }
    SEAM(pb + 8);
    PROBE_END(8);
    PROBE_BEGIN(9);
    if (PHC(9) && IN(pb + 9)) { auto body_ = [&]() { Frame Fq_ = F; { int t_ = threadIdx.x; asm volatile("" : "+v"(t_)); Fq_.tid = t_; Fq_.lane = t_ & 63; } Frame& F = Fq_;     GlaOutRegs R; int cur_h = -1; if (F.vcu < 1024) gla_out_load(F, F.vcu, R); for (int it = F.vcu; it < 1024; it += F.G) { const int ih = (it >> 6) & 3; if (ih != cur_h) { __syncthreads(); if (F.tid < 256) ((LAS float*)(F.lds + GC_HN))[F.tid] = args.in[20][j * 1024 + ih * 256 + F.tid]; cur_h = ih; }     gla_out(F, args, j, it, it + F.G < 1024 ? it + F.G : -1, R); } }; body_(); if (REPK(9)) body_(); }
    SEAM(pb + 9);
    PROBE_END(9);
    PROBE_BEGIN(10);
    if (PHC(10) && IN(pb + 10)) { auto body_ = [&]() { Frame Fq_ = F; { int t_ = threadIdx.x; asm volatile("" : "+v"(t_)); Fq_.tid = t_; Fq_.lane = t_ & 63; } Frame& F = Fq_;
        pg8::DenseSched S; S.init((const bf16_t*)(F.ws + WS_OG), (const bf16_t*)(F.ws + WS_WOUTO) + (size_t)j * D * D, T, D, D, F.G, cblk);
        EPIRES_T(false) E{BF16_RESID ? nullptr : H, HB, H, BF16_RESID ? HB : nullptr, nullptr, nullptr, pg8::SumSq{nullptr, nullptr}};
        pg8::gemm_phase<EPIRES_T(false), pg8::DenseSched, false, true>(F.lds, D, D, S, E);
    }; body_(); if (REPK(10)) body_(); }
    SEAM(pb + 10);
    PROBE_END(10);
    PROBE_BEGIN(11);
    if (PHC(11) && IN(pb + 11)) { auto body_ = [&]() { Frame Fq_ = F; { int t_ = threadIdx.x; asm volatile("" : "+v"(t_)); Fq_.tid = t_; Fq_.lane = t_ & 63; } Frame& F = Fq_;
        PROBE_BEGIN(20); stage_table8(F, (LAS float*)(F.lds + RP_TAB), args.in[22] + (size_t)j * D * 8, 8, 0, args.in[2] + (2 * j + 1) * D); PROBE_END(20);
        f32x4 gk[4];
#pragma unroll
        for (int jj = 0; jj < 4; ++jj) gk[jj] = *(const GAS f32x4*)(args.in[2] + (2 * j + 1) * D + 4 * F.lane + 256 * jj);
        PROBE_BEGIN(21); for (int rb = F.vcu; rb < 256; rb += F.G) router_rows(F, args, j, rb, gk); PROBE_END(21);
    }; body_(); if (REPK(11)) body_(); }
    SEAM(pb + 11);
    PROBE_END(11);
    if (IN(pb + 12) || IN(pb + 13) || IN(pb + 14)) moe_tables(F, j);
    const LAS int* tab = (const LAS int*)(F.lds + MT_OFF);
    PROBE_BEGIN(12);
    if (PHC(12) && IN(pb + 12)) { auto body_ = [&]() { Frame Fq_ = F; { int t_ = threadIdx.x; asm volatile("" : "+v"(t_)); Fq_.tid = t_; Fq_.lane = t_ & 63; } Frame& F = Fq_;
        pg8::MoeSched<true> S; S.A = (const char*)(F.ws + WS_XN); S.Bt = (const char*)(F.ws + WS_W13E + (size_t)j * W13E_PAIR); S.nM = __builtin_amdgcn_readfirstlane(tab[8]); S.nN = 2 * DFE / 256; S.G = F.G; S.c = cblk;
        S.tstepA = 0; S.tstepB = (size_t)256 * D; S.estride = (size_t)2 * DFE * D; S.K2 = D; S.ncol = 2 * DFE / 256; S.ksoff = 0; S.tab = tab; S.TL = (const int*)(F.ws + WS_RT + RT_TL); S.rowtab = (const LAS unsigned*)(F.lds + ROWTAB_OFF); S.fill_rows((LAS unsigned*)(F.lds + ROWTAB_OFF));
        pg8::EpiGluT<true> E{pg8::SumSq{nullptr, nullptr}, (void*)(F.ws + WS_HM), DFE};
        pg8::gemm_phase<pg8::EpiGluT<true>, pg8::MoeSched<true>, true, true, 1>(F.lds, D, D, S, E, W13_SCALE);
        if (j == 1 && F.G == 256 && CV_O4B1 > 0) { const int tf = tail_first(S.nM * S.nN); const int cap = (256 - tf) * NWAVES * 4; const int nx = cap < CV_O4B1 ? cap : CV_O4B1; const int lo1 = CV_ITEMS - CV_O4B1;
            if (cblk >= tf) convert_experts_range(F, args, 1, lo1, lo1 + nx, (cblk - tf) * NWAVES + F.wave, (256 - tf) * NWAVES);
            if (nx < CV_O4B1) convert_experts_range(F, args, 1, lo1 + nx, lo1 + CV_O4B1, F.vcu * NWAVES + F.wave, F.G * NWAVES); }
        if (j == 0 && F.G == 256 && CV_O4B > 0) { const int tf = tail_first(S.nM * S.nN); const int nx = o4b_share(tf); if (cblk >= tf) convert_experts_range(F, args, 1, CV_PRE, CV_PRE + nx, (cblk - tf) * NWAVES + F.wave, (256 - tf) * NWAVES); }
    }; body_(); if (REPK(12)) body_(); }
    SEAM(pb + 12);
    PROBE_END(12);
    PROBE_BEGIN(13);
    if (PHC(13) && IN(pb + 13)) { auto body_ = [&]() { Frame Fq_ = F; { int t_ = threadIdx.x; asm volatile("" : "+v"(t_)); Fq_.tid = t_; Fq_.lane = t_ & 63; } Frame& F = Fq_;
        pg8::MoeSched<false> S; S.A = (const char*)(F.ws + WS_HM); S.Bt = (const char*)(F.ws + WS_W2E); S.nM = __builtin_amdgcn_readfirstlane(tab[8]); S.nN = 2 * (D / 256); S.G = F.G; S.c = cblk;
        S.tstepA = (size_t)256 * DFE; S.tstepB = (size_t)256 * DFE; S.estride = (size_t)D * DFE; S.K2 = DFE; S.ncol = D / 256; S.ksoff = (size_t)(DFE / 2); S.tab = tab; S.TL = nullptr; S.rowtab = nullptr;
        pg8::EpiProj<3> E{pg8::SumSq{nullptr, nullptr}, (bf16_t*)(F.ws + WS_YM), D, 1.f, (bf16_t*)(F.ws + WS_YM1)};
        pg8::gemm_phase<pg8::EpiProj<3>, pg8::MoeSched<false>, true, true, 1>(F.lds, DFE / 2, DFE, S, E, W2_SCALE);
        if (j == 0 && F.G == 256) { const int tf = tail_first(S.nM * S.nN); if (cblk >= tf) convert_experts_range(F, args, 1, 0, CV_PRE, (cblk - tf) * NWAVES + F.wave, (256 - tf) * NWAVES); }
    }; body_(); if (REPK(13)) body_(); }
    SEAM(pb + 13);
    PROBE_END(13);
    PROBE_BEGIN(14);
    if (PHC(14) && IN(pb + 14)) { auto body_ = [&]() { Frame Fq_ = F; { int t_ = threadIdx.x; asm volatile("" : "+v"(t_)); Fq_.tid = t_; Fq_.lane = t_ & 63; } Frame& F = Fq_;
        if (j == 0) stage_table8(F, (LAS float*)(F.lds), args.in[4] + (size_t)D * EIN, EIN, 2560, args.in[1] + 2 * D);
        combine_rows(F, args, j, j == 1);
    }; body_(); if (REPK(14)) body_(); }
    if (j == 0) SEAM(pb + 14);
    PROBE_END(14);
}

__global__ void __launch_bounds__(NTHR, 2) fwd(Args args) {
    extern __shared__ __attribute__((aligned(16))) unsigned char lds_raw[];
    Frame F;
    F.lds = (LAS unsigned char*)lds_raw; F.MISC = (volatile LAS unsigned*)(F.lds + MISC_OFF);
    F.tid = threadIdx.x; F.lane = F.tid & 63; F.wave = __builtin_amdgcn_readfirstlane(F.tid >> 6);
    F.G = gridDim.x; { const int bx = blockIdx.x; F.vcu = (F.G % 8 == 0) ? (bx % 8) * (F.G / 8) + bx / 8 : bx; }
    F.ws = args.ws; F.ctl = (gu32*)(args.ws + WS_CTL);
    { int tz_ = threadIdx.x; asm volatile("" : "+v"(tz_));
      for (int u = tz_; u < (LDS_BYTES - RING_BYTES) / 4; u += NTHR) ((LAS unsigned*)(F.lds + RING_BYTES))[u] = 0u; }
    __syncthreads();
    const int lo = args.ph_lo, hi = args.ph_hi;
    const bool multi = (hi - lo) > 1;
    XcdBarrier bar; bar.bar = (unsigned*)(F.ctl + CW_BAR); bar.x = 0; bar.st = nullptr;
    if (multi) bar = xcd_barrier_post((unsigned*)(F.ctl + CW_BAR), F.MISC + 8);
    unsigned long long pr_acc = 0, pr_t0 = 0;
    PROBE_BEGIN(15);
    if (PHC(15) && IN(0)) {
#if E1_I8 && !CQ_LOCAL
        if (args.p0sub != 2) colmax_wine(F, args);
        if (args.p0sub == 0 && multi) xcd_barrier(bar);
        if (args.p0sub != 1) { convert_dense(F, args); __syncthreads(); p0_rows(F, args); }
#else
        PROBE_BEGIN(16); convert_dense(F, args); __syncthreads(); PROBE_END(16); if (PROBE_PHASE == 19 && blockIdx.x == 0 && threadIdx.x == 0) { volatile unsigned long long* pp = (volatile unsigned long long*)(F.ws + WS_CTL + 2040 * 1024); pr_acc += pp[1] - pp[0]; } PROBE_BEGIN(18); p0_rows(F, args); PROBE_END(18);
#endif
    }
    SEAM(0);
    PROBE_END(15);
    pair_body<0>(F, args, lo, hi, bar, lds_raw, pr_acc);
    pair_body<1>(F, args, lo, hi, bar, lds_raw, pr_acc);
    if (PROBE_PHASE >= 0 && blockIdx.x == 0 && threadIdx.x == 0) { const unsigned long long t1 = __builtin_amdgcn_s_memrealtime(); while (__builtin_amdgcn_s_memrealtime() - t1 < 4ull * pr_acc) __builtin_amdgcn_s_sleep(8); }
}
#undef IN
#undef SEAM
}
extern "C" void kernel_launch(void* const* d_in, const int* in_sizes, int n_in, void* d_out, int out_size, void* d_ws, size_t ws_size, hipStream_t stream) {
    static int grid = 0;
    if (grid == 0) {
        if (n_in != 26 || out_size != 16384 * 1024 || ws_size < (size_t)896 * 1024 * 1024) { fprintf(stderr, "kernel_launch: unexpected sizes n_in %d out %d ws %zu\n", n_in, out_size, ws_size); grid = -1; return; }
        int dev = 0, cus = 0, per_cu = 0;
        if (hipGetDevice(&dev) != hipSuccess || hipDeviceGetAttribute(&cus, hipDeviceAttributeMultiprocessorCount, dev) != hipSuccess) { grid = -1; return; }
        if (hipFuncSetAttribute((const void*)fk::fwd, hipFuncAttributeMaxDynamicSharedMemorySize, fk::LDS_BYTES) != hipSuccess) { fprintf(stderr, "kernel_launch: hipFuncSetAttribute failed\n"); grid = -1; return; }
        if (hipOccupancyMaxActiveBlocksPerMultiprocessor(&per_cu, (const void*)fk::fwd, fk::NTHR, fk::LDS_BYTES) != hipSuccess || per_cu < 1) fprintf(stderr, "kernel_launch: occupancy query says %d\n", per_cu);
        (void)hipGetLastError();
        grid = cus;
    }
    if (grid < 0) return;
    (void)hipMemsetAsync((char*)d_ws + fk::WS_CTL, 0, fk::CTL_ZERO_BYTES, stream);
    fk::Args a{};
    for (int i = 0; i < 26; ++i) a.in[i] = (const float*)d_in[i];
    a.out = (float*)d_out; a.ws = (unsigned char*)d_ws; a.ph_lo = 0; a.ph_hi = fk::N_PHASES;
    hipLaunchKernelGGL(fk::fwd, dim3(grid), dim3(fk::NTHR), fk::LDS_BYTES, stream, a);
#ifdef PROF_PHASES
    { const int plist[] = {PROF_PHASES};
      for (int r = 0; r < PROF_REP; ++r) for (int ph : plist) { a.ph_lo = ph; a.ph_hi = ph + 1; hipLaunchKernelGGL(fk::fwd, dim3(grid), dim3(fk::NTHR), fk::LDS_BYTES, stream, a); } }
#endif
}
```
